# Optimizing an MI355X kernel written in HIP

```python
import jax, jax.numpy as jnp
from jax import lax
import numpy as np

D_MODEL = 2048
BATCH = 4
SEQ = 4096
DEPTH = 2

RMS_EPS = 1e-6
CONV_WIDTH = 4
LRU_WIDTH = D_MODEL
LRU_BLOCKS = 16
LRU_BLOCK = LRU_WIDTH // LRU_BLOCKS
LRU_C = 8.0
MLSTM_WIDTH = D_MODEL
MLSTM_HEADS = 8
MLSTM_HEAD_DIM = MLSTM_WIDTH // MLSTM_HEADS
MLSTM_QKV_BLOCK = 4
MLSTM_QKV_BLOCKS = MLSTM_WIDTH // MLSTM_QKV_BLOCK
MLSTM_CHUNK = 128
MLSTM_GN_EPS = 1e-6
EVEN_MIX = LRU_WIDTH + MLSTM_WIDTH
RWKV_WIDTH = 2 * D_MODEL
RWKV_HEAD_DIM = 64
RWKV_HEADS = RWKV_WIDTH // RWKV_HEAD_DIM
RWKV_DECAY_RANK = 96
RWKV_A_RANK = 96
RWKV_GN_EPS = 64e-5

kernel_name = 'hybrid_rglru_mlstm_rwkv7'


def rms_norm(x, g):
    xf = x.astype(jnp.float32)
    y = xf * lax.rsqrt(jnp.mean(xf * xf, axis=-1, keepdims=True) + RMS_EPS)
    return (y * g.astype(jnp.float32)).astype(x.dtype)


def head_norm(x, n_heads, eps, g, b=None):
    xf = x.astype(jnp.float32)
    xh = xf.reshape(*xf.shape[:-1], n_heads, -1)
    mu = jnp.mean(xh, axis=-1, keepdims=True)
    var = jnp.mean(jnp.square(xh - mu), axis=-1, keepdims=True)
    y = ((xh - mu) * lax.rsqrt(var + eps)).reshape(xf.shape) * g.astype(jnp.float32)
    if b is not None:
        y = y + b.astype(jnp.float32)
    return y.astype(x.dtype)


def shift_right(x):
    return jnp.pad(x[:, :-1], ((0, 0), (1, 0), (0, 0)))


def causal_dwconv(x, w, b):
    K = w.shape[0]
    S = x.shape[1]
    xp = jnp.pad(x, ((0, 0), (K - 1, 0), (0, 0)))
    y = b
    for j in range(K):
        y = y + xp[:, j:j + S] * w[j]
    return y


def block_diag(x, w):
    nb, bs, bo = w.shape
    xb = x.reshape(*x.shape[:-1], nb, bs)
    return jnp.einsum('bsni,nij->bsnj', xb, w).reshape(x.shape[:-1] + (nb * bo,))


def rg_lru(x, w_a, b_a, w_x, b_x, lam):
    xf = x.astype(jnp.float32)
    r = jax.nn.sigmoid(block_diag(xf, w_a.astype(jnp.float32)) + b_a.astype(jnp.float32))
    i = jax.nn.sigmoid(block_diag(xf, w_x.astype(jnp.float32)) + b_x.astype(jnp.float32))
    log_a = -LRU_C * r * jax.nn.softplus(-lam.astype(jnp.float32))
    a = jnp.exp(log_a)
    u = jnp.sqrt(-jnp.expm1(2.0 * log_a)) * (i * xf)

    def combine(c1, c2):
        a1, b1 = c1
        a2, b2 = c2
        return a1 * a2, a2 * b1 + b2

    _, h = lax.associative_scan(combine, (a, u), axis=1)
    return h.astype(x.dtype)


def mlstm_chunkwise(q, k, v, ig, fg):
    B, S, _ = q.shape
    H, d, L = MLSTM_HEADS, MLSTM_HEAD_DIM, MLSTM_CHUNK
    nc = S // L

    def to_chunks(t):
        return t.astype(jnp.float32).reshape(B, nc, L, H, d).transpose(1, 0, 3, 2, 4)

    def gate_chunks(t):
        return t.astype(jnp.float32).reshape(B, nc, L, H).transpose(1, 0, 3, 2)

    qc = to_chunks(q)
    kc = to_chunks(k) * (d ** -0.5)
    vc = to_chunks(v)
    igc = gate_chunks(ig)
    lfc = jax.nn.log_sigmoid(gate_chunks(fg))
    causal = jnp.tril(jnp.ones((L, L), dtype=bool))

    def body(carry, inp):
        C, n, m = carry
        qb, kb, vb, ib, lb = inp
        b = jnp.cumsum(lb, axis=-1)
        Dm = b[..., :, None] - b[..., None, :] + ib[..., None, :]
        Dm = jnp.where(causal, Dm, -jnp.inf)
        m_inter = b + m[..., None]
        m_t = jnp.maximum(jnp.max(Dm, axis=-1), m_inter)
        scores = jnp.einsum('bhtd,bhsd->bhts', qb, kb) * jnp.exp(Dm - m_t[..., None])
        inter = jnp.exp(m_inter - m_t)
        num = (jnp.einsum('bhts,bhsd->bhtd', scores, vb)
               + inter[..., None] * jnp.einsum('bhtd,bhde->bhte', qb, C))
        den = jnp.sum(scores, axis=-1) + inter * jnp.einsum('bhtd,bhd->bht', qb, n)
        h = num / jnp.maximum(jnp.abs(den), jnp.exp(-m_t))[..., None]
        bL = b[..., -1]
        g = bL[..., None] - b + ib
        m_new = jnp.maximum(bL + m, jnp.max(g, axis=-1))
        decay = jnp.exp(bL + m - m_new)
        wts = jnp.exp(g - m_new[..., None])
        C = decay[..., None, None] * C + jnp.einsum('bhs,bhsd,bhse->bhde', wts, kb, vb)
        n = decay[..., None] * n + jnp.einsum('bhs,bhsd->bhd', wts, kb)
        return (C, n, m_new), h

    init = (jnp.zeros((B, H, d, d), jnp.float32),
            jnp.zeros((B, H, d), jnp.float32),
            jnp.zeros((B, H), jnp.float32))
    _, h = lax.scan(body, init, (qc, kc, vc, igc, lfc))
    return h.transpose(1, 0, 3, 2, 4).reshape(B, S, H * d).astype(q.dtype)


def rwkv7_scan(r, w, k, v, kk, a):
    B, _, H, d = r.shape

    def step(S, inp):
        r_t, w_t, k_t, v_t, kk_t, a_t = inp
        sa = jnp.einsum('bhvk,bhk->bhv', S, -kk_t)
        S = (S * w_t[:, :, None, :] + sa[..., None] * (kk_t * a_t)[:, :, None, :]
             + v_t[..., None] * k_t[:, :, None, :])
        return S, jnp.einsum('bhvk,bhk->bhv', S, r_t)

    xs = (jnp.moveaxis(r, 1, 0), jnp.moveaxis(w, 1, 0), jnp.moveaxis(k, 1, 0),
          jnp.moveaxis(v, 1, 0), jnp.moveaxis(kk, 1, 0), jnp.moveaxis(a, 1, 0))
    _, y = lax.scan(step, jnp.zeros((B, H, d, d), jnp.float32), xs)
    return jnp.moveaxis(y, 0, 1)


def even_mixer(h, w_in, lru_conv_w, lru_conv_b, lru_wa, lru_ba, lru_wx, lru_bx, lru_lambda,
               m_conv_w, m_conv_b, m_wq, m_wk, m_wv, m_wi, m_bi, m_wf, m_bf, m_skip, m_gn,
               w_out):
    u = h @ w_in
    xr, zr, xm, zm = jnp.split(
        u, [LRU_WIDTH, 2 * LRU_WIDTH, 2 * LRU_WIDTH + MLSTM_WIDTH], axis=-1)
    xr = causal_dwconv(xr, lru_conv_w, lru_conv_b)
    yr = rg_lru(xr, lru_wa, lru_ba, lru_wx, lru_bx, lru_lambda)
    xmc = jax.nn.silu(causal_dwconv(xm, m_conv_w, m_conv_b))
    q = block_diag(xmc, m_wq)
    k = block_diag(xmc, m_wk)
    v = block_diag(xm, m_wv)
    qkv = jnp.concatenate([q, k, v], axis=-1)
    ig = qkv @ m_wi + m_bi
    fg = qkv @ m_wf + m_bf
    ym = mlstm_chunkwise(q, k, v, ig, fg)
    ym = head_norm(ym, MLSTM_HEADS, MLSTM_GN_EPS, m_gn) + m_skip * xmc
    y = jnp.concatenate([yr * jax.nn.silu(zr), ym * jax.nn.silu(zm)], axis=-1)
    return y @ w_out


def odd_mixer(h, w_in, mu_rkv, mu_w, mu_a, w0, w1, w2, a0, a1, a2, k_k, k_a, r_k,
              gn_g, gn_b, w_out):
    B, S, _ = h.shape
    H, d = RWKV_HEADS, RWKV_HEAD_DIM
    u = h @ w_in
    rkv, z = u[..., :3 * RWKV_WIDTH], u[..., 3 * RWKV_WIDTH:]
    rkv = rkv + (shift_right(rkv) - rkv) * mu_rkv
    r, k, v = jnp.split(rkv, 3, axis=-1)
    dh = shift_right(h) - h
    xw = h + dh * mu_w
    xa = h + dh * mu_a
    w_log = -jax.nn.softplus(-(w0 + jnp.tanh(xw @ w1) @ w2)) - 0.5
    decay = jnp.exp(-jnp.exp(w_log.astype(jnp.float32)))
    a = jax.nn.sigmoid((a0 + (xa @ a1) @ a2).astype(jnp.float32))
    kk = (k * k_k).astype(jnp.float32).reshape(B, S, H, d)
    kk = kk / jnp.maximum(jnp.sqrt(jnp.sum(kk * kk, axis=-1, keepdims=True)), 1e-12)
    k = k.astype(jnp.float32) * (1.0 + (a - 1.0) * k_a.astype(jnp.float32))
    rh = r.astype(jnp.float32).reshape(B, S, H, d)
    kh = k.reshape(B, S, H, d)
    vh = v.astype(jnp.float32).reshape(B, S, H, d)
    ah = a.reshape(B, S, H, d)
    wh = decay.reshape(B, S, H, d)
    y = rwkv7_scan(rh, wh, kh, vh, kk, ah)
    y = head_norm(y.reshape(B, S, RWKV_WIDTH), H, RWKV_GN_EPS, gn_g, gn_b)
    bonus = jnp.sum(rh * kh * r_k.astype(jnp.float32), axis=-1, keepdims=True) * vh
    y = (y + bonus.reshape(B, S, RWKV_WIDTH)).astype(h.dtype)
    return (y * jax.nn.silu(z)) @ w_out


def setup_inputs(seed: int = 0) -> dict:
    key = jax.random.key(seed)
    ks = iter(jax.random.split(key, 64))
    f32 = jnp.float32

    def nrm(shape, scale):
        return jax.random.normal(next(ks), shape, f32) * scale

    def gain(n):
        return 1.0 + nrm((n,), 0.02)

    def unif(shape, lo, hi):
        return jax.random.uniform(next(ks), shape, f32, lo, hi)

    D, R, M, W = D_MODEL, LRU_WIDTH, MLSTM_WIDTH, RWKV_WIDTH
    x = jax.random.normal(next(ks), (BATCH, SEQ, D), f32)
    s = unif((R,), 0.9, 0.999) ** (1.0 / LRU_C)
    lru_lambda = jnp.log(s) - jnp.log1p(-s)
    w0 = jnp.tile(jnp.linspace(-6.0, -1.0, RWKV_HEAD_DIM, dtype=f32), RWKV_HEADS) + nrm((W,), 0.1)
    return {
        'x': x,
        'l0_norm_pre': gain(D),
        'l0_w_in': nrm((D, 2 * EVEN_MIX), D ** -0.5),
        'l0_lru_conv_w': nrm((CONV_WIDTH, R), CONV_WIDTH ** -0.5),
        'l0_lru_conv_b': nrm((R,), 0.01),
        'l0_lru_wa': nrm((LRU_BLOCKS, LRU_BLOCK, LRU_BLOCK), LRU_BLOCK ** -0.5),
        'l0_lru_ba': nrm((R,), 0.01),
        'l0_lru_wx': nrm((LRU_BLOCKS, LRU_BLOCK, LRU_BLOCK), LRU_BLOCK ** -0.5),
        'l0_lru_bx': nrm((R,), 0.01),
        'l0_lru_lambda': lru_lambda,
        'l0_m_conv_w': nrm((CONV_WIDTH, M), CONV_WIDTH ** -0.5),
        'l0_m_conv_b': nrm((M,), 0.01),
        'l0_m_wq': nrm((MLSTM_QKV_BLOCKS, MLSTM_QKV_BLOCK, MLSTM_QKV_BLOCK), MLSTM_QKV_BLOCK ** -0.5),
        'l0_m_wk': nrm((MLSTM_QKV_BLOCKS, MLSTM_QKV_BLOCK, MLSTM_QKV_BLOCK), MLSTM_QKV_BLOCK ** -0.5),
        'l0_m_wv': nrm((MLSTM_QKV_BLOCKS, MLSTM_QKV_BLOCK, MLSTM_QKV_BLOCK), MLSTM_QKV_BLOCK ** -0.5),
        'l0_m_wi': nrm((3 * M, MLSTM_HEADS), (3 * M) ** -0.5),
        'l0_m_bi': nrm((MLSTM_HEADS,), 0.1),
        'l0_m_wf': nrm((3 * M, MLSTM_HEADS), (3 * M) ** -0.5),
        'l0_m_bf': jnp.linspace(3.0, 6.0, MLSTM_HEADS, dtype=f32) + nrm((MLSTM_HEADS,), 0.1),
        'l0_m_skip': gain(M),
        'l0_m_gn': gain(M),
        'l0_w_out': nrm((EVEN_MIX, D), EVEN_MIX ** -0.5),
        'l0_norm_post': gain(D),
        'l1_norm_pre': gain(D),
        'l1_w_in': nrm((D, 4 * W), D ** -0.5),
        'l1_mu_rkv': unif((3 * W,), 0.0, 1.0),
        'l1_mu_w': unif((D,), 0.0, 1.0),
        'l1_mu_a': unif((D,), 0.0, 1.0),
        'l1_w0': w0,
        'l1_w1': nrm((D, RWKV_DECAY_RANK), D ** -0.5),
        'l1_w2': nrm((RWKV_DECAY_RANK, W), 0.1 * RWKV_DECAY_RANK ** -0.5),
        'l1_a0': nrm((W,), 0.1),
        'l1_a1': nrm((D, RWKV_A_RANK), D ** -0.5),
        'l1_a2': nrm((RWKV_A_RANK, W), RWKV_A_RANK ** -0.5),
        'l1_k_k': 0.85 + nrm((W,), 0.02),
        'l1_k_a': 1.0 + nrm((W,), 0.02),
        'l1_r_k': nrm((RWKV_HEADS, RWKV_HEAD_DIM), 0.1),
        'l1_gn_g': gain(W),
        'l1_gn_b': nrm((W,), 0.02),
        'l1_w_out': nrm((W, D), W ** -0.5),
        'l1_norm_post': gain(D),
    }


def reference(x, l0_norm_pre, l0_w_in, l0_lru_conv_w, l0_lru_conv_b, l0_lru_wa, l0_lru_ba,
              l0_lru_wx, l0_lru_bx, l0_lru_lambda, l0_m_conv_w, l0_m_conv_b, l0_m_wq, l0_m_wk,
              l0_m_wv, l0_m_wi, l0_m_bi, l0_m_wf, l0_m_bf, l0_m_skip, l0_m_gn, l0_w_out,
              l0_norm_post, l1_norm_pre, l1_w_in, l1_mu_rkv, l1_mu_w, l1_mu_a, l1_w0, l1_w1,
              l1_w2, l1_a0, l1_a1, l1_a2, l1_k_k, l1_k_a, l1_r_k, l1_gn_g, l1_gn_b, l1_w_out,
              l1_norm_post):
    even_p = (l0_w_in, l0_lru_conv_w, l0_lru_conv_b, l0_lru_wa, l0_lru_ba, l0_lru_wx,
              l0_lru_bx, l0_lru_lambda, l0_m_conv_w, l0_m_conv_b, l0_m_wq, l0_m_wk, l0_m_wv,
              l0_m_wi, l0_m_bi, l0_m_wf, l0_m_bf, l0_m_skip, l0_m_gn, l0_w_out)
    odd_p = (l1_w_in, l1_mu_rkv, l1_mu_w, l1_mu_a, l1_w0, l1_w1, l1_w2, l1_a0, l1_a1, l1_a2,
             l1_k_k, l1_k_a, l1_r_k, l1_gn_g, l1_gn_b, l1_w_out)
    layer_params = [(l0_norm_pre, l0_norm_post, even_p), (l1_norm_pre, l1_norm_post, odd_p)]
    for layer in range(DEPTH):
        g_pre, g_post, p = layer_params[layer]
        h = rms_norm(x, g_pre)
        h = even_mixer(h, *p) if layer % 2 == 0 else odd_mixer(h, *p)
        x = x + rms_norm(h, g_post)
    return x
```

```cpp
#include <hip/hip_runtime.h>
#include <hip/hip_cooperative_groups.h>
#include <cstdio>
namespace cg = cooperative_groups;

#ifndef N_LAUNCH_MODE
#define N_LAUNCH_MODE 1
#endif

typedef unsigned short u16;
typedef short bf16x8 __attribute__((ext_vector_type(8)));
typedef float f32x4 __attribute__((ext_vector_type(4)));
typedef float f32x2 __attribute__((ext_vector_type(2)));
typedef unsigned u32x4 __attribute__((ext_vector_type(4)));
typedef unsigned u32x2 __attribute__((ext_vector_type(2)));

constexpr int NTOK = 16384, DM = 2048, SEQL = 4096;
constexpr size_t MiB = (size_t)1 << 20;
constexpr size_t OFF_H = 0;
constexpr size_t OFF_XR = 64 * MiB;
constexpr size_t OFF_XM = 128 * MiB;
constexpr size_t OFF_Y0 = 192 * MiB;
constexpr size_t OFF_Q = 320 * MiB;
constexpr size_t OFF_KX = 384 * MiB;
constexpr size_t OFF_W0IN = 448 * MiB;
constexpr size_t OFF_W0OUT = 480 * MiB;
constexpr size_t OFF_SMALL = 496 * MiB;
constexpr size_t OFF_G = OFF_SMALL;
constexpr size_t OFF_LRUA = OFF_SMALL + 1 * MiB;
constexpr size_t OFF_LRUH = OFF_SMALL + 3 * MiB;
constexpr size_t OFF_LRUC = OFF_SMALL + 5 * MiB;
constexpr size_t OFF_LRUW = OFF_SMALL + 7 * MiB;
constexpr size_t OFF_WGT = OFF_SMALL + 8 * MiB;
constexpr size_t OFF_M0 = OFF_XR;
constexpr size_t OFF_R = 64 * MiB, OFF_KK = 192 * MiB, OFF_V = 320 * MiB;
constexpr size_t OFF_W1 = 448 * MiB;
constexpr size_t OFF_P = 498 * MiB;
constexpr size_t OFF_W1Z = 448 * MiB, OFF_W1OUT = 464 * MiB;
constexpr size_t OFF_M1 = OFF_V;
constexpr size_t WS_NEED = 510 * MiB;
constexpr int LDS_BYTES = 160 * 1024;
constexpr int NPH = 13;

struct Params { const float* in[41]; float* out; unsigned char* ws; int ph_lo, ph_hi; };

__device__ __forceinline__ unsigned pk2(float lo, float hi) { unsigned r; asm volatile("v_cvt_pk_bf16_f32 %0, %1, %2" : "=v"(r) : "v"(lo), "v"(hi)); return r; }
__device__ __forceinline__ u16 f2bf(float f) { return (u16)(pk2(f, 0.f) & 0xffffu); }
__device__ __forceinline__ float bf2f(u16 v) { return __uint_as_float(((unsigned)v) << 16); }
__device__ __forceinline__ float bflo(unsigned w) { return __uint_as_float(w << 16); }
__device__ __forceinline__ float bfhi(unsigned w) { return __uint_as_float(w & 0xffff0000u); }
__device__ __forceinline__ void unpack8(u32x4 w, float* f) { f[0] = bflo(w.x); f[1] = bfhi(w.x); f[2] = bflo(w.y); f[3] = bfhi(w.y); f[4] = bflo(w.z); f[5] = bfhi(w.z); f[6] = bflo(w.w); f[7] = bfhi(w.w); }
__device__ __forceinline__ u32x4 pack8(const float* f) { u32x4 w; w.x = pk2(f[0], f[1]); w.y = pk2(f[2], f[3]); w.z = pk2(f[4], f[5]); w.w = pk2(f[6], f[7]); return w; }
__device__ __forceinline__ bf16x8 as_frag(u32x4 w) { union { u32x4 u; bf16x8 b; } c; c.u = w; return c.b; }
__device__ __forceinline__ float sigmoidf_(float x) { return 1.0f / (1.0f + __expf(-x)); }
__device__ __forceinline__ float siluf_(float x) { return x / (1.0f + __expf(-x)); }
__device__ __forceinline__ float softplusf_(float x) { return fmaxf(x, 0.f) + log1pf(__expf(-fabsf(x))); }
__device__ __forceinline__ float wave_sum(float v) {
#pragma unroll
    for (int o = 32; o; o >>= 1) v += __shfl_xor(v, o);
    return v;
}
template <int CTRL> __device__ __forceinline__ float dppf(float v) { return __int_as_float(__builtin_amdgcn_update_dpp(0, __float_as_int(v), CTRL, 0xF, 0xF, false)); }
#define MFMA16(a, b, c) __builtin_amdgcn_mfma_f32_16x16x32_bf16((a), (b), (c), 0, 0, 0)

namespace pg8 {
#define PG8_LAS __attribute__((address_space(3)))
typedef unsigned short bf16_t;
constexpr int BM = 256, BK = 64, HALF = 128, HTB = HALF * BK * 2, STAGE_BYTES = 8 * HTB, NXCD = 8, WGM = 8;
__host__ __device__ __forceinline__ int lds_byte(int r, int c) { const int st = (r >> 4) * 2 + (c >> 5), rr = r & 15, cc = c & 31, ob = rr * 64 + cc * 2; return st * 1024 + (ob ^ (((ob >> 9) & 1) << 5)); }
__host__ __device__ __forceinline__ void stage_rc(int b, int& R, int& C) { const int st = b / 1024, sb = b % 1024, swz = sb ^ (((sb >> 9) & 1) << 5); R = (st >> 1) * 16 + swz / 64; C = (st & 1) * 32 + (swz % 64) / 2; }
__host__ __device__ __forceinline__ int perm32(int rho) { const int n = rho >> 4, i = rho & 15; return 8 * (i >> 2) + 4 * n + (i & 3); }
struct Unit { int pm, pn; };
struct Gemm { const bf16_t* A; const bf16_t* Bt; int M, N, K; };
struct StaticOrder {
    int nM, nN, nwg, G, c;
    __host__ __device__ void init(int M, int N, int G_, int c_) { nM = M / BM; nN = N / BM; nwg = nM * nN; G = G_; c = c_; }
    __host__ __device__ bool next(int i, Unit& u) const {
        const long L = (long)i * G + c; if (L >= nwg) return false;
        int wgid = (int)L; { const int q = nwg / NXCD, r = nwg % NXCD, xcd = wgid % NXCD, off = wgid / NXCD; wgid = (xcd < r ? xcd * (q + 1) : r * (q + 1) + (xcd - r) * q) + off; }
        const int nig = WGM * nN, gid = wgid / nig, fm = gid * WGM, gsz = (nM - fm) < WGM ? (nM - fm) : WGM;
        u.pm = fm + ((wgid % nig) % gsz); u.pn = (wgid % nig) / gsz; return true;
    }
};
template <class F> struct EpiG {
    static constexpr bool PERM = true;
    F f;
    __device__ __forceinline__ void operator()(const f32x4 (&acc)[2][2][4][2], const Unit& u, int wr, int wc, int fr, int fq) const {
        const int row0 = u.pm * BM + wr * 64 + fr, col0 = u.pn * BM + wc * 32 + 8 * fq;
#pragma unroll
        for (int ai = 0; ai < 2; ++ai)
#pragma unroll
            for (int m = 0; m < 4; ++m)
#pragma unroll
                for (int bj = 0; bj < 2; ++bj) f(row0 + ai * HALF + m * 16, col0 + bj * HALF, acc[ai][bj][m][0], acc[ai][bj][m][1]);
    }
};

template <class Epi>
__device__ __forceinline__ void gemm_phase(PG8_LAS unsigned char* lds, const Gemm g, const StaticOrder& S, const Epi& E) {
    const int tid = threadIdx.x, wid = __builtin_amdgcn_readfirstlane(tid >> 6), lane = tid & 63, wr = wid >> 2, wc = wid & 3, fr = lane & 15, fq = lane >> 4;
    const int K = g.K, nt = K / BK;
    unsigned voffA[2], voffB[2];
#pragma unroll
    for (int i = 0; i < 2; ++i) { int R, C; stage_rc(tid * 16 + i * 8192, R, C); const int Rb = Epi::PERM ? ((R & ~31) + perm32(R & 31)) : R;
        voffA[i] = (unsigned)(R * K + C) * 2u; voffB[i] = (unsigned)(Rb * K + C) * 2u; }
    const size_t kstep = (size_t)(BK * 2);
    const size_t hstep = (size_t)HALF * K * 2;
    const size_t tstep = 2 * hstep;
    const unsigned ldsw = (unsigned)wid * 1024u;
    const int aoff = lds_byte(wr * 64 + fr, fq * 8), boff = lds_byte(wc * 32 + fr, fq * 8);
#define PG8_SA(b, h) (((b) * 2 + (h)) * HTB)
#define PG8_SB(b, h) ((4 + (b) * 2 + (h)) * HTB)
#define PG8_STAGE(bufoff, gbase, voff) do { _Pragma("unroll") for (int _i = 0; _i < 2; ++_i) \
        __builtin_amdgcn_global_load_lds((const unsigned*)((const char*)(gbase) + (voff)[_i]), (PG8_LAS unsigned*)(lds + (bufoff) + ldsw + _i * 8192), 16, 0, 0); } while (0)
#define PG8_LDA(dst, b, h) do { _Pragma("unroll") for (int m = 0; m < 4; ++m) _Pragma("unroll") for (int k = 0; k < 2; ++k) dst[m][k] = *(const PG8_LAS bf16x8*)(lds + PG8_SA(b, h) + aoff + m * 2048 + k * 1024); } while (0)
#define PG8_LDB(dst, b, h) do { _Pragma("unroll") for (int n = 0; n < 2; ++n) _Pragma("unroll") for (int k = 0; k < 2; ++k) dst[n][k] = *(const PG8_LAS bf16x8*)(lds + PG8_SB(b, h) + boff + n * 2048 + k * 1024); } while (0)
#define PG8_MMA(ai, bj, At, Bt) do { __builtin_amdgcn_s_setprio(1); _Pragma("unroll") for (int m = 0; m < 4; ++m) _Pragma("unroll") for (int n = 0; n < 2; ++n) _Pragma("unroll") for (int k = 0; k < 2; ++k) \
        acc[ai][bj][m][n] = __builtin_amdgcn_mfma_f32_16x16x32_bf16(Bt[n][k], At[m][k], acc[ai][bj][m][n], 0, 0, 0); __builtin_amdgcn_s_setprio(0); } while (0)
#define PG8_WAIT_V(n) asm volatile("s_waitcnt vmcnt(" #n ")" ::: "memory")
#define PG8_WAIT_L(n) asm volatile("s_waitcnt lgkmcnt(" #n ")" ::: "memory")
#define PG8_BAR __builtin_amdgcn_s_barrier()
#define PG8_SCHED __builtin_amdgcn_sched_barrier(0)
    Unit cur, nxt; int ui = 0;
    if (!S.next(0, cur)) return;
    f32x4 acc[2][2][4][2];
#pragma unroll
    for (int a = 0; a < 2; ++a)
#pragma unroll
        for (int b = 0; b < 2; ++b)
#pragma unroll
            for (int m = 0; m < 4; ++m)
#pragma unroll
                for (int n = 0; n < 2; ++n) acc[a][b][m][n] = (f32x4){0.f, 0.f, 0.f, 0.f};
    bf16x8 At[4][2], B0[2][2], B1[2][2];
    const char* cA = (const char*)g.A + (size_t)cur.pm * tstep; const char* cB = (const char*)g.Bt + (size_t)cur.pn * tstep;
    PG8_STAGE(PG8_SB(0, 0), cB, voffB); PG8_STAGE(PG8_SA(0, 0), cA, voffA); PG8_STAGE(PG8_SB(0, 1), cB + hstep, voffB); PG8_STAGE(PG8_SA(0, 1), cA + hstep, voffA);
    if (wr == 1) PG8_BAR;
    PG8_WAIT_V(4); PG8_BAR;
    PG8_STAGE(PG8_SB(1, 0), cB + kstep, voffB); PG8_STAGE(PG8_SA(1, 0), cA + kstep, voffA); PG8_STAGE(PG8_SB(1, 1), cB + hstep + kstep, voffB);
    PG8_WAIT_V(6); PG8_BAR;
    for (;;) {
        const bool has_next = S.next(ui + 1, nxt);
        const char* nA = has_next ? (const char*)g.A + (size_t)nxt.pm * tstep : cA; const char* nB = has_next ? (const char*)g.Bt + (size_t)nxt.pn * tstep : cB;
        for (int t = 0; t < nt; t += 2) {
            const bool last = (t == nt - 2);
            const char* a1 = cA + (size_t)(t + 1) * kstep;
            const char* a2 = last ? nA : cA + (size_t)(t + 2) * kstep; const char* b2 = last ? nB : cB + (size_t)(t + 2) * kstep;
            const char* a3 = a2 + kstep; const char* b3 = b2 + kstep;
            PG8_LDB(B0, 0, 0); PG8_SCHED; PG8_LDA(At, 0, 0); PG8_STAGE(PG8_SA(1, 1), a1 + hstep, voffA);
            PG8_WAIT_L(8); PG8_BAR; PG8_WAIT_L(0); PG8_MMA(0, 0, At, B0); PG8_BAR; PG8_SCHED;
            PG8_LDB(B1, 0, 1); PG8_STAGE(PG8_SB(0, 0), b2, voffB);
            PG8_BAR; PG8_WAIT_L(0); PG8_MMA(0, 1, At, B1); PG8_BAR;
            PG8_LDA(At, 0, 1); PG8_STAGE(PG8_SA(0, 0), a2, voffA);
            PG8_BAR; PG8_WAIT_L(0); PG8_MMA(1, 0, At, B0); PG8_BAR; PG8_SCHED;
            PG8_STAGE(PG8_SB(0, 1), b2 + hstep, voffB);
            PG8_WAIT_V(6); PG8_BAR; PG8_MMA(1, 1, At, B1); PG8_BAR;
            PG8_LDB(B0, 1, 0); PG8_SCHED; PG8_LDA(At, 1, 0); PG8_STAGE(PG8_SA(0, 1), a2 + hstep, voffA);
            PG8_WAIT_L(8); PG8_BAR; PG8_WAIT_L(0); PG8_MMA(0, 0, At, B0); PG8_BAR; PG8_SCHED;
            PG8_LDB(B1, 1, 1); PG8_STAGE(PG8_SB(1, 0), b3, voffB);
            PG8_BAR; PG8_WAIT_L(0); PG8_MMA(0, 1, At, B1); PG8_BAR;
            PG8_LDA(At, 1, 1); PG8_STAGE(PG8_SA(1, 0), a3, voffA);
            PG8_BAR; PG8_WAIT_L(0); PG8_MMA(1, 0, At, B0); PG8_BAR; PG8_SCHED;
            PG8_STAGE(PG8_SB(1, 1), b3 + hstep, voffB);
            PG8_WAIT_V(6); PG8_BAR; PG8_MMA(1, 1, At, B1); PG8_BAR;
        }
        E(acc, cur, wr, wc, fr, fq);
        if (!has_next) break;
#pragma unroll
        for (int a = 0; a < 2; ++a)
#pragma unroll
            for (int b = 0; b < 2; ++b)
#pragma unroll
                for (int m = 0; m < 4; ++m)
#pragma unroll
                    for (int n = 0; n < 2; ++n) acc[a][b][m][n] = (f32x4){0.f, 0.f, 0.f, 0.f};
        cur = nxt; cA = nA; cB = nB; ++ui;
    }
    PG8_WAIT_V(0);
    if (wr == 0) PG8_BAR;
    PG8_BAR;
#undef PG8_SA
#undef PG8_SB
#undef PG8_STAGE
#undef PG8_LDA
#undef PG8_LDB
#undef PG8_MMA
#undef PG8_WAIT_V
#undef PG8_WAIT_L
#undef PG8_BAR
#undef PG8_SCHED
}
}

__device__ __forceinline__ void store8bf(u16* dst, f32x4 v0, f32x4 v1) { u32x4 w; w.x = pk2(v0[0], v0[1]); w.y = pk2(v0[2], v0[3]); w.z = pk2(v1[0], v1[1]); w.w = pk2(v1[2], v1[3]); *(u32x4*)dst = w; }
struct F1 { u16 *XR, *XM, *Y0;
    __device__ __forceinline__ void operator()(int row, int col, f32x4 v0, f32x4 v1) const {
        const int reg = col >> 11, cc = col & 2047;
        u16* dst = reg == 0 ? XR + (size_t)row * 2048 + cc : reg == 1 ? Y0 + (size_t)row * 4096 + cc : reg == 2 ? XM + (size_t)row * 2048 + cc : Y0 + (size_t)row * 4096 + 2048 + cc;
        store8bf(dst, v0, v1); } };
struct F2 { float* C;
    __device__ __forceinline__ void operator()(int row, int col, f32x4 v0, f32x4 v1) const { float* d = C + (size_t)row * 2048 + col; *(f32x4*)d = v0; *(f32x4*)(d + 4) = v1; } };
struct F3 { u16 *RKV, *P;
    __device__ __forceinline__ void operator()(int row, int col, f32x4 v0, f32x4 v1) const {
        if (col < 12288) { const int reg = col >> 12, cc = col & 4095; store8bf(RKV + (size_t)reg * ((size_t)NTOK * 4096) + (size_t)row * 4096 + cc, v0, v1); }
        else { const int cc = col - 12288; if (cc < 384) store8bf(P + (size_t)row * 384 + cc, v0, v1); } } };
struct F4 { u16* R;
    __device__ __forceinline__ void operator()(int row, int col, f32x4 v0, f32x4 v1) const {
        u16* d = R + (size_t)row * 4096 + col; const u32x4 w = *(const u32x4*)d; float y[8]; unpack8(w, y);
        f32x4 o0, o1;
#pragma unroll
        for (int j = 0; j < 4; ++j) { o0[j] = y[j] * siluf_(v0[j]); o1[j] = y[4 + j] * siluf_(v1[j]); }
        store8bf(d, o0, o1); } };

__device__ void tconv(unsigned char* smem, const float* src, int ldsrc, int col0, int N, int K, u16* dst, int ldd) {
    float* T = (float*)smem;
    const int tid = threadIdx.x, tilesN = N >> 6, ntile = tilesN * (K >> 6);
    for (int tile = blockIdx.x; tile < ntile; tile += gridDim.x) {
        const int tn = tile % tilesN, tk = tile / tilesN;
#pragma unroll
        for (int i = 0; i < 8; ++i) { const int r = i * 8 + (tid >> 6), c = tid & 63; T[r * 65 + c] = src[(size_t)(tk * 64 + r) * ldsrc + col0 + tn * 64 + c]; }
        __syncthreads();
#pragma unroll
        for (int i = 0; i < 4; ++i) { const int n = (tid >> 5) + 16 * i, kk = (tid & 31) * 2;
            *(unsigned*)(dst + (size_t)(tn * 64 + n) * ldd + tk * 64 + kk) = pk2(T[kk * 65 + n], T[(kk + 1) * 65 + n]); }
        __syncthreads();
    }
}

template <int MODE> __device__ void rows_phase(const Params& p) {
    const int lane = threadIdx.x & 63, gw = blockIdx.x * 8 + (threadIdx.x >> 6), nw = gridDim.x * 8;
    const float* x = p.in[0];
    for (int row = gw; row < NTOK; row += nw) {
        if (MODE == 0) {
            f32x4 v[8]; float ss = 0.f;
#pragma unroll
            for (int i = 0; i < 8; ++i) { v[i] = *(const f32x4*)(x + (size_t)row * DM + i * 256 + lane * 4); ss += v[i][0] * v[i][0] + v[i][1] * v[i][1] + v[i][2] * v[i][2] + v[i][3] * v[i][3]; }
            ss = wave_sum(ss); const float r = rsqrtf(ss * (1.0f / DM) + 1e-6f);
            u16* H = (u16*)(p.ws + OFF_H);
#pragma unroll
            for (int i = 0; i < 8; ++i) { const int c = i * 256 + lane * 4; const f32x4 g = *(const f32x4*)(p.in[1] + c);
                u32x2 w; w.x = pk2(v[i][0] * r * g[0], v[i][1] * r * g[1]); w.y = pk2(v[i][2] * r * g[2], v[i][3] * r * g[3]); *(u32x2*)(H + (size_t)row * DM + c) = w; }
        } else {
            const float* Mx = (const float*)(p.ws + (MODE == 1 ? OFF_M0 : OFF_M1));
            const float* base = MODE == 1 ? x : p.out;
            const float* gpost = p.in[MODE == 1 ? 22 : 40];
            f32x4 m[8]; float ss = 0.f;
#pragma unroll
            for (int i = 0; i < 8; ++i) { m[i] = *(const f32x4*)(Mx + (size_t)row * DM + i * 256 + lane * 4); ss += m[i][0] * m[i][0] + m[i][1] * m[i][1] + m[i][2] * m[i][2] + m[i][3] * m[i][3]; }
            ss = wave_sum(ss); const float r = rsqrtf(ss * (1.0f / DM) + 1e-6f);
            float ss1 = 0.f;
#pragma unroll
            for (int i = 0; i < 8; ++i) { const int c = i * 256 + lane * 4; const f32x4 g = *(const f32x4*)(gpost + c); const f32x4 b = *(const f32x4*)(base + (size_t)row * DM + c);
                m[i] = b + m[i] * r * g; ss1 += m[i][0] * m[i][0] + m[i][1] * m[i][1] + m[i][2] * m[i][2] + m[i][3] * m[i][3];
                *(f32x4*)(p.out + (size_t)row * DM + c) = m[i]; }
            if (MODE == 1) {
                ss1 = wave_sum(ss1); const float r1 = rsqrtf(ss1 * (1.0f / DM) + 1e-6f);
                u16* H = (u16*)(p.ws + OFF_H);
#pragma unroll
                for (int i = 0; i < 8; ++i) { const int c = i * 256 + lane * 4; const f32x4 g = *(const f32x4*)(p.in[23] + c);
                    u32x2 w; w.x = pk2(m[i][0] * r1 * g[0], m[i][1] * r1 * g[1]); w.y = pk2(m[i][2] * r1 * g[2], m[i][3] * r1 * g[3]); *(u32x2*)(H + (size_t)row * DM + c) = w; }
            }
        }
    }
}

__device__ void prep_small(const Params& p) {
    const int gt = blockIdx.x * 512 + threadIdx.x, nt = gridDim.x * 512;
    u16* LW = (u16*)(p.ws + OFF_LRUW);
    for (int e = gt; e < 2 * 16 * 128 * 128; e += nt) { const int i = e & 127, j = (e >> 7) & 127, blk = (e >> 14) & 15, g = e >> 18;
        LW[e] = f2bf(p.in[g ? 7 : 5][(size_t)(blk * 128 + i) * 128 + j]); }
    u16* WG = (u16*)(p.ws + OFF_WGT);
    for (int e = gt; e < 16 * 6144; e += nt) { const int c = e % 6144, n = e / 6144; WG[e] = f2bf(n < 8 ? p.in[15][c * 8 + n] : p.in[17][c * 8 + n - 8]); }
}
__device__ void prep_extras(const Params& p) {
    const int gt = blockIdx.x * 512 + threadIdx.x, nt = gridDim.x * 512;
    u16* W = (u16*)(p.ws + OFF_W1) + (size_t)12288 * 2048;
    for (int e = gt; e < 512 * 2048; e += nt) { const int k = e & 2047, n = e >> 11; float v = 0.f;
        if (n < 96) v = (1.f - p.in[26][k]) * p.in[29][k * 96 + n];
        else if (n < 192) v = p.in[26][k] * p.in[29][k * 96 + n - 96];
        else if (n < 288) v = (1.f - p.in[27][k]) * p.in[32][k * 96 + n - 192];
        else if (n < 384) v = p.in[27][k] * p.in[32][k * 96 + n - 288];
        W[e] = f2bf(v); }
}

template <int PASS> __device__ void lru_phase(const Params& p, unsigned char* smem) {
    float* xcf = (float*)smem;
    float* As = xcf + 64 * 132;
    float* Us = As + 64 * 132;
    float* qA = Us + 64 * 132;
    float* qH = qA + 512;
    const int tid = threadIdx.x, lane = tid & 63, wave = __builtin_amdgcn_readfirstlane(tid >> 6);
    const u16* XR = (const u16*)(p.ws + OFF_XR);
    u16* Y0 = (u16*)(p.ws + OFF_Y0);
    const u16* LW = (const u16*)(p.ws + OFF_LRUW);
    float* LA = (float*)(p.ws + OFF_LRUA); float* LH = (float*)(p.ws + OFF_LRUH); const float* LC = (const float*)(p.ws + OFF_LRUC);
    const float* cw = p.in[3]; const float* cb = p.in[4];
    for (int tile = blockIdx.x; tile < 4096; tile += gridDim.x) {
        const int jb = tile & 15, c = (tile >> 4) & 63, b = tile >> 10;
        const int row0 = b * SEQL + c * 64;
#pragma unroll
        for (int it = 0; it < 2; ++it) {
            const int t = (tid >> 4) + 32 * it, c8 = (tid & 15) * 8, ch = jb * 128 + c8;
            float acc[8];
            { const f32x4 b0 = *(const f32x4*)(cb + ch), b1 = *(const f32x4*)(cb + ch + 4);
#pragma unroll
              for (int i = 0; i < 4; ++i) { acc[i] = b0[i]; acc[4 + i] = b1[i]; } }
#pragma unroll
            for (int j = 0; j < 4; ++j) { const int s = c * 64 + t - 3 + j;
                if (s >= 0) { const u32x4 raw = *(const u32x4*)(XR + (size_t)(b * SEQL + s) * 2048 + ch); float xv[8]; unpack8(raw, xv);
                    const f32x4 w0 = *(const f32x4*)(cw + j * 2048 + ch), w1 = *(const f32x4*)(cw + j * 2048 + ch + 4);
#pragma unroll
                    for (int i = 0; i < 4; ++i) { acc[i] += w0[i] * xv[i]; acc[4 + i] += w1[i] * xv[4 + i]; } } }
            *(f32x4*)(xcf + t * 132 + c8) = (f32x4){acc[0], acc[1], acc[2], acc[3]}; *(f32x4*)(xcf + t * 132 + c8 + 4) = (f32x4){acc[4], acc[5], acc[6], acc[7]};
        }
        __syncthreads();
        f32x4 accA[4], accX[4];
#pragma unroll
        for (int m = 0; m < 4; ++m) { accA[m] = (f32x4){0.f, 0.f, 0.f, 0.f}; accX[m] = (f32x4){0.f, 0.f, 0.f, 0.f}; }
#pragma unroll
        for (int ks = 0; ks < 4; ++ks) {
            const size_t wo = (size_t)((jb * 128 + 16 * wave + (lane & 15)) * 128 + ks * 32 + 8 * (lane >> 4));
            const bf16x8 ba = *(const bf16x8*)(LW + wo), bx = *(const bf16x8*)(LW + (size_t)16 * 128 * 128 + wo);
#pragma unroll
            for (int m = 0; m < 4; ++m) { const float* s = xcf + (16 * m + (lane & 15)) * 132 + ks * 32 + 8 * (lane >> 4);
                const f32x4 lo = *(const f32x4*)s, hi = *(const f32x4*)(s + 4); float f[8] = {lo[0], lo[1], lo[2], lo[3], hi[0], hi[1], hi[2], hi[3]};
                const bf16x8 af = as_frag(pack8(f));
                accA[m] = MFMA16(af, ba, accA[m]); accX[m] = MFMA16(af, bx, accX[m]); }
        }
        {
            const int ch = 16 * wave + (lane & 15), cgl = jb * 128 + ch;
            const float ba_ = p.in[6][cgl], bx_ = p.in[8][cgl], sp = softplusf_(-p.in[9][cgl]);
#pragma unroll
            for (int m = 0; m < 4; ++m)
#pragma unroll
                for (int r = 0; r < 4; ++r) { const int t = 16 * m + 4 * (lane >> 4) + r;
                    const float rg = sigmoidf_(accA[m][r] + ba_), ig = sigmoidf_(accX[m][r] + bx_);
                    const float la = -8.0f * rg * sp, a = __expf(la), u = sqrtf(-expm1f(2.0f * la)) * (ig * xcf[t * 132 + ch]);
                    As[t * 132 + ch] = a; Us[t * 132 + ch] = u; }
        }
        __syncthreads();
        const int ch = tid & 127, q = tid >> 7, cgl = jb * 128 + ch;
        { float h = 0.f, A = 1.f;
#pragma unroll
          for (int tt = 0; tt < 16; ++tt) { const int t = q * 16 + tt; const float a = As[t * 132 + ch], u = Us[t * 132 + ch]; h = a * h + u; A *= a;
              if (PASS == 2) { Us[t * 132 + ch] = h; As[t * 132 + ch] = A; } }
          qA[q * 128 + ch] = A; qH[q * 128 + ch] = h; }
        __syncthreads();
        if (PASS == 1) {
            if (q == 0) { float h = 0.f, A = 1.f;
#pragma unroll
                for (int qq = 0; qq < 4; ++qq) { h = qA[qq * 128 + ch] * h + qH[qq * 128 + ch]; A *= qA[qq * 128 + ch]; }
                LA[(size_t)(b * 64 + c) * 2048 + cgl] = A; LH[(size_t)(b * 64 + c) * 2048 + cgl] = h; }
        } else {
            float carry = LC[(size_t)(b * 64 + c) * 2048 + cgl];
            for (int qq = 0; qq < q; ++qq) carry = qA[qq * 128 + ch] * carry + qH[qq * 128 + ch];
#pragma unroll 4
            for (int tt = 0; tt < 16; ++tt) { const int t = q * 16 + tt; const float hh = Us[t * 132 + ch] + As[t * 132 + ch] * carry;
                u16* d = Y0 + (size_t)(row0 + t) * 4096 + cgl; *d = f2bf(hh * siluf_(bf2f(*d))); }
        }
        __syncthreads();
    }
}
__device__ void lru_carry(const Params& p) {
    const float* LA = (const float*)(p.ws + OFF_LRUA); const float* LH = (const float*)(p.ws + OFF_LRUH); float* LC = (float*)(p.ws + OFF_LRUC);
    for (int idx = blockIdx.x * 512 + threadIdx.x; idx < 4 * 2048; idx += gridDim.x * 512) { const int b = idx >> 11, cg_ = idx & 2047; float c = 0.f;
#pragma unroll 8
        for (int k = 0; k < 64; ++k) { const size_t o = (size_t)(b * 64 + k) * 2048 + cg_; LC[o] = c; c = LA[o] * c + LH[o]; } }
}

__device__ void mqk_phase(const Params& p, unsigned char* smem) {
    float* red = (float*)smem;
    const int tid = threadIdx.x, lane = tid & 63, wave = __builtin_amdgcn_readfirstlane(tid >> 6);
    const u16* XM = (const u16*)(p.ws + OFF_XM); u16* Q = (u16*)(p.ws + OFF_Q); u16* KX = (u16*)(p.ws + OFF_KX);
    const u16* WG = (const u16*)(p.ws + OFF_WGT); float* G = (float*)(p.ws + OFF_G);
    for (int tile = blockIdx.x; tile < 256; tile += gridDim.x) {
        const int row0 = tile * 64;
        f32x4 acc[4];
#pragma unroll
        for (int m = 0; m < 4; ++m) acc[m] = (f32x4){0.f, 0.f, 0.f, 0.f};
        for (int ks = 0; ks < 8; ++ks) {
            const int c0 = 256 * wave + 32 * ks + 8 * (lane >> 4);
            float cw[4][8], cbv[8];
#pragma unroll
            for (int j = 0; j < 4; ++j) { const f32x4 a = *(const f32x4*)(p.in[10] + j * 2048 + c0), b = *(const f32x4*)(p.in[10] + j * 2048 + c0 + 4);
#pragma unroll
                for (int i = 0; i < 4; ++i) { cw[j][i] = a[i]; cw[j][4 + i] = b[i]; } }
            { const f32x4 a = *(const f32x4*)(p.in[11] + c0), b = *(const f32x4*)(p.in[11] + c0 + 4);
#pragma unroll
              for (int i = 0; i < 4; ++i) { cbv[i] = a[i]; cbv[4 + i] = b[i]; } }
            const bf16x8 bq = *(const bf16x8*)(WG + (size_t)(lane & 15) * 6144 + c0), bk = *(const bf16x8*)(WG + (size_t)(lane & 15) * 6144 + 2048 + c0), bv = *(const bf16x8*)(WG + (size_t)(lane & 15) * 6144 + 4096 + c0);
            const float* wqp = p.in[12] + (size_t)(c0 >> 2) * 16; const float* wkp = p.in[13] + (size_t)(c0 >> 2) * 16; const float* wvp = p.in[14] + (size_t)(c0 >> 2) * 16;
#pragma unroll 1
            for (int m = 0; m < 4; ++m) {
                const int tk = row0 + 16 * m + (lane & 15), s = tk & (SEQL - 1);
                float xmc[8], xcur[8];
#pragma unroll
                for (int i = 0; i < 8; ++i) xmc[i] = cbv[i];
#pragma unroll
                for (int j = 0; j < 4; ++j) { float xv[8];
                    if (s - 3 + j >= 0) { const u32x4 raw = *(const u32x4*)(XM + (size_t)(tk - 3 + j) * 2048 + c0); unpack8(raw, xv); }
                    else {
#pragma unroll
                        for (int i = 0; i < 8; ++i) xv[i] = 0.f; }
#pragma unroll
                    for (int i = 0; i < 8; ++i) { xmc[i] += cw[j][i] * xv[i]; if (j == 3) xcur[i] = xv[i]; } }
#pragma unroll
                for (int i = 0; i < 8; ++i) xmc[i] = siluf_(xmc[i]);
                float qv[8], kv[8], vv[8];
#pragma unroll
                for (int bb = 0; bb < 2; ++bb)
#pragma unroll
                    for (int jj = 0; jj < 4; ++jj) { float aq = 0.f, ak = 0.f, av = 0.f;
#pragma unroll
                        for (int ii = 0; ii < 4; ++ii) { aq += xmc[4 * bb + ii] * wqp[bb * 16 + ii * 4 + jj]; ak += xmc[4 * bb + ii] * wkp[bb * 16 + ii * 4 + jj]; av += xcur[4 * bb + ii] * wvp[bb * 16 + ii * 4 + jj]; }
                        qv[4 * bb + jj] = aq; kv[4 * bb + jj] = ak; vv[4 * bb + jj] = av; }
                const u32x4 qw = pack8(qv), kw = pack8(kv), vw = pack8(vv);
                acc[m] = MFMA16(as_frag(qw), bq, acc[m]); acc[m] = MFMA16(as_frag(kw), bk, acc[m]); acc[m] = MFMA16(as_frag(vw), bv, acc[m]);
#pragma unroll
                for (int i = 0; i < 8; ++i) kv[i] *= 0.0625f;
                *(u32x4*)(Q + (size_t)tk * 2048 + c0) = qw; *(u32x4*)(KX + (size_t)tk * 2048 + c0) = pack8(kv);
            }
        }
#pragma unroll
        for (int m = 0; m < 4; ++m)
#pragma unroll
            for (int r = 0; r < 4; ++r) red[(wave * 64 + 16 * m + 4 * (lane >> 4) + r) * 16 + (lane & 15)] = acc[m][r];
        __syncthreads();
        for (int e = tid; e < 1024; e += 512) { const int tok = e >> 4, n = e & 15; float s = (n < 8) ? p.in[16][n] : p.in[18][n - 8];
#pragma unroll
            for (int w = 0; w < 8; ++w) s += red[(w * 64 + tok) * 16 + n];
            G[(size_t)(row0 + tok) * 16 + n] = s; }
        __syncthreads();
    }
}

__device__ void mlstm_phase(const Params& p, unsigned char* smem) {
    u16* Ks = (u16*)smem;
    u16* Vt = Ks + 128 * 264;
    u16* Vwt = Vt + 48 * 136;
    u16* Ps = Vwt + 48 * 136;
    u16* Ct = Ps + 128 * 136;
    float* gc = (float*)(Ct + 48 * 264);
    float* gM = gc + 128; float* gE = gM + 128; float* gF = gE + 128; float* gW = gF + 128; float* gS = gW + 128;
    const int tid = threadIdx.x, lane = tid & 63, wave = __builtin_amdgcn_readfirstlane(tid >> 6);
    const int l15 = lane & 15, lq = lane >> 4;
    const u16* XM = (const u16*)(p.ws + OFF_XM); const u16* Q = (const u16*)(p.ws + OFF_Q); const u16* KX = (const u16*)(p.ws + OFF_KX);
    const float* G = (const float*)(p.ws + OFF_G); u16* Hm = (u16*)(p.ws + OFF_H);
    for (int unit = blockIdx.x; unit < 256; unit += gridDim.x) {
        const int sl = unit & 7, h = (unit >> 3) & 7, b = unit >> 6;
        f32x4 accC[3][2];
#pragma unroll
        for (int a = 0; a < 3; ++a)
#pragma unroll
            for (int c = 0; c < 2; ++c) accC[a][c] = (f32x4){0.f, 0.f, 0.f, 0.f};
        float m_prev = 0.f;
        for (int e = tid; e < 16 * 136; e += 512) { const int r = e / 136; Vt[32 * 136 + e] = (r == 0) ? (u16)0x3F80 : (u16)0; Vwt[32 * 136 + e] = 0; }
        for (int e = tid; e < 48 * 264; e += 512) Ct[e] = 0;
        const int vc = 256 * h + 32 * sl + 4 * (tid & 7);
        float wv[16];
#pragma unroll
        for (int i = 0; i < 16; ++i) wv[i] = p.in[14][(size_t)(vc >> 2) * 16 + i];
        __syncthreads();
        for (int chunk = 0; chunk < 32; ++chunk) {
            const int row0 = b * SEQL + chunk * 128;
#pragma unroll
            for (int i = 0; i < 8; ++i) { const int idx = tid + 512 * i, r = idx >> 5, cc = (idx & 31) * 8;
                *(u32x4*)(Ks + r * 264 + cc) = *(const u32x4*)(KX + (size_t)(row0 + r) * 2048 + 256 * h + cc); }
            bf16x8 qf[8];
#pragma unroll
            for (int ks = 0; ks < 8; ++ks) qf[ks] = *(const bf16x8*)(Q + (size_t)(row0 + 16 * wave + l15) * 2048 + 256 * h + 32 * ks + 8 * lq);
            float vv[2][4];
#pragma unroll
            for (int i = 0; i < 2; ++i) { const int t = (tid + 512 * i) >> 3; const u32x2 raw = *(const u32x2*)(XM + (size_t)(row0 + t) * 2048 + vc);
                const float x0 = bflo(raw.x), x1 = bfhi(raw.x), x2 = bflo(raw.y), x3 = bfhi(raw.y);
#pragma unroll
                for (int jj = 0; jj < 4; ++jj) vv[i][jj] = x0 * wv[jj] + x1 * wv[4 + jj] + x2 * wv[8 + jj] + x3 * wv[12 + jj]; }
            if (wave == 0) {
                const int t0 = 2 * lane;
                const float ig0 = G[(size_t)(row0 + t0) * 16 + h], fg0 = G[(size_t)(row0 + t0) * 16 + 8 + h];
                const float ig1 = G[(size_t)(row0 + t0 + 1) * 16 + h], fg1 = G[(size_t)(row0 + t0 + 1) * 16 + 8 + h];
                const float lf0 = -softplusf_(-fg0), lf1 = -softplusf_(-fg1);
                float s = lf0 + lf1;
#pragma unroll
                for (int d = 1; d < 64; d <<= 1) { const float o = __shfl_up(s, d); if (lane >= d) s += o; }
                const float b1 = s, b0 = s - lf1;
                const float c0 = ig0 - b0, c1 = ig1 - b1;
                float mx = fmaxf(c0, c1);
#pragma unroll
                for (int d = 1; d < 64; d <<= 1) { const float o = __shfl_up(mx, d); if (lane >= d) mx = fmaxf(mx, o); }
                float pm = __shfl_up(mx, 1); if (lane == 0) pm = -3.0e38f;
                const float M0 = fmaxf(fmaxf(pm, c0), m_prev), M1 = fmaxf(mx, m_prev);
                const float Ml = __shfl(M1, 63), bL = __shfl(b1, 63);
                gc[t0] = c0; gc[t0 + 1] = c1; gM[t0] = M0; gM[t0 + 1] = M1;
                gE[t0] = __expf(m_prev - M0); gE[t0 + 1] = __expf(m_prev - M1);
                gF[t0] = __expf(-(b0 + M0)); gF[t0 + 1] = __expf(-(b1 + M1));
                gW[t0] = __expf(c0 - Ml); gW[t0 + 1] = __expf(c1 - Ml);
                if (lane == 0) gS[0] = __expf(m_prev - Ml);
                m_prev = bL + Ml;
            }
            __syncthreads();
#pragma unroll
            for (int i = 0; i < 2; ++i) { const int t = (tid + 512 * i) >> 3; const float w = gW[t];
#pragma unroll
                for (int jj = 0; jj < 4; ++jj) { const int dv = 4 * (tid & 7) + jj; Vt[dv * 136 + t] = f2bf(vv[i][jj]); Vwt[dv * 136 + t] = f2bf(vv[i][jj] * w); } }
            if (tid < 128) Vwt[32 * 136 + tid] = f2bf(gW[tid]);
            f32x4 accS[8];
#pragma unroll
            for (int n = 0; n < 8; ++n) { accS[n] = (f32x4){0.f, 0.f, 0.f, 0.f};
                if (n <= wave) {
#pragma unroll
                    for (int ks = 0; ks < 8; ++ks) { const bf16x8 kf = *(const bf16x8*)(Ks + (16 * n + l15) * 264 + 32 * ks + 8 * lq); accS[n] = MFMA16(qf[ks], kf, accS[n]); } } }
#pragma unroll
            for (int n = 0; n < 8; ++n) if (n <= (wave | 1)) { const int s = 16 * n + l15; const float cs = gc[s];
#pragma unroll
                for (int r = 0; r < 4; ++r) { const int t = 16 * wave + 4 * lq + r; const float val = (n <= wave && s <= t) ? accS[n][r] * __expf(cs - gM[t]) : 0.f; Ps[t * 136 + s] = f2bf(val); } }
            __syncthreads();
            f32x4 oi[3], oc[3];
#pragma unroll
            for (int nt = 0; nt < 3; ++nt) { oi[nt] = (f32x4){0.f, 0.f, 0.f, 0.f}; oc[nt] = (f32x4){0.f, 0.f, 0.f, 0.f}; }
#pragma unroll
            for (int kk = 0; kk < 4; ++kk) if (kk <= (wave >> 1)) { const bf16x8 pf = *(const bf16x8*)(Ps + (16 * wave + l15) * 136 + 32 * kk + 8 * lq);
#pragma unroll
                for (int nt = 0; nt < 3; ++nt) { const bf16x8 vf = *(const bf16x8*)(Vt + (16 * nt + l15) * 136 + 32 * kk + 8 * lq); oi[nt] = MFMA16(pf, vf, oi[nt]); } }
#pragma unroll
            for (int ks = 0; ks < 8; ++ks)
#pragma unroll
                for (int nt = 0; nt < 3; ++nt) { const bf16x8 cf = *(const bf16x8*)(Ct + (16 * nt + l15) * 264 + 32 * ks + 8 * lq); oc[nt] = MFMA16(qf[ks], cf, oc[nt]); }
#pragma unroll
            for (int r = 0; r < 4; ++r) { const int t = 16 * wave + 4 * lq + r; const float E = gE[t], F = gF[t];
                float den = oi[2][r] + E * oc[2][r]; den = __shfl(den, lane & 48);
                const float inv = 1.0f / fmaxf(fabsf(den), F);
#pragma unroll
                for (int nt = 0; nt < 2; ++nt) Hm[(size_t)(row0 + t) * 2048 + 256 * h + 32 * sl + 16 * nt + l15] = f2bf((oi[nt][r] + E * oc[nt][r]) * inv); }
            { const float decay = gS[0];
#pragma unroll
              for (int a = 0; a < 3; ++a)
#pragma unroll
                for (int c = 0; c < 2; ++c) accC[a][c] = accC[a][c] * decay; }
#pragma unroll
            for (int kk = 0; kk < 4; ++kk) {
                bf16x8 ktf[2];
#pragma unroll
                for (int ntk = 0; ntk < 2; ++ntk) { const int dk = 32 * wave + 16 * ntk + l15;
#pragma unroll
                    for (int j = 0; j < 8; ++j) ktf[ntk][j] = (short)Ks[(32 * kk + 8 * lq + j) * 264 + dk]; }
#pragma unroll
                for (int mt = 0; mt < 3; ++mt) { const bf16x8 vwf = *(const bf16x8*)(Vwt + (16 * mt + l15) * 136 + 32 * kk + 8 * lq);
#pragma unroll
                    for (int ntk = 0; ntk < 2; ++ntk) accC[mt][ntk] = MFMA16(vwf, ktf[ntk], accC[mt][ntk]); }
            }
            __syncthreads();
#pragma unroll
            for (int mt = 0; mt < 3; ++mt)
#pragma unroll
                for (int ntk = 0; ntk < 2; ++ntk)
#pragma unroll
                    for (int r = 0; r < 4; ++r) Ct[(16 * mt + 4 * lq + r) * 264 + 32 * wave + 16 * ntk + l15] = f2bf(accC[mt][ntk][r]);
        }
        __syncthreads();
    }
}

__device__ void mnorm_phase(const Params& p) {
    const int lane = threadIdx.x & 63, wave = threadIdx.x >> 6;
    const u16* XM = (const u16*)(p.ws + OFF_XM); const u16* Hm = (const u16*)(p.ws + OFF_H); u16* Y0 = (u16*)(p.ws + OFF_Y0);
    const int c = 256 * wave + 4 * lane;
    float cw[4][4];
#pragma unroll
    for (int j = 0; j < 4; ++j) { const f32x4 a = *(const f32x4*)(p.in[10] + j * 2048 + c);
#pragma unroll
        for (int i = 0; i < 4; ++i) cw[j][i] = a[i]; }
    const f32x4 cbv = *(const f32x4*)(p.in[11] + c), skip = *(const f32x4*)(p.in[19] + c), gn = *(const f32x4*)(p.in[20] + c);
    for (int blk = blockIdx.x; blk < 256; blk += gridDim.x) {
#pragma unroll 2
        for (int tt = 0; tt < 64; ++tt) {
            const int tk = blk * 64 + tt, s = tk & (SEQL - 1);
            const u32x2 hr = *(const u32x2*)(Hm + (size_t)tk * 2048 + c);
            float hv[4] = {bflo(hr.x), bfhi(hr.x), bflo(hr.y), bfhi(hr.y)};
            const float mu = wave_sum(hv[0] + hv[1] + hv[2] + hv[3]) * (1.0f / 256.0f);
            float d[4], sq = 0.f;
#pragma unroll
            for (int i = 0; i < 4; ++i) { d[i] = hv[i] - mu; sq += d[i] * d[i]; }
            const float rs = rsqrtf(wave_sum(sq) * (1.0f / 256.0f) + 1e-6f);
            float xmc[4] = {cbv[0], cbv[1], cbv[2], cbv[3]};
#pragma unroll
            for (int j = 0; j < 4; ++j) if (s - 3 + j >= 0) { const u32x2 xr = *(const u32x2*)(XM + (size_t)(tk - 3 + j) * 2048 + c);
                xmc[0] += cw[j][0] * bflo(xr.x); xmc[1] += cw[j][1] * bfhi(xr.x); xmc[2] += cw[j][2] * bflo(xr.y); xmc[3] += cw[j][3] * bfhi(xr.y); }
            u16* zp = Y0 + (size_t)tk * 4096 + 2048 + c; const u32x2 zr = *(const u32x2*)zp;
            const float z[4] = {bflo(zr.x), bfhi(zr.x), bflo(zr.y), bfhi(zr.y)};
            float o[4];
#pragma unroll
            for (int i = 0; i < 4; ++i) o[i] = (d[i] * rs * gn[i] + skip[i] * siluf_(xmc[i])) * siluf_(z[i]);
            u32x2 w; w.x = pk2(o[0], o[1]); w.y = pk2(o[2], o[3]); *(u32x2*)zp = w;
        }
    }
}

__device__ void rwkv_phase(const Params& p, unsigned char* smem) {
    float* W2s = (float*)smem;
    float* A2s = W2s + 6144;
    float* vec = A2s + 6144;
    float* scal = vec + 32 * 384;
    float* Yraw = scal + 128;
    float* tw = Yraw + 2048;
    float* ta = tw + 3072;
    float* stash = ta + 3072;
    const int tid = threadIdx.x, lane = tid & 63, wave = __builtin_amdgcn_readfirstlane(tid >> 6);
    u16* R = (u16*)(p.ws + OFF_R); const u16* Kb = (const u16*)(p.ws + OFF_KK); const u16* Vb = (const u16*)(p.ws + OFF_V); const u16* P = (const u16*)(p.ws + OFF_P);
    for (int unit = blockIdx.x; unit < 256; unit += gridDim.x) {
        const int b = unit >> 6, h = unit & 63, hc = 64 * h;
        for (int e = tid; e < 6144; e += 512) { const int j = e >> 6, k = e & 63; W2s[e] = p.in[30][(size_t)j * 4096 + hc + k]; A2s[e] = p.in[33][(size_t)j * 4096 + hc + k]; }
        const int k = lane;
        const float mu_r = p.in[25][hc + k], mu_k = p.in[25][4096 + hc + k], mu_v = p.in[25][8192 + hc + k];
        const float w0k = p.in[28][hc + k], a0k = p.in[31][hc + k], kkk = p.in[34][hc + k], kak = p.in[35][hc + k], rkk = p.in[36][hc + k];
        const float gng = p.in[37][hc + k], gnb = p.in[38][hc + k];
        const int rowv = tid >> 3, j8 = tid & 7;
        float S[8];
#pragma unroll
        for (int i = 0; i < 8; ++i) S[i] = 0.f;
        __syncthreads();
        for (int chunk = 0; chunk < 128; ++chunk) {
            const int row0 = b * SEQL + chunk * 32;
            for (int e = tid; e < 32 * 96; e += 512) { const int t = e / 96, j = e - t * 96; const size_t row = (size_t)(row0 + t);
                const bool first = (chunk == 0 && t == 0);
                const float c1 = bf2f(P[row * 384 + j]), p1 = first ? 0.f : bf2f(P[(row - 1) * 384 + 96 + j]);
                const float c2 = bf2f(P[row * 384 + 192 + j]), p2 = first ? 0.f : bf2f(P[(row - 1) * 384 + 288 + j]);
                tw[e] = tanhf(c1 + p1); ta[e] = c2 + p2; }
            __syncthreads();
#pragma unroll 1
            for (int i = 0; i < 4; ++i) {
                const int t = wave + 8 * i; const size_t row = (size_t)(row0 + t);
                const float rr = bf2f(R[row * 4096 + hc + k]), kr_ = bf2f(Kb[row * 4096 + hc + k]), vr = bf2f(Vb[row * 4096 + hc + k]);
                float rp, kp, vp;
                if (chunk == 0 && t == 0) { rp = 0.f; kp = 0.f; vp = 0.f; }
                else { rp = (t == 0) ? stash[(chunk & 1) * 64 + k] : bf2f(R[(row - 1) * 4096 + hc + k]); kp = bf2f(Kb[(row - 1) * 4096 + hc + k]); vp = bf2f(Vb[(row - 1) * 4096 + hc + k]); }
                const float r = rr + (rp - rr) * mu_r, kx0 = kr_ + (kp - kr_) * mu_k, v = vr + (vp - vr) * mu_v;
                float wl = w0k, al = a0k;
#pragma unroll 8
                for (int j = 0; j < 96; ++j) { wl += tw[t * 96 + j] * W2s[j * 64 + k]; al += ta[t * 96 + j] * A2s[j * 64 + k]; }
                const float wlog = -softplusf_(-wl) - 0.5f, dec = __expf(-__expf(wlog)), a = sigmoidf_(al);
                const float kkv = kx0 * kkk, ss = wave_sum(kkv * kkv), kk = kkv / fmaxf(sqrtf(ss), 1e-12f);
                const float kmod = kx0 * (1.0f + (a - 1.0f) * kak);
                const float kb = kk * a;
                const float br = wave_sum(kb * r), krs = wave_sum(kmod * r), bon = wave_sum(r * kmod * rkk);
                float* vb = vec + t * 384;
                vb[k] = dec; vb[64 + k] = -kk; vb[128 + k] = kb; vb[192 + k] = kmod; vb[256 + k] = dec * r; vb[320 + k] = v;
                if (lane == 0) { scal[t * 4] = br; scal[t * 4 + 1] = krs; scal[t * 4 + 2] = bon; }
                if (t == 31) stash[((chunk + 1) & 1) * 64 + k] = rr;
            }
            __syncthreads();
#pragma unroll 2
            for (int t = 0; t < 32; ++t) {
                const float* vb = vec + t * 384 + 8 * j8;
                const f32x4 d0 = *(const f32x4*)vb, d1 = *(const f32x4*)(vb + 4), a0 = *(const f32x4*)(vb + 64), a1 = *(const f32x4*)(vb + 68);
                const f32x4 b0 = *(const f32x4*)(vb + 128), b1 = *(const f32x4*)(vb + 132), k0 = *(const f32x4*)(vb + 192), k1 = *(const f32x4*)(vb + 196);
                const f32x4 w0 = *(const f32x4*)(vb + 256), w1 = *(const f32x4*)(vb + 260);
                const float vv = vec[t * 384 + 320 + rowv]; const f32x2 sc = *(const f32x2*)(scal + t * 4);
                float p1 = 0.f, p2 = 0.f;
#pragma unroll
                for (int i = 0; i < 4; ++i) { p1 += S[i] * a0[i] + S[4 + i] * a1[i]; p2 += S[i] * w0[i] + S[4 + i] * w1[i]; }
                p1 += dppf<0xB1>(p1); p2 += dppf<0xB1>(p2);
                p1 += dppf<0x4E>(p1); p2 += dppf<0x4E>(p2);
                p1 += dppf<0x141>(p1); p2 += dppf<0x141>(p2);
                const float sa = p1, y = p2 + sa * sc[0] + vv * sc[1];
#pragma unroll
                for (int i = 0; i < 4; ++i) { S[i] = S[i] * d0[i] + sa * b0[i] + vv * k0[i]; S[4 + i] = S[4 + i] * d1[i] + sa * b1[i] + vv * k1[i]; }
                if (j8 == 0) Yraw[t * 64 + rowv] = y;
            }
            __syncthreads();
#pragma unroll 1
            for (int i = 0; i < 4; ++i) {
                const int t = wave + 8 * i; const size_t row = (size_t)(row0 + t);
                const float y = Yraw[t * 64 + k], mu = wave_sum(y) * (1.0f / 64.0f), d = y - mu, var = wave_sum(d * d) * (1.0f / 64.0f);
                const float o = d * rsqrtf(var + 64e-5f) * gng + gnb + scal[t * 4 + 2] * vec[t * 384 + 320 + k];
                R[row * 4096 + hc + k] = f2bf(o);
            }
            __syncthreads();
        }
    }
}

__global__ void __launch_bounds__(512, 2) mega(Params p) {
    extern __shared__ __attribute__((aligned(16))) unsigned char smem[];
    cg::grid_group grid = cg::this_grid();
    const int lo = p.ph_lo, hi = p.ph_hi;
#define IN(k) (lo <= (k) && (k) < hi)
#define SEAM(k) do { if (IN(k) && IN((k) + 1)) grid.sync(); } while (0)
    unsigned char* ws = p.ws;
    PG8_LAS unsigned char* glds = (PG8_LAS unsigned char*)smem;
    if (IN(0)) {
        tconv(smem, p.in[2], 8192, 0, 8192, 2048, (u16*)(ws + OFF_W0IN), 2048);
        tconv(smem, p.in[21], 2048, 0, 2048, 4096, (u16*)(ws + OFF_W0OUT), 4096);
        prep_small(p);
        rows_phase<0>(p);
    }
    SEAM(0);
    if (IN(1)) {
        pg8::Gemm g{(const u16*)(ws + OFF_H), (const u16*)(ws + OFF_W0IN), NTOK, 8192, 2048}; pg8::StaticOrder S; S.init(NTOK, 8192, gridDim.x, blockIdx.x);
        pg8::EpiG<F1> E{F1{(u16*)(ws + OFF_XR), (u16*)(ws + OFF_XM), (u16*)(ws + OFF_Y0)}};
        pg8::gemm_phase(glds, g, S, E);
    }
    SEAM(1);
    if (IN(2)) {
        mqk_phase(p, smem);
        lru_phase<1>(p, smem);
        tconv(smem, p.in[24], 16384, 0, 8192, 2048, (u16*)(ws + OFF_W1), 2048);
    }
    SEAM(2);
    if (IN(3)) lru_carry(p);
    SEAM(3);
    if (IN(4)) { mlstm_phase(p, smem); lru_phase<2>(p, smem); }
    SEAM(4);
    if (IN(5)) mnorm_phase(p);
    SEAM(5);
    if (IN(6)) {
        pg8::Gemm g{(const u16*)(ws + OFF_Y0), (const u16*)(ws + OFF_W0OUT), NTOK, 2048, 4096}; pg8::StaticOrder S; S.init(NTOK, 2048, gridDim.x, blockIdx.x);
        pg8::EpiG<F2> E{F2{(float*)(ws + OFF_M0)}};
        pg8::gemm_phase(glds, g, S, E);
    }
    SEAM(6);
    if (IN(7)) {
        rows_phase<1>(p);
        tconv(smem, p.in[24], 16384, 8192, 4096, 2048, (u16*)(ws + OFF_W1) + (size_t)8192 * 2048, 2048);
        prep_extras(p);
    }
    SEAM(7);
    if (IN(8)) {
        pg8::Gemm g{(const u16*)(ws + OFF_H), (const u16*)(ws + OFF_W1), NTOK, 12800, 2048}; pg8::StaticOrder S; S.init(NTOK, 12800, gridDim.x, blockIdx.x);
        pg8::EpiG<F3> E{F3{(u16*)(ws + OFF_R), (u16*)(ws + OFF_P)}};
        pg8::gemm_phase(glds, g, S, E);
    }
    SEAM(8);
    if (IN(9)) {
        rwkv_phase(p, smem);
        tconv(smem, p.in[24], 16384, 12288, 4096, 2048, (u16*)(ws + OFF_W1Z), 2048);
        tconv(smem, p.in[39], 2048, 0, 2048, 4096, (u16*)(ws + OFF_W1OUT), 4096);
    }
    SEAM(9);
    if (IN(10)) {
        pg8::Gemm g{(const u16*)(ws + OFF_H), (const u16*)(ws + OFF_W1Z), NTOK, 4096, 2048}; pg8::StaticOrder S; S.init(NTOK, 4096, gridDim.x, blockIdx.x);
        pg8::EpiG<F4> E{F4{(u16*)(ws + OFF_R)}};
        pg8::gemm_phase(glds, g, S, E);
    }
    SEAM(10);
    if (IN(11)) {
        pg8::Gemm g{(const u16*)(ws + OFF_R), (const u16*)(ws + OFF_W1OUT), NTOK, 2048, 4096}; pg8::StaticOrder S; S.init(NTOK, 2048, gridDim.x, blockIdx.x);
        pg8::EpiG<F2> E{F2{(float*)(ws + OFF_M1)}};
        pg8::gemm_phase(glds, g, S, E);
    }
    SEAM(11);
    if (IN(12)) rows_phase<2>(p);
}

extern "C" void kernel_launch(void* const* d_in, const int* in_sizes, int n_in, void* d_out, int out_size, void* d_ws, size_t ws_size, hipStream_t stream) {
    static int grid_blocks = 0;
    if (!grid_blocks) {
        if (n_in != 41 || ws_size < WS_NEED) { fprintf(stderr, "kernel_launch: unexpected n_in %d / ws_size %zu (need %zu)\n", n_in, ws_size, (size_t)WS_NEED); grid_blocks = -1; }
        else {
            int dev = 0, cus = 0, per_cu = 0;
            hipGetDevice(&dev);
            hipDeviceGetAttribute(&cus, hipDeviceAttributeMultiprocessorCount, dev);
            if (hipFuncSetAttribute((const void*)mega, hipFuncAttributeMaxDynamicSharedMemorySize, LDS_BYTES) != hipSuccess) fprintf(stderr, "kernel_launch: hipFuncSetAttribute failed\n");
            hipOccupancyMaxActiveBlocksPerMultiprocessor(&per_cu, (const void*)mega, 512, LDS_BYTES);
            if (per_cu < 1) { fprintf(stderr, "kernel_launch: occupancy query says %d blocks/CU\n", per_cu); per_cu = 1; }
            grid_blocks = cus * 1;
            if (grid_blocks > cus * per_cu) grid_blocks = cus * per_cu;
        }
    }
    if (grid_blocks <= 0) return;
    Params p{};
    for (int i = 0; i < 41; ++i) p.in[i] = (const float*)d_in[i];
    p.out = (float*)d_out; p.ws = (unsigned char*)d_ws;
#if N_LAUNCH_MODE == 1
    p.ph_lo = 0; p.ph_hi = NPH;
    { void* args[] = {&p};
      hipError_t e = hipLaunchCooperativeKernel((const void*)mega, dim3(grid_blocks), dim3(512), args, LDS_BYTES, stream);
      if (e != hipSuccess) fprintf(stderr, "cooperative launch failed: %s (grid %d)\n", hipGetErrorString(e), grid_blocks); }
#else
    for (int ph = 0; ph < NPH; ++ph) { p.ph_lo = ph; p.ph_hi = ph + 1; void* args[] = {&p};
        hipError_t e = hipLaunchCooperativeKernel((const void*)mega, dim3(grid_blocks), dim3(512), args, LDS_BYTES, stream);
        if (e != hipSuccess) { fprintf(stderr, "launch %d failed: %s (grid %d)\n", ph, hipGetErrorString(e), grid_blocks); break; } }
#endif
}
```

```cpp
#include <hip/hip_runtime.h>
#include <hip/hip_cooperative_groups.h>
#include <cstdio>
namespace cg = cooperative_groups;

#ifndef N_LAUNCH_MODE
#define N_LAUNCH_MODE 1
#endif

typedef unsigned short u16;
typedef short bf16x8 __attribute__((ext_vector_type(8)));
typedef float f32x4 __attribute__((ext_vector_type(4)));
typedef float f32x2 __attribute__((ext_vector_type(2)));
typedef unsigned u32x4 __attribute__((ext_vector_type(4)));
typedef unsigned u32x2 __attribute__((ext_vector_type(2)));

constexpr int NTOK = 16384, DM = 2048, SEQL = 4096;
constexpr size_t MiB = (size_t)1 << 20;
constexpr size_t OFF_H = 0;
constexpr size_t OFF_XR = 64 * MiB;
constexpr size_t OFF_XM = 128 * MiB;
constexpr size_t OFF_Y0 = 192 * MiB;
constexpr size_t OFF_Q = 320 * MiB;
constexpr size_t OFF_KX = 384 * MiB;
constexpr size_t OFF_W0IN = 448 * MiB;
constexpr size_t OFF_W0OUT = 480 * MiB;
constexpr size_t OFF_SMALL = 496 * MiB;
constexpr size_t OFF_G = OFF_SMALL;
constexpr size_t OFF_LRUA = OFF_SMALL + 1 * MiB;
constexpr size_t OFF_LRUH = OFF_SMALL + 3 * MiB;
constexpr size_t OFF_LRUC = OFF_SMALL + 5 * MiB;
constexpr size_t OFF_LRUW = OFF_SMALL + 7 * MiB;
constexpr size_t OFF_WGT = OFF_SMALL + 8 * MiB;
constexpr size_t OFF_M0 = OFF_XR;
constexpr size_t OFF_R = 64 * MiB, OFF_KK = 192 * MiB, OFF_V = 320 * MiB;
constexpr size_t OFF_W1 = 448 * MiB;
constexpr size_t OFF_P = 498 * MiB;
constexpr size_t OFF_W1Z = 448 * MiB, OFF_W1OUT = 464 * MiB;
constexpr size_t OFF_M1 = OFF_V;
constexpr size_t WS_NEED = 510 * MiB;
constexpr int LDS_BYTES = 160 * 1024;
constexpr int NPH = 13;

struct Params { const float* in[41]; float* out; unsigned char* ws; int ph_lo, ph_hi; };

__device__ __forceinline__ unsigned pk2(float lo, float hi) { unsigned r; asm volatile("v_cvt_pk_bf16_f32 %0, %1, %2" : "=v"(r) : "v"(lo), "v"(hi)); return r; }
__device__ __forceinline__ u16 f2bf(float f) { return (u16)(pk2(f, 0.f) & 0xffffu); }
__device__ __forceinline__ float bf2f(u16 v) { return __uint_as_float(((unsigned)v) << 16); }
__device__ __forceinline__ float bflo(unsigned w) { return __uint_as_float(w << 16); }
__device__ __forceinline__ float bfhi(unsigned w) { return __uint_as_float(w & 0xffff0000u); }
__device__ __forceinline__ void unpack8(u32x4 w, float* f) { f[0] = bflo(w.x); f[1] = bfhi(w.x); f[2] = bflo(w.y); f[3] = bfhi(w.y); f[4] = bflo(w.z); f[5] = bfhi(w.z); f[6] = bflo(w.w); f[7] = bfhi(w.w); }
__device__ __forceinline__ u32x4 pack8(const float* f) { u32x4 w; w.x = pk2(f[0], f[1]); w.y = pk2(f[2], f[3]); w.z = pk2(f[4], f[5]); w.w = pk2(f[6], f[7]); return w; }
__device__ __forceinline__ bf16x8 as_frag(u32x4 w) { union { u32x4 u; bf16x8 b; } c; c.u = w; return c.b; }
__device__ __forceinline__ float sigmoidf_(float x) { return 1.0f / (1.0f + __expf(-x)); }
__device__ __forceinline__ float siluf_(float x) { return x / (1.0f + __expf(-x)); }
__device__ __forceinline__ float softplusf_(float x) { return fmaxf(x, 0.f) + log1pf(__expf(-fabsf(x))); }
__device__ __forceinline__ float wave_sum(float v) {
#pragma unroll
    for (int o = 32; o; o >>= 1) v += __shfl_xor(v, o);
    return v;
}
template <int CTRL> __device__ __forceinline__ float dppf(float v) { return __int_as_float(__builtin_amdgcn_update_dpp(0, __float_as_int(v), CTRL, 0xF, 0xF, false)); }
#define MFMA16(a, b, c) __builtin_amdgcn_mfma_f32_16x16x32_bf16((a), (b), (c), 0, 0, 0)

namespace pg8 {
#define PG8_LAS __attribute__((address_space(3)))
typedef unsigned short bf16_t;
constexpr int BM = 256, BK = 64, HALF = 128, HTB = HALF * BK * 2, STAGE_BYTES = 8 * HTB, NXCD = 8, WGM = 8;
__host__ __device__ __forceinline__ int lds_byte(int r, int c) { const int st = (r >> 4) * 2 + (c >> 5), rr = r & 15, cc = c & 31, ob = rr * 64 + cc * 2; return st * 1024 + (ob ^ (((ob >> 9) & 1) << 5)); }
__host__ __device__ __forceinline__ void stage_rc(int b, int& R, int& C) { const int st = b / 1024, sb = b % 1024, swz = sb ^ (((sb >> 9) & 1) << 5); R = (st >> 1) * 16 + swz / 64; C = (st & 1) * 32 + (swz % 64) / 2; }
__host__ __device__ __forceinline__ int perm32(int rho) { const int n = rho >> 4, i = rho & 15; return 8 * (i >> 2) + 4 * n + (i & 3); }
struct Unit { int pm, pn; };
struct Gemm { const bf16_t* A; const bf16_t* Bt; int M, N, K; };
struct StaticOrder {
    int nM, nN, nwg, G, c;
    __host__ __device__ void init(int M, int N, int G_, int c_) { nM = M / BM; nN = N / BM; nwg = nM * nN; G = G_; c = c_; }
    __host__ __device__ bool next(int i, Unit& u) const {
        const long L = (long)i * G + c; if (L >= nwg) return false;
        int wgid = (int)L; { const int q = nwg / NXCD, r = nwg % NXCD, xcd = wgid % NXCD, off = wgid / NXCD; wgid = (xcd < r ? xcd * (q + 1) : r * (q + 1) + (xcd - r) * q) + off; }
        const int nig = WGM * nN, gid = wgid / nig, fm = gid * WGM, gsz = (nM - fm) < WGM ? (nM - fm) : WGM;
        u.pm = fm + ((wgid % nig) % gsz); u.pn = (wgid % nig) / gsz; return true;
    }
};
template <class F> struct EpiG {
    static constexpr bool PERM = true;
    F f;
    __device__ __forceinline__ void operator()(const f32x4 (&acc)[2][2][4][2], const Unit& u, int wr, int wc, int fr, int fq) const {
        const int row0 = u.pm * BM + wr * 64 + fr, col0 = u.pn * BM + wc * 32 + 8 * fq;
#pragma unroll
        for (int ai = 0; ai < 2; ++ai)
#pragma unroll
            for (int m = 0; m < 4; ++m)
#pragma unroll
                for (int bj = 0; bj < 2; ++bj) f(row0 + ai * HALF + m * 16, col0 + bj * HALF, acc[ai][bj][m][0], acc[ai][bj][m][1]);
    }
};

template <class Epi>
__device__ __forceinline__ void gemm_phase(PG8_LAS unsigned char* lds, const Gemm g, const StaticOrder& S, const Epi& E) {
    const int tid = threadIdx.x, wid = __builtin_amdgcn_readfirstlane(tid >> 6), lane = tid & 63, wr = wid >> 2, wc = wid & 3, fr = lane & 15, fq = lane >> 4;
    const int K = g.K, nt = K / BK;
    unsigned voffA[2], voffB[2];
#pragma unroll
    for (int i = 0; i < 2; ++i) { int R, C; stage_rc(tid * 16 + i * 8192, R, C); const int Rb = Epi::PERM ? ((R & ~31) + perm32(R & 31)) : R;
        voffA[i] = (unsigned)(R * K + C) * 2u; voffB[i] = (unsigned)(Rb * K + C) * 2u; }
    const size_t kstep = (size_t)(BK * 2);
    const size_t hstep = (size_t)HALF * K * 2;
    const size_t tstep = 2 * hstep;
    const unsigned ldsw = (unsigned)wid * 1024u;
    const int aoff = lds_byte(wr * 64 + fr, fq * 8), boff = lds_byte(wc * 32 + fr, fq * 8);
#define PG8_SA(b, h) (((b) * 2 + (h)) * HTB)
#define PG8_SB(b, h) ((4 + (b) * 2 + (h)) * HTB)
#define PG8_STAGE(bufoff, gbase, voff) do { _Pragma("unroll") for (int _i = 0; _i < 2; ++_i) \
        __builtin_amdgcn_global_load_lds((const unsigned*)((const char*)(gbase) + (voff)[_i]), (PG8_LAS unsigned*)(lds + (bufoff) + ldsw + _i * 8192), 16, 0, 0); } while (0)
#define PG8_LDA(dst, b, h) do { _Pragma("unroll") for (int m = 0; m < 4; ++m) _Pragma("unroll") for (int k = 0; k < 2; ++k) dst[m][k] = *(const PG8_LAS bf16x8*)(lds + PG8_SA(b, h) + aoff + m * 2048 + k * 1024); } while (0)
#define PG8_LDB(dst, b, h) do { _Pragma("unroll") for (int n = 0; n < 2; ++n) _Pragma("unroll") for (int k = 0; k < 2; ++k) dst[n][k] = *(const PG8_LAS bf16x8*)(lds + PG8_SB(b, h) + boff + n * 2048 + k * 1024); } while (0)
#define PG8_MMA(ai, bj, At, Bt) do { __builtin_amdgcn_s_setprio(1); _Pragma("unroll") for (int m = 0; m < 4; ++m) _Pragma("unroll") for (int n = 0; n < 2; ++n) _Pragma("unroll") for (int k = 0; k < 2; ++k) \
        acc[ai][bj][m][n] = __builtin_amdgcn_mfma_f32_16x16x32_bf16(Bt[n][k], At[m][k], acc[ai][bj][m][n], 0, 0, 0); __builtin_amdgcn_s_setprio(0); } while (0)
#define PG8_WAIT_V(n) asm volatile("s_waitcnt vmcnt(" #n ")" ::: "memory")
#define PG8_WAIT_L(n) asm volatile("s_waitcnt lgkmcnt(" #n ")" ::: "memory")
#define PG8_BAR __builtin_amdgcn_s_barrier()
#define PG8_SCHED __builtin_amdgcn_sched_barrier(0)
    Unit cur, nxt; int ui = 0;
    if (!S.next(0, cur)) return;
    f32x4 acc[2][2][4][2];
#pragma unroll
    for (int a = 0; a < 2; ++a)
#pragma unroll
        for (int b = 0; b < 2; ++b)
#pragma unroll
            for (int m = 0; m < 4; ++m)
#pragma unroll
                for (int n = 0; n < 2; ++n) acc[a][b][m][n] = (f32x4){0.f, 0.f, 0.f, 0.f};
    bf16x8 At[4][2], B0[2][2], B1[2][2];
    const char* cA = (const char*)g.A + (size_t)cur.pm * tstep; const char* cB = (const char*)g.Bt + (size_t)cur.pn * tstep;
    PG8_STAGE(PG8_SB(0, 0), cB, voffB); PG8_STAGE(PG8_SA(0, 0), cA, voffA); PG8_STAGE(PG8_SB(0, 1), cB + hstep, voffB); PG8_STAGE(PG8_SA(0, 1), cA + hstep, voffA);
    if (wr == 1) PG8_BAR;
    PG8_WAIT_V(4); PG8_BAR;
    PG8_STAGE(PG8_SB(1, 0), cB + kstep, voffB); PG8_STAGE(PG8_SA(1, 0), cA + kstep, voffA); PG8_STAGE(PG8_SB(1, 1), cB + hstep + kstep, voffB);
    PG8_WAIT_V(6); PG8_BAR;
    for (;;) {
        const bool has_next = S.next(ui + 1, nxt);
        const char* nA = has_next ? (const char*)g.A + (size_t)nxt.pm * tstep : cA; const char* nB = has_next ? (const char*)g.Bt + (size_t)nxt.pn * tstep : cB;
        for (int t = 0; t < nt; t += 2) {
            const bool last = (t == nt - 2);
            const char* a1 = cA + (size_t)(t + 1) * kstep;
            const char* a2 = last ? nA : cA + (size_t)(t + 2) * kstep; const char* b2 = last ? nB : cB + (size_t)(t + 2) * kstep;
            const char* a3 = a2 + kstep; const char* b3 = b2 + kstep;
            PG8_LDB(B0, 0, 0); PG8_SCHED; PG8_LDA(At, 0, 0); PG8_STAGE(PG8_SA(1, 1), a1 + hstep, voffA);
            PG8_WAIT_L(8); PG8_BAR; PG8_WAIT_L(0); PG8_MMA(0, 0, At, B0); PG8_BAR; PG8_SCHED;
            PG8_LDB(B1, 0, 1); PG8_STAGE(PG8_SB(0, 0), b2, voffB);
            PG8_BAR; PG8_WAIT_L(0); PG8_MMA(0, 1, At, B1); PG8_BAR;
            PG8_LDA(At, 0, 1); PG8_STAGE(PG8_SA(0, 0), a2, voffA);
            PG8_BAR; PG8_WAIT_L(0); PG8_MMA(1, 0, At, B0); PG8_BAR; PG8_SCHED;
            PG8_STAGE(PG8_SB(0, 1), b2 + hstep, voffB);
            PG8_WAIT_V(6); PG8_BAR; PG8_MMA(1, 1, At, B1); PG8_BAR;
            PG8_LDB(B0, 1, 0); PG8_SCHED; PG8_LDA(At, 1, 0); PG8_STAGE(PG8_SA(0, 1), a2 + hstep, voffA);
            PG8_WAIT_L(8); PG8_BAR; PG8_WAIT_L(0); PG8_MMA(0, 0, At, B0); PG8_BAR; PG8_SCHED;
            PG8_LDB(B1, 1, 1); PG8_STAGE(PG8_SB(1, 0), b3, voffB);
            PG8_BAR; PG8_WAIT_L(0); PG8_MMA(0, 1, At, B1); PG8_BAR;
            PG8_LDA(At, 1, 1); PG8_STAGE(PG8_SA(1, 0), a3, voffA);
            PG8_BAR; PG8_WAIT_L(0); PG8_MMA(1, 0, At, B0); PG8_BAR; PG8_SCHED;
            PG8_STAGE(PG8_SB(1, 1), b3 + hstep, voffB);
            PG8_WAIT_V(6); PG8_BAR; PG8_MMA(1, 1, At, B1); PG8_BAR;
        }
        E(acc, cur, wr, wc, fr, fq);
        if (!has_next) break;
#pragma unroll
        for (int a = 0; a < 2; ++a)
#pragma unroll
            for (int b = 0; b < 2; ++b)
#pragma unroll
                for (int m = 0; m < 4; ++m)
#pragma unroll
                    for (int n = 0; n < 2; ++n) acc[a][b][m][n] = (f32x4){0.f, 0.f, 0.f, 0.f};
        cur = nxt; cA = nA; cB = nB; ++ui;
    }
    PG8_WAIT_V(0);
    if (wr == 0) PG8_BAR;
    PG8_BAR;
#undef PG8_SA
#undef PG8_SB
#undef PG8_STAGE
#undef PG8_LDA
#undef PG8_LDB
#undef PG8_MMA
#undef PG8_WAIT_V
#undef PG8_WAIT_L
#undef PG8_BAR
#undef PG8_SCHED
}
}

__device__ __forceinline__ void store8bf(u16* dst, f32x4 v0, f32x4 v1) { u32x4 w; w.x = pk2(v0[0], v0[1]); w.y = pk2(v0[2], v0[3]); w.z = pk2(v1[0], v1[1]); w.w = pk2(v1[2], v1[3]); *(u32x4*)dst = w; }
struct F1 { u16 *XR, *XM, *Y0;
    __device__ __forceinline__ void operator()(int row, int col, f32x4 v0, f32x4 v1) const {
        const int reg = col >> 11, cc = col & 2047;
        u16* dst = reg == 0 ? XR + (size_t)row * 2048 + cc : reg == 1 ? Y0 + (size_t)row * 4096 + cc : reg == 2 ? XM + (size_t)row * 2048 + cc : Y0 + (size_t)row * 4096 + 2048 + cc;
        store8bf(dst, v0, v1); } };
struct F2 { float* C;
    __device__ __forceinline__ void operator()(int row, int col, f32x4 v0, f32x4 v1) const { float* d = C + (size_t)row * 2048 + col; *(f32x4*)d = v0; *(f32x4*)(d + 4) = v1; } };
struct F3 { u16 *RKV, *P;
    __device__ __forceinline__ void operator()(int row, int col, f32x4 v0, f32x4 v1) const {
        if (col < 12288) { const int reg = col >> 12, cc = col & 4095; store8bf(RKV + (size_t)reg * ((size_t)NTOK * 4096) + (size_t)row * 4096 + cc, v0, v1); }
        else { const int cc = col - 12288; if (cc < 384) store8bf(P + (size_t)row * 384 + cc, v0, v1); } } };
struct F4 { u16* R;
    __device__ __forceinline__ void operator()(int row, int col, f32x4 v0, f32x4 v1) const {
        u16* d = R + (size_t)row * 4096 + col; const u32x4 w = *(const u32x4*)d; float y[8]; unpack8(w, y);
        f32x4 o0, o1;
#pragma unroll
        for (int j = 0; j < 4; ++j) { o0[j] = y[j] * siluf_(v0[j]); o1[j] = y[4 + j] * siluf_(v1[j]); }
        store8bf(d, o0, o1); } };

__device__ void tconv(unsigned char* smem, const float* src, int ldsrc, int col0, int N, int K, u16* dst, int ldd) {
    float* T = (float*)smem;
    const int tid = threadIdx.x, tilesN = N >> 6, ntile = tilesN * (K >> 6);
    for (int tile = blockIdx.x; tile < ntile; tile += gridDim.x) {
        const int tn = tile % tilesN, tk = tile / tilesN;
#pragma unroll
        for (int i = 0; i < 8; ++i) { const int r = i * 8 + (tid >> 6), c = tid & 63; T[r * 65 + c] = src[(size_t)(tk * 64 + r) * ldsrc + col0 + tn * 64 + c]; }
        __syncthreads();
#pragma unroll
        for (int i = 0; i < 4; ++i) { const int n = (tid >> 5) + 16 * i, kk = (tid & 31) * 2;
            *(unsigned*)(dst + (size_t)(tn * 64 + n) * ldd + tk * 64 + kk) = pk2(T[kk * 65 + n], T[(kk + 1) * 65 + n]); }
        __syncthreads();
    }
}

template <int MODE> __device__ void rows_phase(const Params& p) {
    const int lane = threadIdx.x & 63, gw = blockIdx.x * 8 + (threadIdx.x >> 6), nw = gridDim.x * 8;
    const float* x = p.in[0];
    for (int row = gw; row < NTOK; row += nw) {
        if (MODE == 0) {
            f32x4 v[8]; float ss = 0.f;
#pragma unroll
            for (int i = 0; i < 8; ++i) { v[i] = *(const f32x4*)(x + (size_t)row * DM + i * 256 + lane * 4); ss += v[i][0] * v[i][0] + v[i][1] * v[i][1] + v[i][2] * v[i][2] + v[i][3] * v[i][3]; }
            ss = wave_sum(ss); const float r = rsqrtf(ss * (1.0f / DM) + 1e-6f);
            u16* H = (u16*)(p.ws + OFF_H);
#pragma unroll
            for (int i = 0; i < 8; ++i) { const int c = i * 256 + lane * 4; const f32x4 g = *(const f32x4*)(p.in[1] + c);
                u32x2 w; w.x = pk2(v[i][0] * r * g[0], v[i][1] * r * g[1]); w.y = pk2(v[i][2] * r * g[2], v[i][3] * r * g[3]); *(u32x2*)(H + (size_t)row * DM + c) = w; }
        } else {
            const float* Mx = (const float*)(p.ws + (MODE == 1 ? OFF_M0 : OFF_M1));
            const float* base = MODE == 1 ? x : p.out;
            const float* gpost = p.in[MODE == 1 ? 22 : 40];
            f32x4 m[8]; float ss = 0.f;
#pragma unroll
            for (int i = 0; i < 8; ++i) { m[i] = *(const f32x4*)(Mx + (size_t)row * DM + i * 256 + lane * 4); ss += m[i][0] * m[i][0] + m[i][1] * m[i][1] + m[i][2] * m[i][2] + m[i][3] * m[i][3]; }
            ss = wave_sum(ss); const float r = rsqrtf(ss * (1.0f / DM) + 1e-6f);
            float ss1 = 0.f;
#pragma unroll
            for (int i = 0; i < 8; ++i) { const int c = i * 256 + lane * 4; const f32x4 g = *(const f32x4*)(gpost + c); const f32x4 b = *(const f32x4*)(base + (size_t)row * DM + c);
                m[i] = b + m[i] * r * g; ss1 += m[i][0] * m[i][0] + m[i][1] * m[i][1] + m[i][2] * m[i][2] + m[i][3] * m[i][3];
                *(f32x4*)(p.out + (size_t)row * DM + c) = m[i]; }
            if (MODE == 1) {
                ss1 = wave_sum(ss1); const float r1 = rsqrtf(ss1 * (1.0f / DM) + 1e-6f);
                u16* H = (u16*)(p.ws + OFF_H);
#pragma unroll
                for (int i = 0; i < 8; ++i) { const int c = i * 256 + lane * 4; const f32x4 g = *(const f32x4*)(p.in[23] + c);
                    u32x2 w; w.x = pk2(m[i][0] * r1 * g[0], m[i][1] * r1 * g[1]); w.y = pk2(m[i][2] * r1 * g[2], m[i][3] * r1 * g[3]); *(u32x2*)(H + (size_t)row * DM + c) = w; }
            }
        }
    }
}

__device__ void prep_small(const Params& p) {
    const int gt = blockIdx.x * 512 + threadIdx.x, nt = gridDim.x * 512;
    u16* LW = (u16*)(p.ws + OFF_LRUW);
    for (int e = gt; e < 2 * 16 * 128 * 128; e += nt) { const int i = e & 127, j = (e >> 7) & 127, blk = (e >> 14) & 15, g = e >> 18;
        LW[e] = f2bf(p.in[g ? 7 : 5][(size_t)(blk * 128 + i) * 128 + j]); }
    u16* WG = (u16*)(p.ws + OFF_WGT);
    for (int e = gt; e < 16 * 6144; e += nt) { const int c = e % 6144, n = e / 6144; WG[e] = f2bf(n < 8 ? p.in[15][c * 8 + n] : p.in[17][c * 8 + n - 8]); }
}
__device__ void prep_extras(const Params& p) {
    const int gt = blockIdx.x * 512 + threadIdx.x, nt = gridDim.x * 512;
    u16* W = (u16*)(p.ws + OFF_W1) + (size_t)12288 * 2048;
    for (int e = gt; e < 512 * 2048; e += nt) { const int k = e & 2047, n = e >> 11; float v = 0.f;
        if (n < 96) v = (1.f - p.in[26][k]) * p.in[29][k * 96 + n];
        else if (n < 192) v = p.in[26][k] * p.in[29][k * 96 + n - 96];
        else if (n < 288) v = (1.f - p.in[27][k]) * p.in[32][k * 96 + n - 192];
        else if (n < 384) v = p.in[27][k] * p.in[32][k * 96 + n - 288];
        W[e] = f2bf(v); }
}

template <int PASS> __device__ void lru_phase(const Params& p, unsigned char* smem) {
    float* xcf = (float*)smem;
    float* As = xcf + 64 * 132;
    float* Us = As + 64 * 132;
    float* qA = Us + 64 * 132;
    float* qH = qA + 512;
    const int tid = threadIdx.x, lane = tid & 63, wave = __builtin_amdgcn_readfirstlane(tid >> 6);
    const u16* XR = (const u16*)(p.ws + OFF_XR);
    u16* Y0 = (u16*)(p.ws + OFF_Y0);
    const u16* LW = (const u16*)(p.ws + OFF_LRUW);
    float* LA = (float*)(p.ws + OFF_LRUA); float* LH = (float*)(p.ws + OFF_LRUH); const float* LC = (const float*)(p.ws + OFF_LRUC);
    const float* cw = p.in[3]; const float* cb = p.in[4];
    for (int tile = blockIdx.x; tile < 4096; tile += gridDim.x) {
        const int jb = tile & 15, c = (tile >> 4) & 63, b = tile >> 10;
        const int row0 = b * SEQL + c * 64;
#pragma unroll
        for (int it = 0; it < 2; ++it) {
            const int t = (tid >> 4) + 32 * it, c8 = (tid & 15) * 8, ch = jb * 128 + c8;
            float acc[8];
            { const f32x4 b0 = *(const f32x4*)(cb + ch), b1 = *(const f32x4*)(cb + ch + 4);
#pragma unroll
              for (int i = 0; i < 4; ++i) { acc[i] = b0[i]; acc[4 + i] = b1[i]; } }
#pragma unroll
            for (int j = 0; j < 4; ++j) { const int s = c * 64 + t - 3 + j;
                if (s >= 0) { const u32x4 raw = *(const u32x4*)(XR + (size_t)(b * SEQL + s) * 2048 + ch); float xv[8]; unpack8(raw, xv);
                    const f32x4 w0 = *(const f32x4*)(cw + j * 2048 + ch), w1 = *(const f32x4*)(cw + j * 2048 + ch + 4);
#pragma unroll
                    for (int i = 0; i < 4; ++i) { acc[i] += w0[i] * xv[i]; acc[4 + i] += w1[i] * xv[4 + i]; } } }
            *(f32x4*)(xcf + t * 132 + c8) = (f32x4){acc[0], acc[1], acc[2], acc[3]}; *(f32x4*)(xcf + t * 132 + c8 + 4) = (f32x4){acc[4], acc[5], acc[6], acc[7]};
        }
        __syncthreads();
        f32x4 accA[4], accX[4];
#pragma unroll
        for (int m = 0; m < 4; ++m) { accA[m] = (f32x4){0.f, 0.f, 0.f, 0.f}; accX[m] = (f32x4){0.f, 0.f, 0.f, 0.f}; }
#pragma unroll
        for (int ks = 0; ks < 4; ++ks) {
            const size_t wo = (size_t)((jb * 128 + 16 * wave + (lane & 15)) * 128 + ks * 32 + 8 * (lane >> 4));
            const bf16x8 ba = *(const bf16x8*)(LW + wo), bx = *(const bf16x8*)(LW + (size_t)16 * 128 * 128 + wo);
#pragma unroll
            for (int m = 0; m < 4; ++m) { const float* s = xcf + (16 * m + (lane & 15)) * 132 + ks * 32 + 8 * (lane >> 4);
                const f32x4 lo = *(const f32x4*)s, hi = *(const f32x4*)(s + 4); float f[8] = {lo[0], lo[1], lo[2], lo[3], hi[0], hi[1], hi[2], hi[3]};
                const bf16x8 af = as_frag(pack8(f));
                accA[m] = MFMA16(af, ba, accA[m]); accX[m] = MFMA16(af, bx, accX[m]); }
        }
        {
            const int ch = 16 * wave + (lane & 15), cgl = jb * 128 + ch;
            const float ba_ = p.in[6][cgl], bx_ = p.in[8][cgl], sp = softplusf_(-p.in[9][cgl]);
#pragma unroll
            for (int m = 0; m < 4; ++m)
#pragma unroll
                for (int r = 0; r < 4; ++r) { const int t = 16 * m + 4 * (lane >> 4) + r;
                    const float rg = sigmoidf_(accA[m][r] + ba_), ig = sigmoidf_(accX[m][r] + bx_);
                    const float la = -8.0f * rg * sp, a = __expf(la), u = sqrtf(-expm1f(2.0f * la)) * (ig * xcf[t * 132 + ch]);
                    As[t * 132 + ch] = a; Us[t * 132 + ch] = u; }
        }
        __syncthreads();
        const int ch = tid & 127, q = tid >> 7, cgl = jb * 128 + ch;
        { float h = 0.f, A = 1.f;
#pragma unroll
          for (int tt = 0; tt < 16; ++tt) { const int t = q * 16 + tt; const float a = As[t * 132 + ch], u = Us[t * 132 + ch]; h = a * h + u; A *= a;
              if (PASS == 2) { Us[t * 132 + ch] = h; As[t * 132 + ch] = A; } }
          qA[q * 128 + ch] = A; qH[q * 128 + ch] = h; }
        __syncthreads();
        if (PASS == 1) {
            if (q == 0) { float h = 0.f, A = 1.f;
#pragma unroll
                for (int qq = 0; qq < 4; ++qq) { h = qA[qq * 128 + ch] * h + qH[qq * 128 + ch]; A *= qA[qq * 128 + ch]; }
                LA[(size_t)(b * 64 + c) * 2048 + cgl] = A; LH[(size_t)(b * 64 + c) * 2048 + cgl] = h; }
        } else {
            float carry = LC[(size_t)(b * 64 + c) * 2048 + cgl];
            for (int qq = 0; qq < q; ++qq) carry = qA[qq * 128 + ch] * carry + qH[qq * 128 + ch];
#pragma unroll 4
            for (int tt = 0; tt < 16; ++tt) { const int t = q * 16 + tt; const float hh = Us[t * 132 + ch] + As[t * 132 + ch] * carry;
                u16* d = Y0 + (size_t)(row0 + t) * 4096 + cgl; *d = f2bf(hh * siluf_(bf2f(*d))); }
        }
        __syncthreads();
    }
}
__device__ void lru_carry(const Params& p) {
    const float* LA = (const float*)(p.ws + OFF_LRUA); const float* LH = (const float*)(p.ws + OFF_LRUH); float* LC = (float*)(p.ws + OFF_LRUC);
    for (int idx = blockIdx.x * 512 + threadIdx.x; idx < 4 * 2048; idx += gridDim.x * 512) { const int b = idx >> 11, cg_ = idx & 2047; float c = 0.f;
#pragma unroll 8
        for (int k = 0; k < 64; ++k) { const size_t o = (size_t)(b * 64 + k) * 2048 + cg_; LC[o] = c; c = LA[o] * c + LH[o]; } }
}

__device__ void mqk_phase(const Params& p, unsigned char* smem) {
    float* red = (float*)smem;
    const int tid = threadIdx.x, lane = tid & 63, wave = __builtin_amdgcn_readfirstlane(tid >> 6);
    const u16* XM = (const u16*)(p.ws + OFF_XM); u16* Q = (u16*)(p.ws + OFF_Q); u16* KX = (u16*)(p.ws + OFF_KX);
    const u16* WG = (const u16*)(p.ws + OFF_WGT); float* G = (float*)(p.ws + OFF_G);
    for (int tile = blockIdx.x; tile < 256; tile += gridDim.x) {
        const int row0 = tile * 64;
        f32x4 acc[4];
#pragma unroll
        for (int m = 0; m < 4; ++m) acc[m] = (f32x4){0.f, 0.f, 0.f, 0.f};
        for (int ks = 0; ks < 8; ++ks) {
            const int c0 = 256 * wave + 32 * ks + 8 * (lane >> 4);
            float cw[4][8], cbv[8];
#pragma unroll
            for (int j = 0; j < 4; ++j) { const f32x4 a = *(const f32x4*)(p.in[10] + j * 2048 + c0), b = *(const f32x4*)(p.in[10] + j * 2048 + c0 + 4);
#pragma unroll
                for (int i = 0; i < 4; ++i) { cw[j][i] = a[i]; cw[j][4 + i] = b[i]; } }
            { const f32x4 a = *(const f32x4*)(p.in[11] + c0), b = *(const f32x4*)(p.in[11] + c0 + 4);
#pragma unroll
              for (int i = 0; i < 4; ++i) { cbv[i] = a[i]; cbv[4 + i] = b[i]; } }
            const bf16x8 bq = *(const bf16x8*)(WG + (size_t)(lane & 15) * 6144 + c0), bk = *(const bf16x8*)(WG + (size_t)(lane & 15) * 6144 + 2048 + c0), bv = *(const bf16x8*)(WG + (size_t)(lane & 15) * 6144 + 4096 + c0);
            const float* wqp = p.in[12] + (size_t)(c0 >> 2) * 16; const float* wkp = p.in[13] + (size_t)(c0 >> 2) * 16; const float* wvp = p.in[14] + (size_t)(c0 >> 2) * 16;
#pragma unroll 1
            for (int m = 0; m < 4; ++m) {
                const int tk = row0 + 16 * m + (lane & 15), s = tk & (SEQL - 1);
                float xmc[8], xcur[8];
#pragma unroll
                for (int i = 0; i < 8; ++i) xmc[i] = cbv[i];
#pragma unroll
                for (int j = 0; j < 4; ++j) { float xv[8];
                    if (s - 3 + j >= 0) { const u32x4 raw = *(const u32x4*)(XM + (size_t)(tk - 3 + j) * 2048 + c0); unpack8(raw, xv); }
                    else {
#pragma unroll
                        for (int i = 0; i < 8; ++i) xv[i] = 0.f; }
#pragma unroll
                    for (int i = 0; i < 8; ++i) { xmc[i] += cw[j][i] * xv[i]; if (j == 3) xcur[i] = xv[i]; } }
#pragma unroll
                for (int i = 0; i < 8; ++i) xmc[i] = siluf_(xmc[i]);
                float qv[8], kv[8], vv[8];
#pragma unroll
                for (int bb = 0; bb < 2; ++bb)
#pragma unroll
                    for (int jj = 0; jj < 4; ++jj) { float aq = 0.f, ak = 0.f, av = 0.f;
#pragma unroll
                        for (int ii = 0; ii < 4; ++ii) { aq += xmc[4 * bb + ii] * wqp[bb * 16 + ii * 4 + jj]; ak += xmc[4 * bb + ii] * wkp[bb * 16 + ii * 4 + jj]; av += xcur[4 * bb + ii] * wvp[bb * 16 + ii * 4 + jj]; }
                        qv[4 * bb + jj] = aq; kv[4 * bb + jj] = ak; vv[4 * bb + jj] = av; }
                const u32x4 qw = pack8(qv), kw = pack8(kv), vw = pack8(vv);
                acc[m] = MFMA16(as_frag(qw), bq, acc[m]); acc[m] = MFMA16(as_frag(kw), bk, acc[m]); acc[m] = MFMA16(as_frag(vw), bv, acc[m]);
#pragma unroll
                for (int i = 0; i < 8; ++i) kv[i] *= 0.0625f;
                *(u32x4*)(Q + (size_t)tk * 2048 + c0) = qw; *(u32x4*)(KX + (size_t)tk * 2048 + c0) = pack8(kv);
            }
        }
#pragma unroll
        for (int m = 0; m < 4; ++m)
#pragma unroll
            for (int r = 0; r < 4; ++r) red[(wave * 64 + 16 * m + 4 * (lane >> 4) + r) * 16 + (lane & 15)] = acc[m][r];
        __syncthreads();
        for (int e = tid; e < 1024; e += 512) { const int tok = e >> 4, n = e & 15; float s = (n < 8) ? p.in[16][n] : p.in[18][n - 8];
#pragma unroll
            for (int w = 0; w < 8; ++w) s += red[(w * 64 + tok) * 16 + n];
            G[(size_t)(row0 + tok) * 16 + n] = s; }
        __syncthreads();
    }
}

__device__ void mlstm_phase(const Params& p, unsigned char* smem) {
    u16* Ks = (u16*)smem;
    u16* Vt = Ks + 128 * 264;
    u16* Vwt = Vt + 48 * 136;
    u16* Ps = Vwt + 48 * 136;
    u16* Ct = Ps + 128 * 136;
    float* gc = (float*)(Ct + 48 * 264);
    float* gM = gc + 128; float* gE = gM + 128; float* gF = gE + 128; float* gW = gF + 128; float* gS = gW + 128;
    const int tid = threadIdx.x, lane = tid & 63, wave = __builtin_amdgcn_readfirstlane(tid >> 6);
    const int l15 = lane & 15, lq = lane >> 4;
    const u16* XM = (const u16*)(p.ws + OFF_XM); const u16* Q = (const u16*)(p.ws + OFF_Q); const u16* KX = (const u16*)(p.ws + OFF_KX);
    const float* G = (const float*)(p.ws + OFF_G); u16* Hm = (u16*)(p.ws + OFF_H);
    for (int unit = blockIdx.x; unit < 256; unit += gridDim.x) {
        const int sl = unit & 7, h = (unit >> 3) & 7, b = unit >> 6;
        f32x4 accC[3][2];
#pragma unroll
        for (int a = 0; a < 3; ++a)
#pragma unroll
            for (int c = 0; c < 2; ++c) accC[a][c] = (f32x4){0.f, 0.f, 0.f, 0.f};
        float m_prev = 0.f;
        for (int e = tid; e < 16 * 136; e += 512) { const int r = e / 136; Vt[32 * 136 + e] = (r == 0) ? (u16)0x3F80 : (u16)0; Vwt[32 * 136 + e] = 0; }
        for (int e = tid; e < 48 * 264; e += 512) Ct[e] = 0;
        const int vc = 256 * h + 32 * sl + 4 * (tid & 7);
        float wv[16];
#pragma unroll
        for (int i = 0; i < 16; ++i) wv[i] = p.in[14][(size_t)(vc >> 2) * 16 + i];
        __syncthreads();
        for (int chunk = 0; chunk < 32; ++chunk) {
            const int row0 = b * SEQL + chunk * 128;
#pragma unroll
            for (int i = 0; i < 8; ++i) { const int idx = tid + 512 * i, r = idx >> 5, cc = (idx & 31) * 8;
                *(u32x4*)(Ks + r * 264 + cc) = *(const u32x4*)(KX + (size_t)(row0 + r) * 2048 + 256 * h + cc); }
            bf16x8 qf[8];
#pragma unroll
            for (int ks = 0; ks < 8; ++ks) qf[ks] = *(const bf16x8*)(Q + (size_t)(row0 + 16 * wave + l15) * 2048 + 256 * h + 32 * ks + 8 * lq);
            float vv[2][4];
#pragma unroll
            for (int i = 0; i < 2; ++i) { const int t = (tid + 512 * i) >> 3; const u32x2 raw = *(const u32x2*)(XM + (size_t)(row0 + t) * 2048 + vc);
                const float x0 = bflo(raw.x), x1 = bfhi(raw.x), x2 = bflo(raw.y), x3 = bfhi(raw.y);
#pragma unroll
                for (int jj = 0; jj < 4; ++jj) vv[i][jj] = x0 * wv[jj] + x1 * wv[4 + jj] + x2 * wv[8 + jj] + x3 * wv[12 + jj]; }
            if (wave == 0) {
                const int t0 = 2 * lane;
                const float ig0 = G[(size_t)(row0 + t0) * 16 + h], fg0 = G[(size_t)(row0 + t0) * 16 + 8 + h];
                const float ig1 = G[(size_t)(row0 + t0 + 1) * 16 + h], fg1 = G[(size_t)(row0 + t0 + 1) * 16 + 8 + h];
                const float lf0 = -softplusf_(-fg0), lf1 = -softplusf_(-fg1);
                float s = lf0 + lf1;
#pragma unroll
                for (int d = 1; d < 64; d <<= 1) { const float o = __shfl_up(s, d); if (lane >= d) s += o; }
                const float b1 = s, b0 = s - lf1;
                const float c0 = ig0 - b0, c1 = ig1 - b1;
                float mx = fmaxf(c0, c1);
#pragma unroll
                for (int d = 1; d < 64; d <<= 1) { const float o = __shfl_up(mx, d); if (lane >= d) mx = fmaxf(mx, o); }
                float pm = __shfl_up(mx, 1); if (lane == 0) pm = -3.0e38f;
                const float M0 = fmaxf(fmaxf(pm, c0), m_prev), M1 = fmaxf(mx, m_prev);
                const float Ml = __shfl(M1, 63), bL = __shfl(b1, 63);
                gc[t0] = c0; gc[t0 + 1] = c1; gM[t0] = M0; gM[t0 + 1] = M1;
                gE[t0] = __expf(m_prev - M0); gE[t0 + 1] = __expf(m_prev - M1);
                gF[t0] = __expf(-(b0 + M0)); gF[t0 + 1] = __expf(-(b1 + M1));
                gW[t0] = __expf(c0 - Ml); gW[t0 + 1] = __expf(c1 - Ml);
                if (lane == 0) gS[0] = __expf(m_prev - Ml);
                m_prev = bL + Ml;
            }
            __syncthreads();
#pragma unroll
            for (int i = 0; i < 2; ++i) { const int t = (tid + 512 * i) >> 3; const float w = gW[t];
#pragma unroll
                for (int jj = 0; jj < 4; ++jj) { const int dv = 4 * (tid & 7) + jj; Vt[dv * 136 + t] = f2bf(vv[i][jj]); Vwt[dv * 136 + t] = f2bf(vv[i][jj] * w); } }
            if (tid < 128) Vwt[32 * 136 + tid] = f2bf(gW[tid]);
            f32x4 accS[8];
#pragma unroll
            for (int n = 0; n < 8; ++n) { accS[n] = (f32x4){0.f, 0.f, 0.f, 0.f};
                if (n <= wave) {
#pragma unroll
                    for (int ks = 0; ks < 8; ++ks) { const bf16x8 kf = *(const bf16x8*)(Ks + (16 * n + l15) * 264 + 32 * ks + 8 * lq); accS[n] = MFMA16(qf[ks], kf, accS[n]); } } }
#pragma unroll
            for (int n = 0; n < 8; ++n) if (n <= (wave | 1)) { const int s = 16 * n + l15; const float cs = gc[s];
#pragma unroll
                for (int r = 0; r < 4; ++r) { const int t = 16 * wave + 4 * lq + r; const float val = (n <= wave && s <= t) ? accS[n][r] * __expf(cs - gM[t]) : 0.f; Ps[t * 136 + s] = f2bf(val); } }
            __syncthreads();
            f32x4 oi[3], oc[3];
#pragma unroll
            for (int nt = 0; nt < 3; ++nt) { oi[nt] = (f32x4){0.f, 0.f, 0.f, 0.f}; oc[nt] = (f32x4){0.f, 0.f, 0.f, 0.f}; }
#pragma unroll
            for (int kk = 0; kk < 4; ++kk) if (kk <= (wave >> 1)) { const bf16x8 pf = *(const bf16x8*)(Ps + (16 * wave + l15) * 136 + 32 * kk + 8 * lq);
#pragma unroll
                for (int nt = 0; nt < 3; ++nt) { const bf16x8 vf = *(const bf16x8*)(Vt + (16 * nt + l15) * 136 + 32 * kk + 8 * lq); oi[nt] = MFMA16(pf, vf, oi[nt]); } }
#pragma unroll
            for (int ks = 0; ks < 8; ++ks)
#pragma unroll
                for (int nt = 0; nt < 3; ++nt) { const bf16x8 cf = *(const bf16x8*)(Ct + (16 * nt + l15) * 264 + 32 * ks + 8 * lq); oc[nt] = MFMA16(qf[ks], cf, oc[nt]); }
#pragma unroll
            for (int r = 0; r < 4; ++r) { const int t = 16 * wave + 4 * lq + r; const float E = gE[t], F = gF[t];
                float den = oi[2][r] + E * oc[2][r]; den = __shfl(den, lane & 48);
                const float inv = 1.0f / fmaxf(fabsf(den), F);
#pragma unroll
                for (int nt = 0; nt < 2; ++nt) Hm[(size_t)(row0 + t) * 2048 + 256 * h + 32 * sl + 16 * nt + l15] = f2bf((oi[nt][r] + E * oc[nt][r]) * inv); }
            { const float decay = gS[0];
#pragma unroll
              for (int a = 0; a < 3; ++a)
#pragma unroll
                for (int c = 0; c < 2; ++c) accC[a][c] = accC[a][c] * decay; }
#pragma unroll
            for (int kk = 0; kk < 4; ++kk) {
                bf16x8 ktf[2];
#pragma unroll
                for (int ntk = 0; ntk < 2; ++ntk) { const int dk = 32 * wave + 16 * ntk + l15;
#pragma unroll
                    for (int j = 0; j < 8; ++j) ktf[ntk][j] = (short)Ks[(32 * kk + 8 * lq + j) * 264 + dk]; }
#pragma unroll
                for (int mt = 0; mt < 3; ++mt) { const bf16x8 vwf = *(const bf16x8*)(Vwt + (16 * mt + l15) * 136 + 32 * kk + 8 * lq);
#pragma unroll
                    for (int ntk = 0; ntk < 2; ++ntk) accC[mt][ntk] = MFMA16(vwf, ktf[ntk], accC[mt][ntk]); }
            }
            __syncthreads();
#pragma unroll
            for (int mt = 0; mt < 3; ++mt)
#pragma unroll
                for (int ntk = 0; ntk < 2; ++ntk)
#pragma unroll
                    for (int r = 0; r < 4; ++r) Ct[(16 * mt + 4 * lq + r) * 264 + 32 * wave + 16 * ntk + l15] = f2bf(accC[mt][ntk][r]);
        }
        __syncthreads();
    }
}

__device__ void mnorm_phase(const Params& p) {
    const int lane = threadIdx.x & 63, wave = threadIdx.x >> 6;
    const u16* XM = (const u16*)(p.ws + OFF_XM); const u16* Hm = (const u16*)(p.ws + OFF_H); u16* Y0 = (u16*)(p.ws + OFF_Y0);
    const int c = 256 * wave + 4 * lane;
    float cw[4][4];
#pragma unroll
    for (int j = 0; j < 4; ++j) { const f32x4 a = *(const f32x4*)(p.in[10] + j * 2048 + c);
#pragma unroll
        for (int i = 0; i < 4; ++i) cw[j][i] = a[i]; }
    const f32x4 cbv = *(const f32x4*)(p.in[11] + c), skip = *(const f32x4*)(p.in[19] + c), gn = *(const f32x4*)(p.in[20] + c);
    for (int blk = blockIdx.x; blk < 256; blk += gridDim.x) {
#pragma unroll 2
        for (int tt = 0; tt < 64; ++tt) {
            const int tk = blk * 64 + tt, s = tk & (SEQL - 1);
            const u32x2 hr = *(const u32x2*)(Hm + (size_t)tk * 2048 + c);
            float hv[4] = {bflo(hr.x), bfhi(hr.x), bflo(hr.y), bfhi(hr.y)};
            const float mu = wave_sum(hv[0] + hv[1] + hv[2] + hv[3]) * (1.0f / 256.0f);
            float d[4], sq = 0.f;
#pragma unroll
            for (int i = 0; i < 4; ++i) { d[i] = hv[i] - mu; sq += d[i] * d[i]; }
            const float rs = rsqrtf(wave_sum(sq) * (1.0f / 256.0f) + 1e-6f);
            float xmc[4] = {cbv[0], cbv[1], cbv[2], cbv[3]};
#pragma unroll
            for (int j = 0; j < 4; ++j) if (s - 3 + j >= 0) { const u32x2 xr = *(const u32x2*)(XM + (size_t)(tk - 3 + j) * 2048 + c);
                xmc[0] += cw[j][0] * bflo(xr.x); xmc[1] += cw[j][1] * bfhi(xr.x); xmc[2] += cw[j][2] * bflo(xr.y); xmc[3] += cw[j][3] * bfhi(xr.y); }
            u16* zp = Y0 + (size_t)tk * 4096 + 2048 + c; const u32x2 zr = *(const u32x2*)zp;
            const float z[4] = {bflo(zr.x), bfhi(zr.x), bflo(zr.y), bfhi(zr.y)};
            float o[4];
#pragma unroll
            for (int i = 0; i < 4; ++i) o[i] = (d[i] * rs * gn[i] + skip[i] * siluf_(xmc[i])) * siluf_(z[i]);
            u32x2 w; w.x = pk2(o[0], o[1]); w.y = pk2(o[2], o[3]); *(u32x2*)zp = w;
        }
    }
}

__device__ __forceinline__ float wave_sum_dpp(float v) {
    v += dppf<0xB1>(v); v += dppf<0x4E>(v); v += dppf<0x141>(v); v += dppf<0x140>(v);
    const int iv = __float_as_int(v);
    return __int_as_float(__builtin_amdgcn_readlane(iv, 0)) + __int_as_float(__builtin_amdgcn_readlane(iv, 16)) + __int_as_float(__builtin_amdgcn_readlane(iv, 32)) + __int_as_float(__builtin_amdgcn_readlane(iv, 48));
}
__device__ void rwkv_phase(const Params& p, unsigned char* smem) {
    constexpr int TC = 16, NCH = SEQL / TC;
    u16* W2t = (u16*)smem;
    u16* A2t = W2t + 64 * 104;
    float* vec = (float*)(A2t + 64 * 104);
    float* scal = vec + 2 * TC * 384;
    float* Yraw = scal + 2 * TC * 4;
    u16* raw = (u16*)(Yraw + 2 * TC * 64);
    u16* twa = raw + 3 * 17 * 64;
    const int tid = threadIdx.x, lane = tid & 63, wave = __builtin_amdgcn_readfirstlane(tid >> 6);
    const int l15 = lane & 15, lq = lane >> 4;
    u16* R = (u16*)(p.ws + OFF_R); const u16* Kb = (const u16*)(p.ws + OFF_KK); const u16* Vb = (const u16*)(p.ws + OFF_V); const u16* P = (const u16*)(p.ws + OFF_P);
    for (int unit = blockIdx.x; unit < 256; unit += gridDim.x) {
        const int b = unit >> 6, h = unit & 63, hc = 64 * h;
        for (int e = tid; e < 6144; e += 512) { const int j = e >> 6, k = e & 63; W2t[k * 104 + j] = f2bf(p.in[30][(size_t)j * 4096 + hc + k]); A2t[k * 104 + j] = f2bf(p.in[33][(size_t)j * 4096 + hc + k]); }
        __syncthreads();
        if (wave < 4) {
            const int rp = tid >> 3, j8 = tid & 7;
            f32x2 S0[4], S1[4];
#pragma unroll
            for (int i = 0; i < 4; ++i) { S0[i] = (f32x2){0.f, 0.f}; S1[i] = (f32x2){0.f, 0.f}; }
            for (int pc = -1; pc <= NCH; ++pc) {
                const bool act = (pc >= 0 && pc < NCH);
                const float* vbase = vec + (pc & 1) * TC * 384 + 8 * j8;
                const float* sbase = scal + (pc & 1) * TC * 4;
                float* ybase = Yraw + (pc & 1) * TC * 64;
#pragma unroll 1
                for (int q = 0; q < 4; ++q) {
                    if (act) {
#pragma unroll
                        for (int tt = 0; tt < 4; ++tt) {
                            const int t = 4 * q + tt;
                            const float* vb = vbase + t * 384;
                            const f32x4 d0 = *(const f32x4*)vb, d1 = *(const f32x4*)(vb + 4), a0 = *(const f32x4*)(vb + 64), a1 = *(const f32x4*)(vb + 68);
                            const f32x4 b0 = *(const f32x4*)(vb + 128), b1 = *(const f32x4*)(vb + 132), k0 = *(const f32x4*)(vb + 192), k1 = *(const f32x4*)(vb + 196);
                            const f32x4 w0 = *(const f32x4*)(vb + 256), w1 = *(const f32x4*)(vb + 260);
                            const float v0 = vbase[t * 384 - 8 * j8 + 320 + rp], v1 = vbase[t * 384 - 8 * j8 + 352 + rp];
                            const f32x2 sc = *(const f32x2*)(sbase + t * 4);
                            const f32x2 av[4] = {{a0[0], a0[1]}, {a0[2], a0[3]}, {a1[0], a1[1]}, {a1[2], a1[3]}};
                            const f32x2 wv[4] = {{w0[0], w0[1]}, {w0[2], w0[3]}, {w1[0], w1[1]}, {w1[2], w1[3]}};
                            const f32x2 dv[4] = {{d0[0], d0[1]}, {d0[2], d0[3]}, {d1[0], d1[1]}, {d1[2], d1[3]}};
                            const f32x2 bv[4] = {{b0[0], b0[1]}, {b0[2], b0[3]}, {b1[0], b1[1]}, {b1[2], b1[3]}};
                            const f32x2 kv[4] = {{k0[0], k0[1]}, {k0[2], k0[3]}, {k1[0], k1[1]}, {k1[2], k1[3]}};
                            f32x2 q1 = S0[0] * av[0], q2 = S0[0] * wv[0], q3 = S1[0] * av[0], q4 = S1[0] * wv[0];
#pragma unroll
                            for (int i = 1; i < 4; ++i) { q1 += S0[i] * av[i]; q2 += S0[i] * wv[i]; q3 += S1[i] * av[i]; q4 += S1[i] * wv[i]; }
                            float p1 = q1.x + q1.y, p2 = q2.x + q2.y, p3 = q3.x + q3.y, p4 = q4.x + q4.y;
                            p1 += dppf<0xB1>(p1); p2 += dppf<0xB1>(p2); p3 += dppf<0xB1>(p3); p4 += dppf<0xB1>(p4);
                            p1 += dppf<0x4E>(p1); p2 += dppf<0x4E>(p2); p3 += dppf<0x4E>(p3); p4 += dppf<0x4E>(p4);
                            p1 += dppf<0x141>(p1); p2 += dppf<0x141>(p2); p3 += dppf<0x141>(p3); p4 += dppf<0x141>(p4);
                            const float y0 = p2 + p1 * sc.x + v0 * sc.y, y1 = p4 + p3 * sc.x + v1 * sc.y;
                            const f32x2 sa0 = {p1, p1}, sa1 = {p3, p3}, vv0 = {v0, v0}, vv1 = {v1, v1};
#pragma unroll
                            for (int i = 0; i < 4; ++i) { S0[i] = S0[i] * dv[i] + sa0 * bv[i] + vv0 * kv[i]; S1[i] = S1[i] * dv[i] + sa1 * bv[i] + vv1 * kv[i]; }
                            if (j8 == 0) { ybase[t * 64 + rp] = y0; ybase[t * 64 + 32 + rp] = y1; }
                        }
                    }
                    __syncthreads();
                }
            }
        } else {
            const int w4 = wave - 4, ptid = tid - 256, k = lane;
            const float mu_r = p.in[25][hc + k], mu_k = p.in[25][4096 + hc + k], mu_v = p.in[25][8192 + hc + k];
            const float w0k = p.in[28][hc + k], a0k = p.in[31][hc + k], kkk = p.in[34][hc + k], kak = p.in[35][hc + k], rkk = p.in[36][hc + k];
            const float gng = p.in[37][hc + k], gnb = p.in[38][hc + k];
            u32x4 pfP[4]; u32x2 pfR[4];
#define RW_PREFETCH(c) do { const int row0_ = b * SEQL + (c) * TC; \
                _Pragma("unroll") for (int i = 0; i < 2; ++i) { const int it = ptid + 256 * i; const int mt = it / 192, rem = it - mt * 192, t_ = rem / 12, g_ = rem - t_ * 12; \
                    if (it < 384) { const size_t row_ = (size_t)(row0_ + t_); pfP[2 * i] = *(const u32x4*)(P + row_ * 384 + mt * 192 + 8 * g_); \
                        pfP[2 * i + 1] = ((c) == 0 && t_ == 0) ? (u32x4){0u, 0u, 0u, 0u} : *(const u32x4*)(P + (row_ - 1) * 384 + mt * 192 + 96 + 8 * g_); } } \
                _Pragma("unroll") for (int i = 0; i < 4; ++i) { const int it = ptid + 256 * i; const int ar = it / 272, rem = it - ar * 272, rr_ = rem >> 4, c4 = rem & 15; \
                    if (it < 816) { const u16* src_ = ar == 0 ? (const u16*)R : ar == 1 ? Kb : Vb; \
                        pfR[i] = ((c) == 0 && rr_ == 0) ? (u32x2){0u, 0u} : *(const u32x2*)(src_ + (size_t)(row0_ - 1 + rr_) * 4096 + hc + 4 * c4); } } } while (0)
            RW_PREFETCH(0);
            for (int pc = -1; pc <= NCH; ++pc) {
                const int cn = pc + 1;
                const bool prep = (cn < NCH);
                float* vnext = vec + (cn & 1) * TC * 384;
                float* snext = scal + (cn & 1) * TC * 4;
                if (pc >= 1) {
                    const int cp = pc - 1; const float* vprev = vec + (cp & 1) * TC * 384; const float* sprev = scal + (cp & 1) * TC * 4; const float* yprev = Yraw + (cp & 1) * TC * 64;
#pragma unroll
                    for (int i = 0; i < 4; ++i) { const int t = w4 + 4 * i; const size_t row = (size_t)(b * SEQL + cp * TC + t);
                        const float y = yprev[t * 64 + k], mu = wave_sum_dpp(y) * (1.0f / 64.0f), d = y - mu, var = wave_sum_dpp(d * d) * (1.0f / 64.0f);
                        const float o = d * rsqrtf(var + 64e-5f) * gng + gnb + sprev[t * 4 + 2] * vprev[t * 384 + 320 + k];
                        R[row * 4096 + hc + k] = f2bf(o); }
                }
                if (prep) {
#pragma unroll
                    for (int i = 0; i < 2; ++i) { const int it = ptid + 256 * i; const int mt = it / 192, rem = it - mt * 192, t_ = rem / 12, g_ = rem - t_ * 12;
                        if (it < 384) { float c8[8], p8[8]; unpack8(pfP[2 * i], c8); unpack8(pfP[2 * i + 1], p8);
#pragma unroll
                            for (int j = 0; j < 8; ++j) { const float s = c8[j] + p8[j]; c8[j] = mt == 0 ? tanhf(s) : s; }
                            *(u32x4*)(twa + (mt * 16 + t_) * 104 + 8 * g_) = pack8(c8); } }
#pragma unroll
                    for (int i = 0; i < 4; ++i) { const int it = ptid + 256 * i; const int ar = it / 272, rem = it - ar * 272, rr_ = rem >> 4, c4 = rem & 15;
                        if (it < 816) *(u32x2*)(raw + (ar * 17 + rr_) * 64 + 4 * c4) = pfR[i]; }
                }
                __syncthreads();
                if (prep) {
                    const int mt = w4 >> 1, nh = w4 & 1; const u16* Bt_ = mt ? A2t : W2t;
                    f32x4 acc[2] = {{0.f, 0.f, 0.f, 0.f}, {0.f, 0.f, 0.f, 0.f}};
#pragma unroll
                    for (int ks = 0; ks < 3; ++ks) { const bf16x8 af = *(const bf16x8*)(twa + (mt * 16 + l15) * 104 + 32 * ks + 8 * lq);
#pragma unroll
                        for (int nt = 0; nt < 2; ++nt) { const bf16x8 bfr = *(const bf16x8*)(Bt_ + (32 * nh + 16 * nt + l15) * 104 + 32 * ks + 8 * lq); acc[nt] = MFMA16(af, bfr, acc[nt]); } }
#pragma unroll
                    for (int nt = 0; nt < 2; ++nt)
#pragma unroll
                        for (int r = 0; r < 4; ++r) vnext[(4 * lq + r) * 384 + mt * 128 + 32 * nh + 16 * nt + l15] = acc[nt][r];
                }
                __syncthreads();
                if (prep) {
#pragma unroll
                    for (int i = 0; i < 4; ++i) { const int t = w4 + 4 * i; float* vb = vnext + t * 384;
                        const float wl = w0k + vb[k], al = a0k + vb[128 + k];
                        const float rr = bf2f(raw[(0 * 17 + t + 1) * 64 + k]), rp_ = bf2f(raw[(0 * 17 + t) * 64 + k]);
                        const float kr_ = bf2f(raw[(1 * 17 + t + 1) * 64 + k]), kp = bf2f(raw[(1 * 17 + t) * 64 + k]);
                        const float vr = bf2f(raw[(2 * 17 + t + 1) * 64 + k]), vp = bf2f(raw[(2 * 17 + t) * 64 + k]);
                        const float r = rr + (rp_ - rr) * mu_r, kx0 = kr_ + (kp - kr_) * mu_k, v = vr + (vp - vr) * mu_v;
                        const float wlog = -softplusf_(-wl) - 0.5f, dec = __expf(-__expf(wlog)), a = sigmoidf_(al);
                        const float kkv = kx0 * kkk, ss = wave_sum_dpp(kkv * kkv), kk = kkv / fmaxf(sqrtf(ss), 1e-12f);
                        const float kmod = kx0 * (1.0f + (a - 1.0f) * kak), kb = kk * a;
                        const float br = wave_sum_dpp(kb * r), krs = wave_sum_dpp(kmod * r), bon = wave_sum_dpp(r * kmod * rkk);
                        vb[k] = dec; vb[64 + k] = -kk; vb[128 + k] = kb; vb[192 + k] = kmod; vb[256 + k] = dec * r; vb[320 + k] = v;
                        if (lane == 0) { snext[t * 4] = br; snext[t * 4 + 1] = krs; snext[t * 4 + 2] = bon; } }
                }
                __syncthreads();
                if (cn + 1 < NCH) RW_PREFETCH(cn + 1);
                __syncthreads();
            }
#undef RW_PREFETCH
        }
        __syncthreads();
    }
}


__global__ void __launch_bounds__(512, 2) mega(Params p) {
    extern __shared__ __attribute__((aligned(16))) unsigned char smem[];
    cg::grid_group grid = cg::this_grid();
    const int lo = p.ph_lo, hi = p.ph_hi;
#define IN(k) (lo <= (k) && (k) < hi)
#define SEAM(k) do { if (IN(k) && IN((k) + 1)) grid.sync(); } while (0)
    unsigned char* ws = p.ws;
    PG8_LAS unsigned char* glds = (PG8_LAS unsigned char*)smem;
    if (IN(0)) {
        tconv(smem, p.in[2], 8192, 0, 8192, 2048, (u16*)(ws + OFF_W0IN), 2048);
        tconv(smem, p.in[21], 2048, 0, 2048, 4096, (u16*)(ws + OFF_W0OUT), 4096);
        prep_small(p);
        rows_phase<0>(p);
    }
    SEAM(0);
    if (IN(1)) {
        pg8::Gemm g{(const u16*)(ws + OFF_H), (const u16*)(ws + OFF_W0IN), NTOK, 8192, 2048}; pg8::StaticOrder S; S.init(NTOK, 8192, gridDim.x, blockIdx.x);
        pg8::EpiG<F1> E{F1{(u16*)(ws + OFF_XR), (u16*)(ws + OFF_XM), (u16*)(ws + OFF_Y0)}};
        pg8::gemm_phase(glds, g, S, E);
    }
    SEAM(1);
    if (IN(2)) {
        mqk_phase(p, smem);
        lru_phase<1>(p, smem);
        tconv(smem, p.in[24], 16384, 0, 8192, 2048, (u16*)(ws + OFF_W1), 2048);
    }
    SEAM(2);
    if (IN(3)) lru_carry(p);
    SEAM(3);
    if (IN(4)) { mlstm_phase(p, smem); lru_phase<2>(p, smem); }
    SEAM(4);
    if (IN(5)) mnorm_phase(p);
    SEAM(5);
    if (IN(6)) {
        pg8::Gemm g{(const u16*)(ws + OFF_Y0), (const u16*)(ws + OFF_W0OUT), NTOK, 2048, 4096}; pg8::StaticOrder S; S.init(NTOK, 2048, gridDim.x, blockIdx.x);
        pg8::EpiG<F2> E{F2{(float*)(ws + OFF_M0)}};
        pg8::gemm_phase(glds, g, S, E);
    }
    SEAM(6);
    if (IN(7)) {
        rows_phase<1>(p);
        tconv(smem, p.in[24], 16384, 8192, 4096, 2048, (u16*)(ws + OFF_W1) + (size_t)8192 * 2048, 2048);
        prep_extras(p);
    }
    SEAM(7);
    if (IN(8)) {
        pg8::Gemm g{(const u16*)(ws + OFF_H), (const u16*)(ws + OFF_W1), NTOK, 12800, 2048}; pg8::StaticOrder S; S.init(NTOK, 12800, gridDim.x, blockIdx.x);
        pg8::EpiG<F3> E{F3{(u16*)(ws + OFF_R), (u16*)(ws + OFF_P)}};
        pg8::gemm_phase(glds, g, S, E);
    }
    SEAM(8);
    if (IN(9)) {
        rwkv_phase(p, smem);
        tconv(smem, p.in[24], 16384, 12288, 4096, 2048, (u16*)(ws + OFF_W1Z), 2048);
        tconv(smem, p.in[39], 2048, 0, 2048, 4096, (u16*)(ws + OFF_W1OUT), 4096);
    }
    SEAM(9);
    if (IN(10)) {
        pg8::Gemm g{(const u16*)(ws + OFF_H), (const u16*)(ws + OFF_W1Z), NTOK, 4096, 2048}; pg8::StaticOrder S; S.init(NTOK, 4096, gridDim.x, blockIdx.x);
        pg8::EpiG<F4> E{F4{(u16*)(ws + OFF_R)}};
        pg8::gemm_phase(glds, g, S, E);
    }
    SEAM(10);
    if (IN(11)) {
        pg8::Gemm g{(const u16*)(ws + OFF_R), (const u16*)(ws + OFF_W1OUT), NTOK, 2048, 4096}; pg8::StaticOrder S; S.init(NTOK, 2048, gridDim.x, blockIdx.x);
        pg8::EpiG<F2> E{F2{(float*)(ws + OFF_M1)}};
        pg8::gemm_phase(glds, g, S, E);
    }
    SEAM(11);
    if (IN(12)) rows_phase<2>(p);
}

extern "C" void kernel_launch(void* const* d_in, const int* in_sizes, int n_in, void* d_out, int out_size, void* d_ws, size_t ws_size, hipStream_t stream) {
    static int grid_blocks = 0;
    if (!grid_blocks) {
        if (n_in != 41 || ws_size < WS_NEED) { fprintf(stderr, "kernel_launch: unexpected n_in %d / ws_size %zu (need %zu)\n", n_in, ws_size, (size_t)WS_NEED); grid_blocks = -1; }
        else {
            int dev = 0, cus = 0, per_cu = 0;
            hipGetDevice(&dev);
            hipDeviceGetAttribute(&cus, hipDeviceAttributeMultiprocessorCount, dev);
            if (hipFuncSetAttribute((const void*)mega, hipFuncAttributeMaxDynamicSharedMemorySize, LDS_BYTES) != hipSuccess) fprintf(stderr, "kernel_launch: hipFuncSetAttribute failed\n");
            hipOccupancyMaxActiveBlocksPerMultiprocessor(&per_cu, (const void*)mega, 512, LDS_BYTES);
            if (per_cu < 1) { fprintf(stderr, "kernel_launch: occupancy query says %d blocks/CU\n", per_cu); per_cu = 1; }
            grid_blocks = cus * 1;
            if (grid_blocks > cus * per_cu) grid_blocks = cus * per_cu;
        }
    }
    if (grid_blocks <= 0) return;
    Params p{};
    for (int i = 0; i < 41; ++i) p.in[i] = (const float*)d_in[i];
    p.out = (float*)d_out; p.ws = (unsigned char*)d_ws;
#if N_LAUNCH_MODE == 1
    p.ph_lo = 0; p.ph_hi = NPH;
    { void* args[] = {&p};
      hipError_t e = hipLaunchCooperativeKernel((const void*)mega, dim3(grid_blocks), dim3(512), args, LDS_BYTES, stream);
      if (e != hipSuccess) fprintf(stderr, "cooperative launch failed: %s (grid %d)\n", hipGetErrorString(e), grid_blocks); }
#else
    for (int ph = 0; ph < NPH; ++ph) { p.ph_lo = ph; p.ph_hi = ph + 1; void* args[] = {&p};
        hipError_t e = hipLaunchCooperativeKernel((const void*)mega, dim3(grid_blocks), dim3(512), args, LDS_BYTES, stream);
        if (e != hipSuccess) { fprintf(stderr, "launch %d failed: %s (grid %d)\n", ph, hipGetErrorString(e), grid_blocks); break; } }
#endif
}
```

```cpp
#include <hip/hip_runtime.h>
#include <hip/hip_cooperative_groups.h>
#include <cstdio>
namespace cg = cooperative_groups;

#ifndef REP_MASK
#define REP_MASK 0
#endif
#ifndef PROBE_PH
#define PROBE_PH -1
#endif
#define REPS(k) for (int rep_ = 0; rep_ < 1 + ((REP_MASK >> (k)) & 1); ++rep_)
#ifndef RWKV_CHUNKED
#define RWKV_CHUNKED 1
#endif
#ifndef N_LAUNCH_MODE
#define N_LAUNCH_MODE 1
#endif

typedef unsigned short u16;
typedef short bf16x8 __attribute__((ext_vector_type(8)));
typedef float f32x4 __attribute__((ext_vector_type(4)));
typedef float f32x2 __attribute__((ext_vector_type(2)));
typedef unsigned u32x4 __attribute__((ext_vector_type(4)));
typedef unsigned u32x2 __attribute__((ext_vector_type(2)));

constexpr int NTOK = 16384, DM = 2048, SEQL = 4096;
constexpr size_t MiB = (size_t)1 << 20;
constexpr size_t OFF_H = 0;
constexpr size_t OFF_XR = 64 * MiB;
constexpr size_t OFF_XM = 128 * MiB;
constexpr size_t OFF_Y0 = 192 * MiB;
constexpr size_t OFF_Q = 320 * MiB;
constexpr size_t OFF_KX = 384 * MiB;
constexpr size_t OFF_W0IN = 448 * MiB;
constexpr size_t OFF_W0OUT = 480 * MiB;
constexpr size_t OFF_SMALL = 496 * MiB;
constexpr size_t OFF_G = OFF_SMALL;
constexpr size_t OFF_LRUA = OFF_SMALL + 1 * MiB;
constexpr size_t OFF_LRUH = OFF_SMALL + 3 * MiB;
constexpr size_t OFF_LRUC = OFF_SMALL + 5 * MiB;
constexpr size_t OFF_LRUW = OFF_SMALL + 7 * MiB;
constexpr size_t OFF_WGT = OFF_SMALL + 8 * MiB;
constexpr size_t OFF_M0 = OFF_XR;
constexpr size_t OFF_R = 64 * MiB, OFF_KK = 192 * MiB, OFF_V = 320 * MiB;
constexpr size_t OFF_W1 = 448 * MiB;
constexpr size_t OFF_P = 498 * MiB;
constexpr size_t OFF_W1Z = 448 * MiB, OFF_W1OUT = 464 * MiB;
constexpr size_t OFF_M1 = OFF_V;
constexpr size_t WS_NEED = 510 * MiB;
constexpr int LDS_BYTES = 160 * 1024;
constexpr int NPH = 13;

struct Params { const float* in[41]; float* out; unsigned char* ws; int ph_lo, ph_hi; };

__device__ __forceinline__ unsigned pk2(float lo, float hi) { unsigned r; asm volatile("v_cvt_pk_bf16_f32 %0, %1, %2" : "=v"(r) : "v"(lo), "v"(hi)); return r; }
__device__ __forceinline__ u16 f2bf(float f) { return (u16)(pk2(f, 0.f) & 0xffffu); }
__device__ __forceinline__ float bf2f(u16 v) { return __uint_as_float(((unsigned)v) << 16); }
__device__ __forceinline__ float bflo(unsigned w) { return __uint_as_float(w << 16); }
__device__ __forceinline__ float bfhi(unsigned w) { return __uint_as_float(w & 0xffff0000u); }
__device__ __forceinline__ void unpack8(u32x4 w, float* f) { f[0] = bflo(w.x); f[1] = bfhi(w.x); f[2] = bflo(w.y); f[3] = bfhi(w.y); f[4] = bflo(w.z); f[5] = bfhi(w.z); f[6] = bflo(w.w); f[7] = bfhi(w.w); }
__device__ __forceinline__ u32x4 pack8(const float* f) { u32x4 w; w.x = pk2(f[0], f[1]); w.y = pk2(f[2], f[3]); w.z = pk2(f[4], f[5]); w.w = pk2(f[6], f[7]); return w; }
__device__ __forceinline__ bf16x8 as_frag(u32x4 w) { union { u32x4 u; bf16x8 b; } c; c.u = w; return c.b; }
__device__ __forceinline__ float sigmoidf_(float x) { return 1.0f / (1.0f + __expf(-x)); }
__device__ __forceinline__ float siluf_(float x) { return x / (1.0f + __expf(-x)); }
__device__ __forceinline__ float softplusf_(float x) { return fmaxf(x, 0.f) + log1pf(__expf(-fabsf(x))); }
__device__ __forceinline__ float wave_sum(float v) {
#pragma unroll
    for (int o = 32; o; o >>= 1) v += __shfl_xor(v, o);
    return v;
}
template <int CTRL> __device__ __forceinline__ float dppf(float v) { return __int_as_float(__builtin_amdgcn_update_dpp(0, __float_as_int(v), CTRL, 0xF, 0xF, false)); }
__device__ __forceinline__ float wave_sum_dpp(float v) {
    v += dppf<0xB1>(v); v += dppf<0x4E>(v); v += dppf<0x141>(v); v += dppf<0x140>(v);
    const int iv = __float_as_int(v);
    return __int_as_float(__builtin_amdgcn_readlane(iv, 0)) + __int_as_float(__builtin_amdgcn_readlane(iv, 16)) + __int_as_float(__builtin_amdgcn_readlane(iv, 32)) + __int_as_float(__builtin_amdgcn_readlane(iv, 48));
}
#define MFMA16(a, b, c) __builtin_amdgcn_mfma_f32_16x16x32_bf16((a), (b), (c), 0, 0, 0)

namespace pg8 {
#define PG8_LAS __attribute__((address_space(3)))
typedef unsigned short bf16_t;
constexpr int BM = 256, BK = 64, HALF = 128, HTB = HALF * BK * 2, STAGE_BYTES = 8 * HTB, NXCD = 8, WGM = 8;
__host__ __device__ __forceinline__ int lds_byte(int r, int c) { const int st = (r >> 4) * 2 + (c >> 5), rr = r & 15, cc = c & 31, ob = rr * 64 + cc * 2; return st * 1024 + (ob ^ (((ob >> 9) & 1) << 5)); }
__host__ __device__ __forceinline__ void stage_rc(int b, int& R, int& C) { const int st = b / 1024, sb = b % 1024, swz = sb ^ (((sb >> 9) & 1) << 5); R = (st >> 1) * 16 + swz / 64; C = (st & 1) * 32 + (swz % 64) / 2; }
__host__ __device__ __forceinline__ int perm32(int rho) { const int n = rho >> 4, i = rho & 15; return 8 * (i >> 2) + 4 * n + (i & 3); }
struct Unit { int pm, pn; };
struct Gemm { const bf16_t* A; const bf16_t* Bt; int M, N, K; };
struct StaticOrder {
    int nM, nN, nwg, G, c;
    __host__ __device__ void init(int M, int N, int G_, int c_) { nM = M / BM; nN = N / BM; nwg = nM * nN; G = G_; c = c_; }
    __host__ __device__ bool next(int i, Unit& u) const {
        const long L = (long)i * G + c; if (L >= nwg) return false;
        int wgid = (int)L; { const int q = nwg / NXCD, r = nwg % NXCD, xcd = wgid % NXCD, off = wgid / NXCD; wgid = (xcd < r ? xcd * (q + 1) : r * (q + 1) + (xcd - r) * q) + off; }
        const int nig = WGM * nN, gid = wgid / nig, fm = gid * WGM, gsz = (nM - fm) < WGM ? (nM - fm) : WGM;
        u.pm = fm + ((wgid % nig) % gsz); u.pn = (wgid % nig) / gsz; return true;
    }
};
template <class F> struct EpiG {
    static constexpr bool PERM = true;
    F f;
    __device__ __forceinline__ void operator()(const f32x4 (&acc)[2][2][4][2], const Unit& u, int wr, int wc, int fr, int fq) const {
        const int row0 = u.pm * BM + wr * 64 + fr, col0 = u.pn * BM + wc * 32 + 8 * fq;
#pragma unroll
        for (int ai = 0; ai < 2; ++ai)
#pragma unroll
            for (int m = 0; m < 4; ++m)
#pragma unroll
                for (int bj = 0; bj < 2; ++bj) f(row0 + ai * HALF + m * 16, col0 + bj * HALF, acc[ai][bj][m][0], acc[ai][bj][m][1]);
    }
};

template <class Epi>
__device__ __forceinline__ void gemm_phase(PG8_LAS unsigned char* lds, const Gemm g, const StaticOrder& S, const Epi& E) {
    const int tid = threadIdx.x, wid = __builtin_amdgcn_readfirstlane(tid >> 6), lane = tid & 63, wr = wid >> 2, wc = wid & 3, fr = lane & 15, fq = lane >> 4;
    const int K = g.K, nt = K / BK;
    unsigned voffA[2], voffB[2];
#pragma unroll
    for (int i = 0; i < 2; ++i) { int R, C; stage_rc(tid * 16 + i * 8192, R, C); const int Rb = Epi::PERM ? ((R & ~31) + perm32(R & 31)) : R;
        voffA[i] = (unsigned)(R * K + C) * 2u; voffB[i] = (unsigned)(Rb * K + C) * 2u; }
    const size_t kstep = (size_t)(BK * 2);
    const size_t hstep = (size_t)HALF * K * 2;
    const size_t tstep = 2 * hstep;
    const unsigned ldsw = (unsigned)wid * 1024u;
    const int aoff = lds_byte(wr * 64 + fr, fq * 8), boff = lds_byte(wc * 32 + fr, fq * 8);
#define PG8_SA(b, h) (((b) * 2 + (h)) * HTB)
#define PG8_SB(b, h) ((4 + (b) * 2 + (h)) * HTB)
#define PG8_STAGE(bufoff, gbase, voff) do { _Pragma("unroll") for (int _i = 0; _i < 2; ++_i) \
        __builtin_amdgcn_global_load_lds((const unsigned*)((const char*)(gbase) + (voff)[_i]), (PG8_LAS unsigned*)(lds + (bufoff) + ldsw + _i * 8192), 16, 0, 0); } while (0)
#define PG8_LDA(dst, b, h) do { _Pragma("unroll") for (int m = 0; m < 4; ++m) _Pragma("unroll") for (int k = 0; k < 2; ++k) dst[m][k] = *(const PG8_LAS bf16x8*)(lds + PG8_SA(b, h) + aoff + m * 2048 + k * 1024); } while (0)
#define PG8_LDB(dst, b, h) do { _Pragma("unroll") for (int n = 0; n < 2; ++n) _Pragma("unroll") for (int k = 0; k < 2; ++k) dst[n][k] = *(const PG8_LAS bf16x8*)(lds + PG8_SB(b, h) + boff + n * 2048 + k * 1024); } while (0)
#define PG8_MMA(ai, bj, At, Bt) do { __builtin_amdgcn_s_setprio(1); _Pragma("unroll") for (int m = 0; m < 4; ++m) _Pragma("unroll") for (int n = 0; n < 2; ++n) _Pragma("unroll") for (int k = 0; k < 2; ++k) \
        acc[ai][bj][m][n] = __builtin_amdgcn_mfma_f32_16x16x32_bf16(Bt[n][k], At[m][k], acc[ai][bj][m][n], 0, 0, 0); __builtin_amdgcn_s_setprio(0); } while (0)
#define PG8_WAIT_V(n) asm volatile("s_waitcnt vmcnt(" #n ")" ::: "memory")
#define PG8_WAIT_L(n) asm volatile("s_waitcnt lgkmcnt(" #n ")" ::: "memory")
#define PG8_BAR __builtin_amdgcn_s_barrier()
#define PG8_SCHED __builtin_amdgcn_sched_barrier(0)
    Unit cur, nxt; int ui = 0;
    if (!S.next(0, cur)) return;
    f32x4 acc[2][2][4][2];
#pragma unroll
    for (int a = 0; a < 2; ++a)
#pragma unroll
        for (int b = 0; b < 2; ++b)
#pragma unroll
            for (int m = 0; m < 4; ++m)
#pragma unroll
                for (int n = 0; n < 2; ++n) acc[a][b][m][n] = (f32x4){0.f, 0.f, 0.f, 0.f};
    bf16x8 At[4][2], B0[2][2], B1[2][2];
    const char* cA = (const char*)g.A + (size_t)cur.pm * tstep; const char* cB = (const char*)g.Bt + (size_t)cur.pn * tstep;
    PG8_STAGE(PG8_SB(0, 0), cB, voffB); PG8_STAGE(PG8_SA(0, 0), cA, voffA); PG8_STAGE(PG8_SB(0, 1), cB + hstep, voffB); PG8_STAGE(PG8_SA(0, 1), cA + hstep, voffA);
    if (wr == 1) PG8_BAR;
    PG8_WAIT_V(4); PG8_BAR;
    PG8_STAGE(PG8_SB(1, 0), cB + kstep, voffB); PG8_STAGE(PG8_SA(1, 0), cA + kstep, voffA); PG8_STAGE(PG8_SB(1, 1), cB + hstep + kstep, voffB);
    PG8_WAIT_V(6); PG8_BAR;
    for (;;) {
        const bool has_next = S.next(ui + 1, nxt);
        const char* nA = has_next ? (const char*)g.A + (size_t)nxt.pm * tstep : cA; const char* nB = has_next ? (const char*)g.Bt + (size_t)nxt.pn * tstep : cB;
        for (int t = 0; t < nt; t += 2) {
            const bool last = (t == nt - 2);
            const char* a1 = cA + (size_t)(t + 1) * kstep;
            const char* a2 = last ? nA : cA + (size_t)(t + 2) * kstep; const char* b2 = last ? nB : cB + (size_t)(t + 2) * kstep;
            const char* a3 = a2 + kstep; const char* b3 = b2 + kstep;
            PG8_LDB(B0, 0, 0); PG8_SCHED; PG8_LDA(At, 0, 0); PG8_STAGE(PG8_SA(1, 1), a1 + hstep, voffA);
            PG8_WAIT_L(8); PG8_BAR; PG8_WAIT_L(0); PG8_MMA(0, 0, At, B0); PG8_BAR; PG8_SCHED;
            PG8_LDB(B1, 0, 1); PG8_STAGE(PG8_SB(0, 0), b2, voffB);
            PG8_BAR; PG8_WAIT_L(0); PG8_MMA(0, 1, At, B1); PG8_BAR;
            PG8_LDA(At, 0, 1); PG8_STAGE(PG8_SA(0, 0), a2, voffA);
            PG8_BAR; PG8_WAIT_L(0); PG8_MMA(1, 0, At, B0); PG8_BAR; PG8_SCHED;
            PG8_STAGE(PG8_SB(0, 1), b2 + hstep, voffB);
            PG8_WAIT_V(6); PG8_BAR; PG8_MMA(1, 1, At, B1); PG8_BAR;
            PG8_LDB(B0, 1, 0); PG8_SCHED; PG8_LDA(At, 1, 0); PG8_STAGE(PG8_SA(0, 1), a2 + hstep, voffA);
            PG8_WAIT_L(8); PG8_BAR; PG8_WAIT_L(0); PG8_MMA(0, 0, At, B0); PG8_BAR; PG8_SCHED;
            PG8_LDB(B1, 1, 1); PG8_STAGE(PG8_SB(1, 0), b3, voffB);
            PG8_BAR; PG8_WAIT_L(0); PG8_MMA(0, 1, At, B1); PG8_BAR;
            PG8_LDA(At, 1, 1); PG8_STAGE(PG8_SA(1, 0), a3, voffA);
            PG8_BAR; PG8_WAIT_L(0); PG8_MMA(1, 0, At, B0); PG8_BAR; PG8_SCHED;
            PG8_STAGE(PG8_SB(1, 1), b3 + hstep, voffB);
            PG8_WAIT_V(6); PG8_BAR; PG8_MMA(1, 1, At, B1); PG8_BAR;
        }
        E(acc, cur, wr, wc, fr, fq);
        if (!has_next) break;
#pragma unroll
        for (int a = 0; a < 2; ++a)
#pragma unroll
            for (int b = 0; b < 2; ++b)
#pragma unroll
                for (int m = 0; m < 4; ++m)
#pragma unroll
                    for (int n = 0; n < 2; ++n) acc[a][b][m][n] = (f32x4){0.f, 0.f, 0.f, 0.f};
        cur = nxt; cA = nA; cB = nB; ++ui;
    }
    PG8_WAIT_V(0);
    if (wr == 0) PG8_BAR;
    PG8_BAR;
#undef PG8_SA
#undef PG8_SB
#undef PG8_STAGE
#undef PG8_LDA
#undef PG8_LDB
#undef PG8_MMA
#undef PG8_WAIT_V
#undef PG8_WAIT_L
#undef PG8_BAR
#undef PG8_SCHED
}
}

__device__ __forceinline__ void store8bf(u16* dst, f32x4 v0, f32x4 v1) { u32x4 w; w.x = pk2(v0[0], v0[1]); w.y = pk2(v0[2], v0[3]); w.z = pk2(v1[0], v1[1]); w.w = pk2(v1[2], v1[3]); *(u32x4*)dst = w; }
struct F1 { u16 *XR, *XM, *Y0;
    __device__ __forceinline__ void operator()(int row, int col, f32x4 v0, f32x4 v1) const {
        const int reg = col >> 11, cc = col & 2047;
        u16* dst = reg == 0 ? XR + (size_t)row * 2048 + cc : reg == 1 ? Y0 + (size_t)row * 4096 + cc : reg == 2 ? XM + (size_t)row * 2048 + cc : Y0 + (size_t)row * 4096 + 2048 + cc;
        store8bf(dst, v0, v1); } };
struct F2 { u16* C;
    __device__ __forceinline__ void operator()(int row, int col, f32x4 v0, f32x4 v1) const { store8bf(C + (size_t)row * 2048 + col, v0, v1); } };
struct F3 { u16 *RKV, *P;
    __device__ __forceinline__ void operator()(int row, int col, f32x4 v0, f32x4 v1) const {
        if (col < 12288) { const int reg = col >> 12, cc = col & 4095; store8bf(RKV + (size_t)reg * ((size_t)NTOK * 4096) + (size_t)row * 4096 + cc, v0, v1); }
        else { const int cc = col - 12288; if (cc < 384) store8bf(P + (size_t)row * 384 + cc, v0, v1); } } };
struct F4 { u16* R;
    __device__ __forceinline__ void operator()(int row, int col, f32x4 v0, f32x4 v1) const {
        u16* d = R + (size_t)row * 4096 + col; const u32x4 w = *(const u32x4*)d; float y[8]; unpack8(w, y);
        f32x4 o0, o1;
#pragma unroll
        for (int j = 0; j < 4; ++j) { o0[j] = y[j] * siluf_(v0[j]); o1[j] = y[4 + j] * siluf_(v1[j]); }
        store8bf(d, o0, o1); } };

__device__ void tconv(unsigned char* smem, const float* src, int ldsrc, int col0, int N, int K, u16* dst, int ldd) {
    float* T = (float*)smem;
    const int tid = threadIdx.x, tilesN = N >> 6, ntile = tilesN * (K >> 6);
    const int lr = tid >> 4, lc = (tid & 15) * 4;
    const int sn = tid >> 3, sk = (tid & 7) * 8;
    int tile = blockIdx.x;
    f32x4 v0 = {0.f, 0.f, 0.f, 0.f}, v1 = {0.f, 0.f, 0.f, 0.f};
    if (tile < ntile) { const int tn = tile % tilesN, tk = tile / tilesN; const float* s = src + (size_t)(tk * 64 + lr) * ldsrc + col0 + tn * 64 + lc;
        v0 = *(const f32x4*)s; v1 = *(const f32x4*)(s + (size_t)32 * ldsrc); }
    for (; tile < ntile; tile += gridDim.x) {
        const int tn = tile % tilesN, tk = tile / tilesN;
#pragma unroll
        for (int j = 0; j < 4; ++j) { T[lr * 65 + lc + j] = v0[j]; T[(lr + 32) * 65 + lc + j] = v1[j]; }
        asm volatile("s_waitcnt lgkmcnt(0)" ::: "memory"); __builtin_amdgcn_s_barrier(); asm volatile("" ::: "memory");
        const int nx = tile + gridDim.x;
        if (nx < ntile) { const int tn2 = nx % tilesN, tk2 = nx / tilesN; const float* s = src + (size_t)(tk2 * 64 + lr) * ldsrc + col0 + tn2 * 64 + lc;
            v0 = *(const f32x4*)s; v1 = *(const f32x4*)(s + (size_t)32 * ldsrc); }
        float f[8];
#pragma unroll
        for (int j = 0; j < 8; ++j) f[j] = T[(sk + j) * 65 + sn];
        *(u32x4*)(dst + (size_t)(tn * 64 + sn) * ldd + tk * 64 + sk) = pack8(f);
        asm volatile("s_waitcnt lgkmcnt(0)" ::: "memory"); __builtin_amdgcn_s_barrier(); asm volatile("" ::: "memory");
    }
    __syncthreads();
}

template <int MODE> __device__ void rows_phase(const Params& p) {
    const int lane = threadIdx.x & 63, gw = blockIdx.x * 8 + (threadIdx.x >> 6), nw = gridDim.x * 8;
    const float* x = p.in[0];
    for (int row = gw; row < NTOK; row += nw) {
        if (MODE == 0) {
            f32x4 v[8]; float ss = 0.f;
#pragma unroll
            for (int i = 0; i < 8; ++i) { v[i] = *(const f32x4*)(x + (size_t)row * DM + i * 256 + lane * 4); ss += v[i][0] * v[i][0] + v[i][1] * v[i][1] + v[i][2] * v[i][2] + v[i][3] * v[i][3]; }
            ss = wave_sum(ss); const float r = rsqrtf(ss * (1.0f / DM) + 1e-6f);
            u16* H = (u16*)(p.ws + OFF_H);
#pragma unroll
            for (int i = 0; i < 8; ++i) { const int c = i * 256 + lane * 4; const f32x4 g = *(const f32x4*)(p.in[1] + c);
                u32x2 w; w.x = pk2(v[i][0] * r * g[0], v[i][1] * r * g[1]); w.y = pk2(v[i][2] * r * g[2], v[i][3] * r * g[3]); *(u32x2*)(H + (size_t)row * DM + c) = w; }
        } else {
            const u16* Mx = (const u16*)(p.ws + (MODE == 1 ? OFF_M0 : OFF_M1));
            const float* base = MODE == 1 ? x : p.out;
            const float* gpost = p.in[MODE == 1 ? 22 : 40];
            f32x4 m[8]; float ss = 0.f;
#pragma unroll
            for (int i = 0; i < 8; ++i) { const u32x2 w_ = *(const u32x2*)(Mx + (size_t)row * DM + i * 256 + lane * 4); m[i] = (f32x4){bflo(w_.x), bfhi(w_.x), bflo(w_.y), bfhi(w_.y)};
                ss += m[i][0] * m[i][0] + m[i][1] * m[i][1] + m[i][2] * m[i][2] + m[i][3] * m[i][3]; }
            ss = wave_sum(ss); const float r = rsqrtf(ss * (1.0f / DM) + 1e-6f);
            float ss1 = 0.f;
#pragma unroll
            for (int i = 0; i < 8; ++i) { const int c = i * 256 + lane * 4; const f32x4 g = *(const f32x4*)(gpost + c); const f32x4 b = *(const f32x4*)(base + (size_t)row * DM + c);
                m[i] = b + m[i] * r * g; ss1 += m[i][0] * m[i][0] + m[i][1] * m[i][1] + m[i][2] * m[i][2] + m[i][3] * m[i][3];
                *(f32x4*)(p.out + (size_t)row * DM + c) = m[i]; }
            if (MODE == 1) {
                ss1 = wave_sum(ss1); const float r1 = rsqrtf(ss1 * (1.0f / DM) + 1e-6f);
                u16* H = (u16*)(p.ws + OFF_H);
#pragma unroll
                for (int i = 0; i < 8; ++i) { const int c = i * 256 + lane * 4; const f32x4 g = *(const f32x4*)(p.in[23] + c);
                    u32x2 w; w.x = pk2(m[i][0] * r1 * g[0], m[i][1] * r1 * g[1]); w.y = pk2(m[i][2] * r1 * g[2], m[i][3] * r1 * g[3]); *(u32x2*)(H + (size_t)row * DM + c) = w; }
            }
        }
    }
}

__device__ void prep_small(const Params& p) {
    const int gt = blockIdx.x * 512 + threadIdx.x, nt = gridDim.x * 512;
    u16* LW = (u16*)(p.ws + OFF_LRUW);
    for (int e = gt; e < 2 * 16 * 128 * 128; e += nt) { const int i = e & 127, j = (e >> 7) & 127, blk = (e >> 14) & 15, g = e >> 18;
        LW[e] = f2bf(p.in[g ? 7 : 5][(size_t)(blk * 128 + i) * 128 + j]); }
    u16* WG = (u16*)(p.ws + OFF_WGT);
    for (int e = gt; e < 16 * 6144; e += nt) { const int c = e % 6144, n = e / 6144; WG[e] = f2bf(n < 8 ? p.in[15][c * 8 + n] : p.in[17][c * 8 + n - 8]); }
}
__device__ void prep_extras(const Params& p) {
    const int gt = blockIdx.x * 512 + threadIdx.x, nt = gridDim.x * 512;
    u16* W = (u16*)(p.ws + OFF_W1) + (size_t)12288 * 2048;
    for (int e = gt; e < 512 * 2048; e += nt) { const int k = e & 2047, n = e >> 11; float v = 0.f;
        if (n < 96) v = (1.f - p.in[26][k]) * p.in[29][k * 96 + n];
        else if (n < 192) v = p.in[26][k] * p.in[29][k * 96 + n - 96];
        else if (n < 288) v = (1.f - p.in[27][k]) * p.in[32][k * 96 + n - 192];
        else if (n < 384) v = p.in[27][k] * p.in[32][k * 96 + n - 288];
        W[e] = f2bf(v); }
}

#define LBAR0() do { asm volatile("s_waitcnt lgkmcnt(0)" ::: "memory"); __builtin_amdgcn_s_barrier(); asm volatile("" ::: "memory"); } while (0)
__device__ __forceinline__ float fsig0(float x) { return __builtin_amdgcn_rcpf(1.0f + __expf(-x)); }
template <int PASS> __device__ void lru_phase(const Params& p, unsigned char* smem) {
    float* xcf = (float*)smem;
    float* As = xcf + 64 * 132;
    float* Us = As + 64 * 132;
    float* qA = Us + 64 * 132;
    float* qH = qA + 512;
    const int tid = threadIdx.x, lane = tid & 63, wave = __builtin_amdgcn_readfirstlane(tid >> 6);
    const u16* XR = (const u16*)(p.ws + OFF_XR);
    u16* Y0 = (u16*)(p.ws + OFF_Y0);
    const u16* LW = (const u16*)(p.ws + OFF_LRUW);
    float* LA = (float*)(p.ws + OFF_LRUA); float* LH = (float*)(p.ws + OFF_LRUH); const float* LC = (const float*)(p.ws + OFF_LRUC);
    const float* cw = p.in[3]; const float* cb = p.in[4];
    u32x4 craw[2][4];
#define LRU_CLOAD(tl_) do { const int jb_ = (tl_) & 15, c_ = ((tl_) >> 4) & 63, b_ = (tl_) >> 10; \
        _Pragma("unroll") for (int it = 0; it < 2; ++it) { const int t_ = (tid >> 4) + 32 * it, ch_ = jb_ * 128 + (tid & 15) * 8; \
            _Pragma("unroll") for (int j = 0; j < 4; ++j) { const int s_ = c_ * 64 + t_ - 3 + j; \
                craw[it][j] = (s_ >= 0) ? *(const u32x4*)(XR + (size_t)(b_ * SEQL + s_) * 2048 + ch_) : (u32x4){0u, 0u, 0u, 0u}; } } } while (0)
    if ((int)blockIdx.x < 4096) LRU_CLOAD((int)blockIdx.x);
    for (int tile = blockIdx.x; tile < 4096; tile += gridDim.x) {
        const int jb = tile & 15, c = (tile >> 4) & 63, b = tile >> 10;
        const int row0 = b * SEQL + c * 64;
        u16 zpre[16];
        if (PASS == 2) {
#pragma unroll
            for (int tt = 0; tt < 16; ++tt) zpre[tt] = Y0[(size_t)(row0 + (tid >> 7) * 16 + tt) * 4096 + jb * 128 + (tid & 127)];
        }
#pragma unroll
        for (int it = 0; it < 2; ++it) {
            const int t = (tid >> 4) + 32 * it, c8 = (tid & 15) * 8, ch = jb * 128 + c8;
            float acc[8];
            { const f32x4 b0 = *(const f32x4*)(cb + ch), b1 = *(const f32x4*)(cb + ch + 4);
#pragma unroll
              for (int i = 0; i < 4; ++i) { acc[i] = b0[i]; acc[4 + i] = b1[i]; } }
#pragma unroll
            for (int j = 0; j < 4; ++j) { float xv[8]; unpack8(craw[it][j], xv);
                const f32x4 w0 = *(const f32x4*)(cw + j * 2048 + ch), w1 = *(const f32x4*)(cw + j * 2048 + ch + 4);
#pragma unroll
                for (int i = 0; i < 4; ++i) { acc[i] += w0[i] * xv[i]; acc[4 + i] += w1[i] * xv[4 + i]; } }
            *(f32x4*)(xcf + t * 132 + c8) = (f32x4){acc[0], acc[1], acc[2], acc[3]}; *(f32x4*)(xcf + t * 132 + c8 + 4) = (f32x4){acc[4], acc[5], acc[6], acc[7]};
        }
        if (tile + (int)gridDim.x < 4096) LRU_CLOAD(tile + (int)gridDim.x);
        LBAR0();
        f32x4 accA[4], accX[4];
#pragma unroll
        for (int m = 0; m < 4; ++m) { accA[m] = (f32x4){0.f, 0.f, 0.f, 0.f}; accX[m] = (f32x4){0.f, 0.f, 0.f, 0.f}; }
#pragma unroll
        for (int ks = 0; ks < 4; ++ks) {
            const size_t wo = (size_t)((jb * 128 + 16 * wave + (lane & 15)) * 128 + ks * 32 + 8 * (lane >> 4));
            const bf16x8 ba = *(const bf16x8*)(LW + wo), bx = *(const bf16x8*)(LW + (size_t)16 * 128 * 128 + wo);
#pragma unroll
            for (int m = 0; m < 4; ++m) { const float* s = xcf + (16 * m + (lane & 15)) * 132 + ks * 32 + 8 * (lane >> 4);
                const f32x4 lo = *(const f32x4*)s, hi = *(const f32x4*)(s + 4); float f[8] = {lo[0], lo[1], lo[2], lo[3], hi[0], hi[1], hi[2], hi[3]};
                const bf16x8 af = as_frag(pack8(f));
                accA[m] = MFMA16(af, ba, accA[m]); accX[m] = MFMA16(af, bx, accX[m]); }
        }
        {
            const int ch = 16 * wave + (lane & 15), cgl = jb * 128 + ch;
            const float ba_ = p.in[6][cgl], bx_ = p.in[8][cgl], sp = softplusf_(-p.in[9][cgl]);
#pragma unroll
            for (int m = 0; m < 4; ++m)
#pragma unroll
                for (int r = 0; r < 4; ++r) { const int t = 16 * m + 4 * (lane >> 4) + r;
                    const float rg = fsig0(accA[m][r] + ba_), ig = fsig0(accX[m][r] + bx_);
                    const float la = -8.0f * rg * sp, a = __expf(la), u = __builtin_amdgcn_sqrtf(fmaxf(1.0f - a * a, 0.f)) * (ig * xcf[t * 132 + ch]);
                    As[t * 132 + ch] = a; Us[t * 132 + ch] = u; }
        }
        LBAR0();
        const int ch = tid & 127, q = tid >> 7, cgl = jb * 128 + ch;
        { float h = 0.f, A = 1.f;
#pragma unroll
          for (int tt = 0; tt < 16; ++tt) { const int t = q * 16 + tt; const float a = As[t * 132 + ch], u = Us[t * 132 + ch]; h = a * h + u; A *= a;
              if (PASS == 2) { Us[t * 132 + ch] = h; As[t * 132 + ch] = A; } }
          qA[q * 128 + ch] = A; qH[q * 128 + ch] = h; }
        LBAR0();
        if (PASS == 1) {
            if (q == 0) { float h = 0.f, A = 1.f;
#pragma unroll
                for (int qq = 0; qq < 4; ++qq) { h = qA[qq * 128 + ch] * h + qH[qq * 128 + ch]; A *= qA[qq * 128 + ch]; }
                LA[(size_t)(b * 64 + c) * 2048 + cgl] = A; LH[(size_t)(b * 64 + c) * 2048 + cgl] = h; }
        } else {
            float carry = LC[(size_t)(b * 64 + c) * 2048 + cgl];
            for (int qq = 0; qq < q; ++qq) carry = qA[qq * 128 + ch] * carry + qH[qq * 128 + ch];
#pragma unroll
            for (int tt = 0; tt < 16; ++tt) { const int t = q * 16 + tt; const float hh = Us[t * 132 + ch] + As[t * 132 + ch] * carry; const float z = bf2f(zpre[tt]);
                Y0[(size_t)(row0 + t) * 4096 + cgl] = f2bf(hh * z * fsig0(z)); }
        }
        LBAR0();
    }
}
__device__ void lru_carry(const Params& p) {
    const float* LA = (const float*)(p.ws + OFF_LRUA); const float* LH = (const float*)(p.ws + OFF_LRUH); float* LC = (float*)(p.ws + OFF_LRUC);
    for (int idx = blockIdx.x * 512 + threadIdx.x; idx < 4 * 2048; idx += gridDim.x * 512) { const int b = idx >> 11, cg_ = idx & 2047; float c = 0.f;
#pragma unroll 8
        for (int k = 0; k < 64; ++k) { const size_t o = (size_t)(b * 64 + k) * 2048 + cg_; LC[o] = c; c = LA[o] * c + LH[o]; } }
}

__device__ void mqk_phase(const Params& p, unsigned char* smem) {
    float* red = (float*)smem;
    const int tid = threadIdx.x, lane = tid & 63, wave = __builtin_amdgcn_readfirstlane(tid >> 6);
    const u16* XM = (const u16*)(p.ws + OFF_XM); u16* Q = (u16*)(p.ws + OFF_Q); u16* KX = (u16*)(p.ws + OFF_KX);
    const u16* WG = (const u16*)(p.ws + OFF_WGT); float* G = (float*)(p.ws + OFF_G);
    for (int tile = blockIdx.x; tile < 256; tile += gridDim.x) {
        const int row0 = tile * 64;
        f32x4 acc[4];
#pragma unroll
        for (int m = 0; m < 4; ++m) acc[m] = (f32x4){0.f, 0.f, 0.f, 0.f};
        for (int ks = 0; ks < 8; ++ks) {
            const int c0 = 256 * wave + 32 * ks + 8 * (lane >> 4);
            float cw[4][8], cbv[8];
#pragma unroll
            for (int j = 0; j < 4; ++j) { const f32x4 a = *(const f32x4*)(p.in[10] + j * 2048 + c0), b = *(const f32x4*)(p.in[10] + j * 2048 + c0 + 4);
#pragma unroll
                for (int i = 0; i < 4; ++i) { cw[j][i] = a[i]; cw[j][4 + i] = b[i]; } }
            { const f32x4 a = *(const f32x4*)(p.in[11] + c0), b = *(const f32x4*)(p.in[11] + c0 + 4);
#pragma unroll
              for (int i = 0; i < 4; ++i) { cbv[i] = a[i]; cbv[4 + i] = b[i]; } }
            const bf16x8 bq = *(const bf16x8*)(WG + (size_t)(lane & 15) * 6144 + c0), bk = *(const bf16x8*)(WG + (size_t)(lane & 15) * 6144 + 2048 + c0), bv = *(const bf16x8*)(WG + (size_t)(lane & 15) * 6144 + 4096 + c0);
            const float* wqp = p.in[12] + (size_t)(c0 >> 2) * 16; const float* wkp = p.in[13] + (size_t)(c0 >> 2) * 16; const float* wvp = p.in[14] + (size_t)(c0 >> 2) * 16;
            u32x4 xraw[4];
#define MQ_LOAD(dst, mm) do { const int tk_ = row0 + 16 * (mm) + (lane & 15), s_ = tk_ & (SEQL - 1); \
                _Pragma("unroll") for (int j = 0; j < 4; ++j) dst[j] = (s_ - 3 + j >= 0) ? *(const u32x4*)(XM + (size_t)(tk_ - 3 + j) * 2048 + c0) : (u32x4){0u, 0u, 0u, 0u}; } while (0)
            MQ_LOAD(xraw, 0);
#pragma unroll
            for (int m = 0; m < 4; ++m) {
                const int tk = row0 + 16 * m + (lane & 15);
                u32x4 xnx[4];
                if (m < 3) MQ_LOAD(xnx, m + 1);
                float xmc[8], xcur[8];
#pragma unroll
                for (int i = 0; i < 8; ++i) xmc[i] = cbv[i];
#pragma unroll
                for (int j = 0; j < 4; ++j) { float xv[8]; unpack8(xraw[j], xv);
#pragma unroll
                    for (int i = 0; i < 8; ++i) { xmc[i] += cw[j][i] * xv[i]; if (j == 3) xcur[i] = xv[i]; } }
                if (m < 3) {
#pragma unroll
                    for (int j = 0; j < 4; ++j) xraw[j] = xnx[j]; }
#pragma unroll
                for (int i = 0; i < 8; ++i) xmc[i] = xmc[i] * fsig0(xmc[i]);
                float qv[8], kv[8], vv[8];
#pragma unroll
                for (int bb = 0; bb < 2; ++bb)
#pragma unroll
                    for (int jj = 0; jj < 4; ++jj) { float aq = 0.f, ak = 0.f, av = 0.f;
#pragma unroll
                        for (int ii = 0; ii < 4; ++ii) { aq += xmc[4 * bb + ii] * wqp[bb * 16 + ii * 4 + jj]; ak += xmc[4 * bb + ii] * wkp[bb * 16 + ii * 4 + jj]; av += xcur[4 * bb + ii] * wvp[bb * 16 + ii * 4 + jj]; }
                        qv[4 * bb + jj] = aq; kv[4 * bb + jj] = ak; vv[4 * bb + jj] = av; }
                const u32x4 qw = pack8(qv), kw = pack8(kv), vw = pack8(vv);
                acc[m] = MFMA16(as_frag(qw), bq, acc[m]); acc[m] = MFMA16(as_frag(kw), bk, acc[m]); acc[m] = MFMA16(as_frag(vw), bv, acc[m]);
#pragma unroll
                for (int i = 0; i < 8; ++i) kv[i] *= 0.0625f;
                *(u32x4*)(Q + (size_t)tk * 2048 + c0) = qw; *(u32x4*)(KX + (size_t)tk * 2048 + c0) = pack8(kv);
            }
        }
#pragma unroll
        for (int m = 0; m < 4; ++m)
#pragma unroll
            for (int r = 0; r < 4; ++r) red[(wave * 64 + 16 * m + 4 * (lane >> 4) + r) * 16 + (lane & 15)] = acc[m][r];
        __syncthreads();
        for (int e = tid; e < 1024; e += 512) { const int tok = e >> 4, n = e & 15; float s = (n < 8) ? p.in[16][n] : p.in[18][n - 8];
#pragma unroll
            for (int w = 0; w < 8; ++w) s += red[(w * 64 + tok) * 16 + n];
            G[(size_t)(row0 + tok) * 16 + n] = s; }
        __syncthreads();
    }
}

__device__ void mlstm_phase(const Params& p, unsigned char* smem) {
    u16* Ks = (u16*)smem;
    u16* Vt = Ks + 128 * 264;
    u16* Vwt = Vt + 48 * 136;
    u16* Ps = Vwt + 48 * 136;
    u16* Ct = Ps + 128 * 136;
    float* gc = (float*)(Ct + 48 * 264);
    float* gM = gc + 128; float* gE = gM + 128; float* gF = gE + 128; float* gW = gF + 128; float* gS = gW + 128;
    const int tid = threadIdx.x, lane = tid & 63, wave = __builtin_amdgcn_readfirstlane(tid >> 6);
    const int l15 = lane & 15, lq = lane >> 4;
    const u16* XM = (const u16*)(p.ws + OFF_XM); const u16* Q = (const u16*)(p.ws + OFF_Q); const u16* KX = (const u16*)(p.ws + OFF_KX);
    const float* G = (const float*)(p.ws + OFF_G); u16* Hm = (u16*)(p.ws + OFF_H);
    for (int unit = blockIdx.x; unit < 256; unit += gridDim.x) {
        int sl = unit & 7, bh_ = unit >> 3;
        if (gridDim.x == 256) { const int xcd_ = unit & 7, j_ = unit >> 3; bh_ = xcd_ * 4 + (j_ >> 3); sl = j_ & 7; }
        const int h = bh_ & 7, b = bh_ >> 3;
        f32x4 accC[3][2];
#pragma unroll
        for (int a = 0; a < 3; ++a)
#pragma unroll
            for (int c = 0; c < 2; ++c) accC[a][c] = (f32x4){0.f, 0.f, 0.f, 0.f};
        float m_prev = 0.f;
        for (int e = tid; e < 16 * 136; e += 512) { const int r = e / 136; Vt[32 * 136 + e] = (r == 0) ? (u16)0x3F80 : (u16)0; Vwt[32 * 136 + e] = 0; }
        for (int e = tid; e < 48 * 264; e += 512) Ct[e] = 0;
        const int vc = 256 * h + 32 * sl + 4 * (tid & 7);
        const float* wvp = p.in[14] + (size_t)(vc >> 2) * 16;
        __syncthreads();
        for (int chunk = 0; chunk < 32; ++chunk) {
            const int row0 = b * SEQL + chunk * 128;
#pragma unroll
            for (int i = 0; i < 8; ++i) { const int idx = tid + 512 * i, r = idx >> 5, cc = (idx & 31) * 8;
                *(u32x4*)(Ks + r * 264 + cc) = *(const u32x4*)(KX + (size_t)(row0 + r) * 2048 + 256 * h + cc); }
            bf16x8 qf[8];
#pragma unroll
            for (int ks = 0; ks < 8; ++ks) qf[ks] = *(const bf16x8*)(Q + (size_t)(row0 + 16 * wave + l15) * 2048 + 256 * h + 32 * ks + 8 * lq);
            float vv[2][4];
#pragma unroll
            for (int i = 0; i < 2; ++i) { const int t = (tid + 512 * i) >> 3; const u32x2 raw = *(const u32x2*)(XM + (size_t)(row0 + t) * 2048 + vc);
                const float x0 = bflo(raw.x), x1 = bfhi(raw.x), x2 = bflo(raw.y), x3 = bfhi(raw.y);
#pragma unroll
                for (int jj = 0; jj < 4; ++jj) vv[i][jj] = x0 * wvp[jj] + x1 * wvp[4 + jj] + x2 * wvp[8 + jj] + x3 * wvp[12 + jj]; }
            if (wave == 0) {
                const int t0 = 2 * lane;
                const float ig0 = G[(size_t)(row0 + t0) * 16 + h], fg0 = G[(size_t)(row0 + t0) * 16 + 8 + h];
                const float ig1 = G[(size_t)(row0 + t0 + 1) * 16 + h], fg1 = G[(size_t)(row0 + t0 + 1) * 16 + 8 + h];
                const float lf0 = -softplusf_(-fg0), lf1 = -softplusf_(-fg1);
                float s = lf0 + lf1;
#pragma unroll
                for (int d = 1; d < 64; d <<= 1) { const float o = __shfl_up(s, d); if (lane >= d) s += o; }
                const float b1 = s, b0 = s - lf1;
                const float c0 = ig0 - b0, c1 = ig1 - b1;
                float mx = fmaxf(c0, c1);
#pragma unroll
                for (int d = 1; d < 64; d <<= 1) { const float o = __shfl_up(mx, d); if (lane >= d) mx = fmaxf(mx, o); }
                float pm = __shfl_up(mx, 1); if (lane == 0) pm = -3.0e38f;
                const float M0 = fmaxf(fmaxf(pm, c0), m_prev), M1 = fmaxf(mx, m_prev);
                const float Ml = __shfl(M1, 63), bL = __shfl(b1, 63);
                gc[t0] = c0; gc[t0 + 1] = c1; gM[t0] = M0; gM[t0 + 1] = M1;
                gE[t0] = __expf(m_prev - M0); gE[t0 + 1] = __expf(m_prev - M1);
                gF[t0] = __expf(-(b0 + M0)); gF[t0 + 1] = __expf(-(b1 + M1));
                gW[t0] = __expf(c0 - Ml); gW[t0 + 1] = __expf(c1 - Ml);
                if (lane == 0) gS[0] = __expf(m_prev - Ml);
                m_prev = bL + Ml;
            }
            LBAR0();
#pragma unroll
            for (int i = 0; i < 2; ++i) { const int t = (tid + 512 * i) >> 3; const float w = gW[t];
#pragma unroll
                for (int jj = 0; jj < 4; ++jj) { const int dv = 4 * (tid & 7) + jj; Vt[dv * 136 + t] = f2bf(vv[i][jj]); Vwt[dv * 136 + t] = f2bf(vv[i][jj] * w); } }
            if (tid < 128) Vwt[32 * 136 + tid] = f2bf(gW[tid]);
            f32x4 accS[8];
#pragma unroll
            for (int n = 0; n < 8; ++n) { accS[n] = (f32x4){0.f, 0.f, 0.f, 0.f};
                if (n <= wave) {
#pragma unroll
                    for (int ks = 0; ks < 8; ++ks) { const bf16x8 kf = *(const bf16x8*)(Ks + (16 * n + l15) * 264 + 32 * ks + 8 * lq); accS[n] = MFMA16(qf[ks], kf, accS[n]); } } }
#pragma unroll
            for (int n = 0; n < 8; ++n) if (n <= (wave | 1)) { const int s = 16 * n + l15; const float cs = gc[s];
#pragma unroll
                for (int r = 0; r < 4; ++r) { const int t = 16 * wave + 4 * lq + r; const float val = (n <= wave && s <= t) ? accS[n][r] * __expf(cs - gM[t]) : 0.f; Ps[t * 136 + s] = f2bf(val); } }
            LBAR0();
            f32x4 oi[3], oc[3];
#pragma unroll
            for (int nt = 0; nt < 3; ++nt) { oi[nt] = (f32x4){0.f, 0.f, 0.f, 0.f}; oc[nt] = (f32x4){0.f, 0.f, 0.f, 0.f}; }
#pragma unroll
            for (int kk = 0; kk < 4; ++kk) if (kk <= (wave >> 1)) { const bf16x8 pf = *(const bf16x8*)(Ps + (16 * wave + l15) * 136 + 32 * kk + 8 * lq);
#pragma unroll
                for (int nt = 0; nt < 3; ++nt) { const bf16x8 vf = *(const bf16x8*)(Vt + (16 * nt + l15) * 136 + 32 * kk + 8 * lq); oi[nt] = MFMA16(pf, vf, oi[nt]); } }
#pragma unroll
            for (int ks = 0; ks < 8; ++ks)
#pragma unroll
                for (int nt = 0; nt < 3; ++nt) { const bf16x8 cf = *(const bf16x8*)(Ct + (16 * nt + l15) * 264 + 32 * ks + 8 * lq); oc[nt] = MFMA16(qf[ks], cf, oc[nt]); }
#pragma unroll
            for (int r = 0; r < 4; ++r) { const int t = 16 * wave + 4 * lq + r; const float E = gE[t], F = gF[t];
                float den = oi[2][r] + E * oc[2][r]; den = __shfl(den, lane & 48);
                const float inv = 1.0f / fmaxf(fabsf(den), F);
#pragma unroll
                for (int nt = 0; nt < 2; ++nt) Hm[(size_t)(row0 + t) * 2048 + 256 * h + 32 * sl + 16 * nt + l15] = f2bf((oi[nt][r] + E * oc[nt][r]) * inv); }
            { const float decay = gS[0];
#pragma unroll
              for (int a = 0; a < 3; ++a)
#pragma unroll
                for (int c = 0; c < 2; ++c) accC[a][c] = accC[a][c] * decay; }
#pragma unroll
            for (int kk = 0; kk < 4; ++kk) {
                bf16x8 ktf[2];
#pragma unroll
                for (int ntk = 0; ntk < 2; ++ntk) { const int dk = 32 * wave + 16 * ntk + l15;
#pragma unroll
                    for (int j = 0; j < 8; ++j) ktf[ntk][j] = (short)Ks[(32 * kk + 8 * lq + j) * 264 + dk]; }
#pragma unroll
                for (int mt = 0; mt < 3; ++mt) { const bf16x8 vwf = *(const bf16x8*)(Vwt + (16 * mt + l15) * 136 + 32 * kk + 8 * lq);
#pragma unroll
                    for (int ntk = 0; ntk < 2; ++ntk) accC[mt][ntk] = MFMA16(vwf, ktf[ntk], accC[mt][ntk]); }
            }
            LBAR0();
#pragma unroll
            for (int mt = 0; mt < 3; ++mt)
#pragma unroll
                for (int ntk = 0; ntk < 2; ++ntk)
#pragma unroll
                    for (int r = 0; r < 4; ++r) Ct[(16 * mt + 4 * lq + r) * 264 + 32 * wave + 16 * ntk + l15] = f2bf(accC[mt][ntk][r]);
        }
        __syncthreads();
    }
}

__device__ void mnorm_phase(const Params& p) {
    const int lane = threadIdx.x & 63, wave = threadIdx.x >> 6;
    const u16* XM = (const u16*)(p.ws + OFF_XM); const u16* Hm = (const u16*)(p.ws + OFF_H); u16* Y0 = (u16*)(p.ws + OFF_Y0);
    const int c = 256 * wave + 4 * lane;
    float cw[4][4];
#pragma unroll
    for (int j = 0; j < 4; ++j) { const f32x4 a = *(const f32x4*)(p.in[10] + j * 2048 + c);
#pragma unroll
        for (int i = 0; i < 4; ++i) cw[j][i] = a[i]; }
    const f32x4 cbv = *(const f32x4*)(p.in[11] + c), skip = *(const f32x4*)(p.in[19] + c), gn = *(const f32x4*)(p.in[20] + c);
    for (int blk = blockIdx.x; blk < 256; blk += gridDim.x) {
        u32x2 hr, xr[4], zr;
#define MN_LOAD(tk_) do { const int s_ = (tk_) & (SEQL - 1); hr = *(const u32x2*)(Hm + (size_t)(tk_) * 2048 + c); zr = *(const u32x2*)(Y0 + (size_t)(tk_) * 4096 + 2048 + c); \
            _Pragma("unroll") for (int j = 0; j < 4; ++j) xr[j] = (s_ - 3 + j >= 0) ? *(const u32x2*)(XM + (size_t)((tk_) - 3 + j) * 2048 + c) : (u32x2){0u, 0u}; } while (0)
        MN_LOAD(blk * 64);
#pragma unroll 2
        for (int tt = 0; tt < 64; ++tt) {
            const int tk = blk * 64 + tt;
            const u32x2 hc_ = hr, zc_ = zr; const u32x2 xc0 = xr[0], xc1 = xr[1], xc2 = xr[2], xc3 = xr[3];
            if (tt < 63) MN_LOAD(tk + 1);
            float hv[4] = {bflo(hc_.x), bfhi(hc_.x), bflo(hc_.y), bfhi(hc_.y)};
            const float mu = wave_sum_dpp(hv[0] + hv[1] + hv[2] + hv[3]) * (1.0f / 256.0f);
            float d[4], sq = 0.f;
#pragma unroll
            for (int i = 0; i < 4; ++i) { d[i] = hv[i] - mu; sq += d[i] * d[i]; }
            const float rs = rsqrtf(wave_sum_dpp(sq) * (1.0f / 256.0f) + 1e-6f);
            float xmc[4] = {cbv[0], cbv[1], cbv[2], cbv[3]};
            const u32x2 xs[4] = {xc0, xc1, xc2, xc3};
#pragma unroll
            for (int j = 0; j < 4; ++j) { xmc[0] += cw[j][0] * bflo(xs[j].x); xmc[1] += cw[j][1] * bfhi(xs[j].x); xmc[2] += cw[j][2] * bflo(xs[j].y); xmc[3] += cw[j][3] * bfhi(xs[j].y); }
            const float z[4] = {bflo(zc_.x), bfhi(zc_.x), bflo(zc_.y), bfhi(zc_.y)};
            float o[4];
#pragma unroll
            for (int i = 0; i < 4; ++i) o[i] = (d[i] * rs * gn[i] + skip[i] * xmc[i] * fsig0(xmc[i])) * z[i] * fsig0(z[i]);
            u32x2 w; w.x = pk2(o[0], o[1]); w.y = pk2(o[2], o[3]); *(u32x2*)(Y0 + (size_t)tk * 4096 + 2048 + c) = w;
        }
#undef MN_LOAD
    }
}

__device__ __forceinline__ float fsigmoid(float x) { return __builtin_amdgcn_rcpf(1.0f + __expf(-x)); }
__device__ __forceinline__ float ftanh(float x) { return 1.0f - 2.0f * __builtin_amdgcn_rcpf(1.0f + __expf(2.0f * x)); }
__device__ __forceinline__ float row16_sum(float v) { v += dppf<0xB1>(v); v += dppf<0x4E>(v); v += dppf<0x141>(v); v += dppf<0x140>(v); return v; }
#define LBAR() do { asm volatile("s_waitcnt lgkmcnt(0)" ::: "memory"); __builtin_amdgcn_s_barrier(); asm volatile("" ::: "memory"); } while (0)
struct RwStep { f32x4 d0, d1, a0, a1, b0, b1, k0, k1, w0, w1; float v0, v1; f32x2 sc; };
__device__ __forceinline__ RwStep rw_load(const float* vb, const float* vrow, const float* sb) {
    RwStep s;
    s.d0 = *(const f32x4*)vb; s.d1 = *(const f32x4*)(vb + 4); s.a0 = *(const f32x4*)(vb + 64); s.a1 = *(const f32x4*)(vb + 68);
    s.b0 = *(const f32x4*)(vb + 128); s.b1 = *(const f32x4*)(vb + 132); s.k0 = *(const f32x4*)(vb + 192); s.k1 = *(const f32x4*)(vb + 196);
    s.w0 = *(const f32x4*)(vb + 256); s.w1 = *(const f32x4*)(vb + 260);
    s.v0 = vrow[320]; s.v1 = vrow[352]; s.sc = *(const f32x2*)sb;
    return s;
}
__device__ void rwkv_phase(const Params& p, unsigned char* smem) {
    constexpr int TC = 16, NCH = SEQL / TC;
    u16* W2t = (u16*)smem;
    u16* A2t = W2t + 64 * 104;
    float* vec = (float*)(A2t + 64 * 104);
    float* scal = vec + 2 * TC * 384;
    float* Yraw = scal + 2 * TC * 4;
    u16* raw = (u16*)(Yraw + 2 * TC * 64);
    u16* twa = raw + 3 * 17 * 64;
    const int tid = threadIdx.x, lane = tid & 63, wave = __builtin_amdgcn_readfirstlane(tid >> 6);
    const int l15 = lane & 15, lq = lane >> 4;
    u16* R = (u16*)(p.ws + OFF_R); const u16* Kb = (const u16*)(p.ws + OFF_KK); const u16* Vb = (const u16*)(p.ws + OFF_V); const u16* P = (const u16*)(p.ws + OFF_P);
    for (int unit = blockIdx.x; unit < 256; unit += gridDim.x) {
        const int b = unit >> 6, h = unit & 63, hc = 64 * h;
        for (int e = tid; e < 6144; e += 512) { const int j = e >> 6, k = e & 63; W2t[k * 104 + j] = f2bf(p.in[30][(size_t)j * 4096 + hc + k]); A2t[k * 104 + j] = f2bf(p.in[33][(size_t)j * 4096 + hc + k]); }
        __syncthreads();
        if (wave < 4) {
            const int rp = tid >> 3, j8 = tid & 7;
            f32x2 S0[4], S1[4];
#pragma unroll
            for (int i = 0; i < 4; ++i) { S0[i] = (f32x2){0.f, 0.f}; S1[i] = (f32x2){0.f, 0.f}; }
            for (int pc = -1; pc <= NCH; ++pc) {
                const bool act = (pc >= 0 && pc < NCH);
                const float* vbase = vec + (pc & 1) * TC * 384;
                const float* sbase = scal + (pc & 1) * TC * 4;
                float* ybase = Yraw + (pc & 1) * TC * 64;
#pragma unroll 1
                for (int q = 0; q < 2; ++q) {
                    if (act) {
                        RwStep cur = rw_load(vbase + (8 * q) * 384 + 8 * j8, vbase + (8 * q) * 384 + rp, sbase + (8 * q) * 4);
#pragma unroll
                        for (int tt = 0; tt < 8; ++tt) {
                            const int t = 8 * q + tt;
                            RwStep nxt = cur;
                            if (tt < 7) nxt = rw_load(vbase + (t + 1) * 384 + 8 * j8, vbase + (t + 1) * 384 + rp, sbase + (t + 1) * 4);
                            __builtin_amdgcn_sched_barrier(0);
                            const f32x2 av[4] = {{cur.a0[0], cur.a0[1]}, {cur.a0[2], cur.a0[3]}, {cur.a1[0], cur.a1[1]}, {cur.a1[2], cur.a1[3]}};
                            const f32x2 wv[4] = {{cur.w0[0], cur.w0[1]}, {cur.w0[2], cur.w0[3]}, {cur.w1[0], cur.w1[1]}, {cur.w1[2], cur.w1[3]}};
                            const f32x2 dv[4] = {{cur.d0[0], cur.d0[1]}, {cur.d0[2], cur.d0[3]}, {cur.d1[0], cur.d1[1]}, {cur.d1[2], cur.d1[3]}};
                            const f32x2 bv[4] = {{cur.b0[0], cur.b0[1]}, {cur.b0[2], cur.b0[3]}, {cur.b1[0], cur.b1[1]}, {cur.b1[2], cur.b1[3]}};
                            const f32x2 kv[4] = {{cur.k0[0], cur.k0[1]}, {cur.k0[2], cur.k0[3]}, {cur.k1[0], cur.k1[1]}, {cur.k1[2], cur.k1[3]}};
                            f32x2 q1 = S0[0] * av[0], q2 = S0[0] * wv[0], q3 = S1[0] * av[0], q4 = S1[0] * wv[0];
#pragma unroll
                            for (int i = 1; i < 4; ++i) { q1 += S0[i] * av[i]; q2 += S0[i] * wv[i]; q3 += S1[i] * av[i]; q4 += S1[i] * wv[i]; }
                            float p1 = q1.x + q1.y, p2 = q2.x + q2.y, p3 = q3.x + q3.y, p4 = q4.x + q4.y;
                            p1 += dppf<0xB1>(p1); p2 += dppf<0xB1>(p2); p3 += dppf<0xB1>(p3); p4 += dppf<0xB1>(p4);
                            p1 += dppf<0x4E>(p1); p2 += dppf<0x4E>(p2); p3 += dppf<0x4E>(p3); p4 += dppf<0x4E>(p4);
                            p1 += dppf<0x141>(p1); p2 += dppf<0x141>(p2); p3 += dppf<0x141>(p3); p4 += dppf<0x141>(p4);
                            { const float y0 = p2 + p1 * cur.sc.x + cur.v0 * cur.sc.y, y1 = p4 + p3 * cur.sc.x + cur.v1 * cur.sc.y;
                              if (j8 == 0) { ybase[t * 64 + rp] = y0; ybase[t * 64 + 32 + rp] = y1; } }
                            const f32x2 sa0 = {p1, p1}, sa1 = {p3, p3}, vv0 = {cur.v0, cur.v0}, vv1 = {cur.v1, cur.v1};
#pragma unroll
                            for (int i = 0; i < 4; ++i) { S0[i] = (S0[i] * dv[i] + vv0 * kv[i]) + sa0 * bv[i]; S1[i] = (S1[i] * dv[i] + vv1 * kv[i]) + sa1 * bv[i]; }
                            cur = nxt;
                        }
                    }
                    LBAR();
                }
            }
        } else {
            const int w4 = wave - 4, ptid = tid - 256, tl = 4 * lq + w4;
            float mu_r[4], mu_k[4], mu_v[4], w0k[4], a0k[4], kkk[4], kak[4], rkk[4], gng[4], gnb[4];
#pragma unroll
            for (int nt = 0; nt < 4; ++nt) { const int k = hc + 16 * nt + l15;
                mu_r[nt] = p.in[25][k]; mu_k[nt] = p.in[25][4096 + k]; mu_v[nt] = p.in[25][8192 + k];
                w0k[nt] = p.in[28][k]; a0k[nt] = p.in[31][k]; kkk[nt] = p.in[34][k]; kak[nt] = p.in[35][k]; rkk[nt] = p.in[36][k]; gng[nt] = p.in[37][k]; gnb[nt] = p.in[38][k]; }
            u32x4 pfP[4]; u32x2 pfR[4];
#define RW_PREFETCH(c) do { const int row0_ = b * SEQL + (c) * TC; \
                _Pragma("unroll") for (int i = 0; i < 2; ++i) { const int it = ptid + 256 * i; const int mt = it / 192, rem = it - mt * 192, t_ = rem / 12, g_ = rem - t_ * 12; \
                    if (it < 384) { const size_t row_ = (size_t)(row0_ + t_); pfP[2 * i] = *(const u32x4*)(P + row_ * 384 + mt * 192 + 8 * g_); \
                        pfP[2 * i + 1] = ((c) == 0 && t_ == 0) ? (u32x4){0u, 0u, 0u, 0u} : *(const u32x4*)(P + (row_ - 1) * 384 + mt * 192 + 96 + 8 * g_); } } \
                _Pragma("unroll") for (int i = 0; i < 4; ++i) { const int it = ptid + 256 * i; const int ar = it / 272, rem = it - ar * 272, rr_ = rem >> 4, c4 = rem & 15; \
                    if (it < 816) { const u16* src_ = ar == 0 ? (const u16*)R : ar == 1 ? Kb : Vb; \
                        pfR[i] = ((c) == 0 && rr_ == 0) ? (u32x2){0u, 0u} : *(const u32x2*)(src_ + (size_t)(row0_ - 1 + rr_) * 4096 + hc + 4 * c4); } } } while (0)
            RW_PREFETCH(0);
            for (int pc = -1; pc <= NCH; ++pc) {
                const int cn = pc + 1;
                const bool prep = (cn < NCH);
                float* vnext = vec + (cn & 1) * TC * 384;
                float* snext = scal + (cn & 1) * TC * 4;
                if (prep) {
#pragma unroll
                    for (int i = 0; i < 2; ++i) { const int it = ptid + 256 * i; const int mt = it / 192, rem = it - mt * 192, t_ = rem / 12, g_ = rem - t_ * 12;
                        if (it < 384) { float c8[8], p8[8]; unpack8(pfP[2 * i], c8); unpack8(pfP[2 * i + 1], p8);
#pragma unroll
                            for (int j = 0; j < 8; ++j) { const float s = c8[j] + p8[j]; c8[j] = mt == 0 ? ftanh(s) : s; }
                            *(u32x4*)(twa + (mt * 16 + t_) * 104 + 8 * g_) = pack8(c8); } }
#pragma unroll
                    for (int i = 0; i < 4; ++i) { const int it = ptid + 256 * i; const int ar = it / 272, rem = it - ar * 272, rr_ = rem >> 4, c4 = rem & 15;
                        if (it < 816) *(u32x2*)(raw + (ar * 17 + rr_) * 64 + 4 * c4) = pfR[i]; }
                }
                if (cn + 1 < NCH) RW_PREFETCH(cn + 1);
                if (pc >= 1) {
                    const int cp = pc - 1; const float* vprev = vec + (cp & 1) * TC * 384; const float* sprev = scal + (cp & 1) * TC * 4; const float* yprev = Yraw + (cp & 1) * TC * 64;
                    const size_t row = (size_t)(b * SEQL + cp * TC + tl);
                    float y[4], s1 = 0.f;
#pragma unroll
                    for (int nt = 0; nt < 4; ++nt) { y[nt] = yprev[tl * 64 + 16 * nt + l15]; s1 += y[nt]; }
                    const float mu = row16_sum(s1) * (1.0f / 64.0f); float s2 = 0.f;
#pragma unroll
                    for (int nt = 0; nt < 4; ++nt) { y[nt] -= mu; s2 += y[nt] * y[nt]; }
                    const float rs = rsqrtf(row16_sum(s2) * (1.0f / 64.0f) + 64e-5f), bon = sprev[tl * 4 + 2];
#pragma unroll
                    for (int nt = 0; nt < 4; ++nt) R[row * 4096 + hc + 16 * nt + l15] = f2bf(y[nt] * rs * gng[nt] + gnb[nt] + bon * vprev[tl * 384 + 320 + 16 * nt + l15]);
                }
                LBAR();
                if (prep) {
                    f32x4 accW[4], accA[4];
#pragma unroll
                    for (int nt = 0; nt < 4; ++nt) { accW[nt] = (f32x4){0.f, 0.f, 0.f, 0.f}; accA[nt] = (f32x4){0.f, 0.f, 0.f, 0.f}; }
#pragma unroll
                    for (int ks = 0; ks < 3; ++ks) { const bf16x8 afw = *(const bf16x8*)(twa + l15 * 104 + 32 * ks + 8 * lq), afa = *(const bf16x8*)(twa + (16 + l15) * 104 + 32 * ks + 8 * lq);
#pragma unroll
                        for (int nt = 0; nt < 4; ++nt) { const bf16x8 bw = *(const bf16x8*)(W2t + (16 * nt + l15) * 104 + 32 * ks + 8 * lq), ba = *(const bf16x8*)(A2t + (16 * nt + l15) * 104 + 32 * ks + 8 * lq);
                            accW[nt] = MFMA16(afw, bw, accW[nt]); accA[nt] = MFMA16(afa, ba, accA[nt]); } }
                    float r_[4], kx0[4], v_[4], dec[4], a_[4], kkv[4]; float ss = 0.f;
#pragma unroll
                    for (int nt = 0; nt < 4; ++nt) { const int k = 16 * nt + l15;
                        const float wl = w0k[nt] + (w4 == 0 ? accW[nt][0] : w4 == 1 ? accW[nt][1] : w4 == 2 ? accW[nt][2] : accW[nt][3]);
                        const float al = a0k[nt] + (w4 == 0 ? accA[nt][0] : w4 == 1 ? accA[nt][1] : w4 == 2 ? accA[nt][2] : accA[nt][3]);
                        const float rr = bf2f(raw[(0 * 17 + tl + 1) * 64 + k]), rp_ = bf2f(raw[(0 * 17 + tl) * 64 + k]);
                        const float kr_ = bf2f(raw[(1 * 17 + tl + 1) * 64 + k]), kp = bf2f(raw[(1 * 17 + tl) * 64 + k]);
                        const float vr = bf2f(raw[(2 * 17 + tl + 1) * 64 + k]), vp = bf2f(raw[(2 * 17 + tl) * 64 + k]);
                        r_[nt] = rr + (rp_ - rr) * mu_r[nt]; kx0[nt] = kr_ + (kp - kr_) * mu_k[nt]; v_[nt] = vr + (vp - vr) * mu_v[nt];
                        dec[nt] = __expf(-0.60653066f * fsigmoid(wl)); a_[nt] = fsigmoid(al);
                        kkv[nt] = kx0[nt] * kkk[nt]; ss += kkv[nt] * kkv[nt]; }
                    const float rinv = rsqrtf(fmaxf(row16_sum(ss), 1e-24f));
                    float br = 0.f, krs = 0.f, bon = 0.f; float* vb = vnext + tl * 384;
#pragma unroll
                    for (int nt = 0; nt < 4; ++nt) { const int k = 16 * nt + l15;
                        const float kk = kkv[nt] * rinv, kmod = kx0[nt] * (1.0f + (a_[nt] - 1.0f) * kak[nt]), kb = kk * a_[nt];
                        br += kb * r_[nt]; krs += kmod * r_[nt]; bon += r_[nt] * kmod * rkk[nt];
                        vb[k] = dec[nt]; vb[64 + k] = -kk; vb[128 + k] = kb; vb[192 + k] = kmod; vb[256 + k] = dec[nt] * r_[nt]; vb[320 + k] = v_[nt]; }
                    br = row16_sum(br); krs = row16_sum(krs); bon = row16_sum(bon);
                    if (l15 == 0) { snext[tl * 4] = br; snext[tl * 4 + 1] = krs; snext[tl * 4 + 2] = bon; }
                }
                LBAR();
            }
#undef RW_PREFETCH
        }
        __syncthreads();
    }
}

#ifndef PROBE_ROLE
#define PROBE_ROLE -1
#endif
#define LBARW() do { if (PROBE_ROLE >= 0 && wave == PROBE_ROLE) { const unsigned long long tb_ = __builtin_amdgcn_s_memrealtime(); LBAR(); twait += __builtin_amdgcn_s_memrealtime() - tb_; } else { LBAR(); } } while (0)
__device__ void ptanh_phase(const Params& p) {
    u16* P = (u16*)(p.ws + OFF_P);
    const int gt = blockIdx.x * 512 + threadIdx.x, nth = gridDim.x * 512;
    for (int it = gt; it < NTOK * 24; it += nth) { const int row = it / 24, rem = it - row * 24, mt = rem / 12, g = rem - mt * 12;
        u16* cp = P + (size_t)row * 384 + mt * 192 + 8 * g;
        float c8[8], p8[8]; unpack8(*(const u32x4*)cp, c8);
        if ((row & (SEQL - 1)) != 0) unpack8(*(const u32x4*)(cp - 384 + 96), p8);
        else {
#pragma unroll
            for (int j = 0; j < 8; ++j) p8[j] = 0.f; }
#pragma unroll
        for (int j = 0; j < 8; ++j) { const float s = c8[j] + p8[j]; c8[j] = mt == 0 ? (1.0f - 2.0f * __builtin_amdgcn_rcpf(1.0f + __expf(2.0f * s))) : s; }
        *(u32x4*)cp = pack8(c8); }
}

__device__ unsigned long long rwkv2_phase(const Params& p, unsigned char* smem) {
    unsigned long long twait = 0;
    constexpr int TC = 16, NCH = SEQL / TC;
    u16* W2t = (u16*)smem;
    u16* A2t = W2t + 64 * 104;
    u16* raw = A2t + 64 * 104;
    u16* twa = raw + 3 * 17 * 64;
    u16* S1 = twa + 2 * 16 * 104;
    unsigned char* S1b = (unsigned char*)(S1 + 2 * 4 * 16 * 72);
    float* Mx = (float*)(S1b + 3 * 10560);
    u16* Mxb = (u16*)(Mx + 1024);
    u16* AhT = Mxb + 3 * 16 * 32;
    u16* VhT = AhT + 64 * 16;
    float* MVs = (float*)(VhT + 64 * 16);
    float* ssP = MVs + 16 * 64;
    float* bonP = ssP + 64;
    unsigned char* S2 = (unsigned char*)(bonP + 64);
    u16* Sb = (u16*)(S2 + 2 * 16896);
    const int tid = threadIdx.x, lane = tid & 63, wave = __builtin_amdgcn_readfirstlane(tid >> 6);
    const int l15 = lane & 15, lq = lane >> 4;
    u16* R = (u16*)(p.ws + OFF_R); const u16* Kb = (const u16*)(p.ws + OFF_KK); const u16* Vb = (const u16*)(p.ws + OFF_V); const u16* P = (const u16*)(p.ws + OFF_P);
    for (int unit = blockIdx.x; unit < 256; unit += gridDim.x) {
        const int b = unit >> 6, h = unit & 63, hc = 64 * h;
        for (int e = tid; e < 6144; e += 512) { const int j = e >> 6, k = e & 63; W2t[k * 104 + j] = f2bf(p.in[30][(size_t)j * 4096 + hc + k]); A2t[k * 104 + j] = f2bf(p.in[33][(size_t)j * 4096 + hc + k]); }
        for (int e = tid; e < 64 * 72; e += 512) Sb[e] = 0;
        for (int e = tid; e < 3 * 16 * 32; e += 512) Mxb[e] = 0;
        __syncthreads();
        if (wave < 4) {
            const int w4 = wave, ptid = tid, k = 16 * w4 + l15, kg = hc + k;
            const float mu_r = p.in[25][kg], mu_k = p.in[25][4096 + kg], mu_v = p.in[25][8192 + kg];
            const float w0k = p.in[28][kg], a0k = p.in[31][kg], kkk = p.in[34][kg], kak = p.in[35][kg], rkk = p.in[36][kg];
            u32x4 pfP[2]; u32x2 pfR[4];
#define RW_PREFETCH(c) do { const int row0_ = b * SEQL + (c) * TC; \
                _Pragma("unroll") for (int i = 0; i < 2; ++i) { const int it = ptid + 256 * i; const int mt = it / 192, rem = it - mt * 192, t_ = rem / 12, g_ = rem - t_ * 12; \
                    if (it < 384) pfP[i] = *(const u32x4*)(P + (size_t)(row0_ + t_) * 384 + mt * 192 + 8 * g_); } \
                _Pragma("unroll") for (int i = 0; i < 4; ++i) { const int it = ptid + 256 * i; const int ar = it / 272, rem = it - ar * 272, rr_ = rem >> 4, c4 = rem & 15; \
                    if (it < 816) { const u16* src_ = ar == 0 ? (const u16*)R : ar == 1 ? Kb : Vb; \
                        pfR[i] = ((c) == 0 && rr_ == 0) ? (u32x2){0u, 0u} : *(const u32x2*)(src_ + (size_t)(row0_ - 1 + rr_) * 4096 + hc + 4 * c4); } } } while (0)
            RW_PREFETCH(0);
            for (int pc = 0; pc <= NCH + 1; ++pc) {
                const bool prep = (pc < NCH);
                int ln_ = lane; asm volatile("" : "+v"(ln_)); const int l15 = ln_ & 15, lq = ln_ >> 4;
                u16* set1 = S1 + (pc & 1) * (4 * 16 * 72);
                u16* At = set1; u16* Rt = set1 + 16 * 72; u16* Bt = set1 + 2 * 16 * 72; u16* Kt = set1 + 3 * 16 * 72;
                unsigned char* set1b = S1b + (pc % 3) * 10560;
                float* Vf = (float*)set1b; u16* BKT = (u16*)(set1b + 4096); u16* VT = (u16*)(set1b + 8192); float* W15 = (float*)(set1b + 10240); float* bonus = (float*)(set1b + 10496);
                if (prep) {
#pragma unroll
                    for (int i = 0; i < 2; ++i) { const int it = ptid + 256 * i; const int mt = it / 192, rem = it - mt * 192, t_ = rem / 12, g_ = rem - t_ * 12;
                        if (it < 384) *(u32x4*)(twa + (mt * 16 + t_) * 104 + 8 * g_) = pfP[i]; }
#pragma unroll
                    for (int i = 0; i < 4; ++i) { const int it = ptid + 256 * i; const int ar = it / 272, rem = it - ar * 272, rr_ = rem >> 4, c4 = rem & 15;
                        if (it < 816) *(u32x2*)(raw + (ar * 17 + rr_) * 64 + 4 * c4) = pfR[i]; }
                }
                if (pc + 1 < NCH) RW_PREFETCH(pc + 1);
                LBARW();
                float au[4], bu[4];
                if (prep) {
                    float kkv[4], a_[4], eP[4], eTi[4];
                    f32x4 accW = {0.f, 0.f, 0.f, 0.f}, accA = {0.f, 0.f, 0.f, 0.f};
#pragma unroll
                    for (int ks = 0; ks < 3; ++ks) { const bf16x8 afw = *(const bf16x8*)(twa + l15 * 104 + 32 * ks + 8 * lq), afa = *(const bf16x8*)(twa + (16 + l15) * 104 + 32 * ks + 8 * lq);
                        const bf16x8 bwf = *(const bf16x8*)(W2t + k * 104 + 32 * ks + 8 * lq), baf = *(const bf16x8*)(A2t + k * 104 + 32 * ks + 8 * lq);
                        accW = MFMA16(afw, bwf, accW); accA = MFMA16(afa, baf, accA); }
                    float ld[4]; f32x4 cum = {0.f, 0.f, 0.f, 0.f};
#pragma unroll
                    for (int r = 0; r < 4; ++r) ld[r] = -0.60653066f * fsigmoid(w0k + accW[r]);
#pragma unroll
                    for (int r = 0; r < 4; ++r) cum = __builtin_amdgcn_mfma_f32_16x16x4f32((4 * lq + r <= l15) ? 1.0f : 0.0f, ld[r], cum, 0, 0, 0);
                    float kmq[4], vq[4];
#pragma unroll
                    for (int r = 0; r < 4; ++r) { const int t = 4 * lq + r;
                        const float rr = bf2f(raw[(0 * 17 + t + 1) * 64 + k]), rp_ = bf2f(raw[(0 * 17 + t) * 64 + k]);
                        const float kr_ = bf2f(raw[(1 * 17 + t + 1) * 64 + k]), kp = bf2f(raw[(1 * 17 + t) * 64 + k]);
                        const float vr = bf2f(raw[(2 * 17 + t + 1) * 64 + k]), vp = bf2f(raw[(2 * 17 + t) * 64 + k]);
                        const float r_ = rr + (rp_ - rr) * mu_r, kx0 = kr_ + (kp - kr_) * mu_k, v_ = vr + (vp - vr) * mu_v;
                        a_[r] = fsigmoid(a0k + accA[r]); kkv[r] = kx0 * kkk;
                        const float kmod = kx0 * (1.0f + (a_[r] - 1.0f) * kak);
                        const float eT = __expf(cum[r]); eTi[r] = __builtin_amdgcn_rcpf(eT); eP[r] = __expf(cum[r] - ld[r]);
                        const float ssp = row16_sum(kkv[r] * kkv[r]), bop = row16_sum(r_ * kmod * rkk);
                        if (l15 == 0) { ssP[t * 4 + w4] = ssp; bonP[t * 4 + w4] = bop; }
                        Rt[t * 72 + k] = f2bf(r_ * eT); kmq[r] = kmod * eTi[r]; Kt[t * 72 + k] = f2bf(kmq[r]);
                        Vf[t * 64 + k] = v_; vq[r] = v_;
                        au[r] = -kkv[r] * eP[r]; bu[r] = kkv[r] * a_[r] * eTi[r];
                        if (t == 15) W15[k] = eT; }
                    { u32x2 w_; w_.x = pk2(kmq[0], kmq[1]); w_.y = pk2(kmq[2], kmq[3]); *(u32x2*)(BKT + k * 32 + lq * 8 + 4) = w_; }
                    { u32x2 w_; w_.x = pk2(vq[0], vq[1]); w_.y = pk2(vq[2], vq[3]); *(u32x2*)(VT + k * 16 + 4 * lq) = w_; }
                }
                LBARW();
                if (prep) {
                    float bq[4];
#pragma unroll
                    for (int r = 0; r < 4; ++r) { const int t = 4 * lq + r; const f32x4 s4 = *(const f32x4*)(ssP + t * 4);
                        const float rinv = rsqrtf(fmaxf((s4[0] + s4[1]) + (s4[2] + s4[3]), 1e-24f));
                        At[t * 72 + k] = f2bf(au[r] * rinv); bq[r] = bu[r] * rinv; Bt[t * 72 + k] = f2bf(bq[r]);
                        if (w4 == 0 && l15 == 0) { const f32x4 b4 = *(const f32x4*)(bonP + t * 4); bonus[t] = (b4[0] + b4[1]) + (b4[2] + b4[3]); } }
                    { u32x2 w_; w_.x = pk2(bq[0], bq[1]); w_.y = pk2(bq[2], bq[3]); *(u32x2*)(BKT + k * 32 + lq * 8) = w_; }
                }
                LBARW();
            }
#undef RW_PREFETCH
        } else if (wave < 6) {
            for (int pc = 0; pc <= NCH + 1; ++pc) {
                const int cm = pc - 1; const bool act = (cm >= 0 && cm < NCH);
                int ln_ = lane; asm volatile("" : "+v"(ln_)); const int lane = ln_, l15 = ln_ & 15, lq = ln_ >> 4; (void)lane;
                const u16* set1 = S1 + (cm & 1) * (4 * 16 * 72);
                const u16* At = set1; const u16* Rt = set1 + 16 * 72; const u16* Bt = set1 + 2 * 16 * 72; const u16* Kt = set1 + 3 * 16 * 72;
                if (act) {
                    f32x4 m0 = {0.f, 0.f, 0.f, 0.f}, m1 = {0.f, 0.f, 0.f, 0.f};
                    const u16* Xt = (wave == 4) ? At : Rt;
#pragma unroll
                    for (int ks = 0; ks < 2; ++ks) { const int o = l15 * 72 + 32 * ks + 8 * lq;
                        const bf16x8 xf = *(const bf16x8*)(Xt + o), bf_ = *(const bf16x8*)(Bt + o), kf = *(const bf16x8*)(Kt + o);
                        m0 = MFMA16(xf, bf_, m0); m1 = MFMA16(xf, kf, m1); }
#pragma unroll
                    for (int r = 0; r < 4; ++r) { const int t = 4 * lq + r, s = l15;
                        if (wave == 4) { Mx[t * 16 + s] = (s < t) ? m0[r] : 0.f; Mxb[1024 + t * 32 + s] = f2bf((s < t) ? m1[r] : 0.f); }
                        else { Mxb[t * 32 + s] = f2bf((s <= t) ? m0[r] : 0.f); Mxb[512 + t * 32 + s] = f2bf((s <= t) ? m1[r] : 0.f); } }
                }
                LBARW();
                if (act) {
                    unsigned char* set2 = S2 + (cm & 1) * 16896;
                    const float* Vf = (const float*)(S1b + (cm % 3) * 10560);
#define TRI_ROW(dst, base, t) do { dst[0] = *(const f32x4*)(Mx + (base) + (t) * 16); dst[1] = *(const f32x4*)(Mx + (base) + (t) * 16 + 4); dst[2] = *(const f32x4*)(Mx + (base) + (t) * 16 + 8); dst[3] = *(const f32x4*)(Mx + (base) + (t) * 16 + 12); } while (0)
#define TRI_NEXT(rc, rn) do { _Pragma("unroll") for (int i_ = 0; i_ < 4; ++i_) rc[i_] = rn[i_]; asm volatile("" ::: "memory"); } while (0)
                    if (wave == 4) {
                        u16* Ah = (u16*)set2;
                        float ah[16], x0[16];
#pragma unroll
                        for (int t = 0; t < 16; ++t) x0[t] = bf2f(At[t * 72 + lane]);
                        f32x4 rc[4], rn[4];
                        TRI_ROW(rc, 0, 0);
#pragma unroll
                        for (int t = 0; t < 16; ++t) { if (t < 15) TRI_ROW(rn, 0, t + 1);
                            float pa[4] = {x0[t], 0.f, 0.f, 0.f};
#pragma unroll
                            for (int s = 0; s + 1 < t; ++s) pa[s & 3] += rc[s >> 2][s & 3] * ah[s];
                            float acc = (pa[0] + pa[1]) + (pa[2] + pa[3]);
                            if (t >= 1) acc += rc[(t - 1) >> 2][(t - 1) & 3] * ah[t - 1];
                            ah[t] = acc; Ah[t * 72 + lane] = f2bf(acc);
                            TRI_NEXT(rc, rn); }
                        { u32x4 q0, q1; q0.x = pk2(ah[0], ah[1]); q0.y = pk2(ah[2], ah[3]); q0.z = pk2(ah[4], ah[5]); q0.w = pk2(ah[6], ah[7]);
                          q1.x = pk2(ah[8], ah[9]); q1.y = pk2(ah[10], ah[11]); q1.z = pk2(ah[12], ah[13]); q1.w = pk2(ah[14], ah[15]);
                          *(u32x4*)(AhT + lane * 16) = q0; *(u32x4*)(AhT + lane * 16 + 8) = q1; }
                    } else {
                        float* Vh = (float*)(set2 + 4608);
                        { const u16* VT = (const u16*)(S1b + (cm % 3) * 10560 + 8192);
                          const bf16x8 makf = *(const bf16x8*)(Mxb + 1024 + l15 * 32 + 8 * lq);
#pragma unroll
                          for (int nt = 0; nt < 4; ++nt) { u32x4 vz = {0u, 0u, 0u, 0u}; if (lq < 2) vz = *(const u32x4*)(VT + (16 * nt + l15) * 16 + 8 * lq);
                              const f32x4 d = MFMA16(makf, as_frag(vz), ((f32x4){0.f, 0.f, 0.f, 0.f}));
#pragma unroll
                              for (int r = 0; r < 4; ++r) MVs[(4 * lq + r) * 64 + 16 * nt + l15] = d[r]; }
                          asm volatile("s_waitcnt lgkmcnt(0)" ::: "memory"); }
                        float vh[16], x0[16];
#pragma unroll
                        for (int t = 0; t < 16; ++t) x0[t] = MVs[t * 64 + lane];
                        f32x4 rc[4], rn[4];
                        TRI_ROW(rc, 0, 0);
#pragma unroll
                        for (int t = 0; t < 16; ++t) { if (t < 15) TRI_ROW(rn, 0, t + 1);
                            float pa[4] = {x0[t], 0.f, 0.f, 0.f};
#pragma unroll
                            for (int s = 0; s + 1 < t; ++s) pa[s & 3] += rc[s >> 2][s & 3] * vh[s];
                            float acc = (pa[0] + pa[1]) + (pa[2] + pa[3]);
                            if (t >= 1) acc += rc[(t - 1) >> 2][(t - 1) & 3] * vh[t - 1];
                            vh[t] = acc; Vh[t * 64 + lane] = acc;
                            TRI_NEXT(rc, rn); }
                        { u32x4 q0, q1; q0.x = pk2(vh[0], vh[1]); q0.y = pk2(vh[2], vh[3]); q0.z = pk2(vh[4], vh[5]); q0.w = pk2(vh[6], vh[7]);
                          q1.x = pk2(vh[8], vh[9]); q1.y = pk2(vh[10], vh[11]); q1.z = pk2(vh[12], vh[13]); q1.w = pk2(vh[14], vh[15]);
                          *(u32x4*)(VhT + lane * 16) = q0; *(u32x4*)(VhT + lane * 16 + 8) = q1; }
                    }
                }
#undef TRI_ROW
#undef TRI_NEXT
                LBARW();
                if (act) {
                    unsigned char* set2 = S2 + (cm & 1) * 16896;
                    const bf16x8 mrbf = *(const bf16x8*)(Mxb + l15 * 32 + 8 * lq);
                    if (wave == 4) {
                        u16* Rh = (u16*)(set2 + 2304); float* Yk = (float*)(set2 + 12800);
                        const u16* VT = (const u16*)(S1b + (cm % 3) * 10560 + 8192);
                        const bf16x8 mrkf = *(const bf16x8*)(Mxb + 512 + l15 * 32 + 8 * lq);
#pragma unroll
                        for (int nt = 0; nt < 4; ++nt) { u32x4 az = {0u, 0u, 0u, 0u}, vz = {0u, 0u, 0u, 0u};
                            if (lq < 2) { az = *(const u32x4*)(AhT + (16 * nt + l15) * 16 + 8 * lq); vz = *(const u32x4*)(VT + (16 * nt + l15) * 16 + 8 * lq); }
                            const f32x4 d = MFMA16(mrbf, as_frag(az), ((f32x4){0.f, 0.f, 0.f, 0.f})), e = MFMA16(mrkf, as_frag(vz), ((f32x4){0.f, 0.f, 0.f, 0.f}));
#pragma unroll
                            for (int r = 0; r < 4; ++r) { const int o = (4 * lq + r) * 72 + 16 * nt + l15; Rh[o] = f2bf(d[r] + bf2f(Rt[o])); Yk[(4 * lq + r) * 64 + 16 * nt + l15] = e[r]; } }
                    } else {
                        float* Yh = (float*)(set2 + 8704);
#pragma unroll
                        for (int nt = 0; nt < 4; ++nt) { u32x4 vz = {0u, 0u, 0u, 0u}; if (lq < 2) vz = *(const u32x4*)(VhT + (16 * nt + l15) * 16 + 8 * lq);
                            const f32x4 d = MFMA16(mrbf, as_frag(vz), ((f32x4){0.f, 0.f, 0.f, 0.f}));
#pragma unroll
                            for (int r = 0; r < 4; ++r) Yh[(4 * lq + r) * 64 + 16 * nt + l15] = d[r]; }
                    }
                }
                LBARW();
            }
        } else {
            const int ws = wave - 6;
            float gng[4], gnb[4];
#pragma unroll
            for (int nt = 0; nt < 4; ++nt) { gng[nt] = p.in[37][hc + 16 * nt + l15]; gnb[nt] = p.in[38][hc + 16 * nt + l15]; }
            f32x4 accS[2][4];
#pragma unroll
            for (int m = 0; m < 2; ++m)
#pragma unroll
                for (int n = 0; n < 4; ++n) accS[m][n] = (f32x4){0.f, 0.f, 0.f, 0.f};
            for (int pc = 0; pc <= NCH + 1; ++pc) {
                const int cs = pc - 2; const bool act = (cs >= 0 && cs < NCH); const bool doY = act && ((cs & 1) == ws);
                int ln_ = lane; asm volatile("" : "+v"(ln_)); const int lane = ln_, l15 = ln_ & 15, lq = ln_ >> 4; (void)lane;
                const unsigned char* set2 = S2 + (cs & 1) * 16896;
                const u16* Ah = (const u16*)set2; const u16* Rh = (const u16*)(set2 + 2304); const float* Vh = (const float*)(set2 + 4608); const float* Yh = (const float*)(set2 + 8704); const float* Yk = (const float*)(set2 + 12800);
                const unsigned char* set1b = S1b + (((cs % 3) + 3) % 3) * 10560;
                const float* Vf = (const float*)set1b; const u16* BKT = (const u16*)(set1b + 4096); const u16* VT = (const u16*)(set1b + 8192); const float* W15 = (const float*)(set1b + 10240); const float* bonus = (const float*)(set1b + 10496);
                f32x4 accY[4];
                if (act) {
                    bf16x8 ahf[2];
#pragma unroll
                    for (int ks = 0; ks < 2; ++ks) ahf[ks] = *(const bf16x8*)(Ah + l15 * 72 + 32 * ks + 8 * lq);
                    f32x4 accSA[2];
#pragma unroll
                    for (int m = 0; m < 2; ++m) { const int vb = 16 * (2 * ws + m);
#pragma unroll
                        for (int r = 0; r < 4; ++r) accSA[m][r] = Vh[(4 * lq + r) * 64 + vb + l15];
#pragma unroll
                        for (int ks = 0; ks < 2; ++ks) { const bf16x8 sbf = *(const bf16x8*)(Sb + (vb + l15) * 72 + 32 * ks + 8 * lq); accSA[m] = MFMA16(ahf[ks], sbf, accSA[m]); } }
                    if (doY) {
                        bf16x8 rhf[2];
#pragma unroll
                        for (int ks = 0; ks < 2; ++ks) rhf[ks] = *(const bf16x8*)(Rh + l15 * 72 + 32 * ks + 8 * lq);
#pragma unroll
                        for (int nt = 0; nt < 4; ++nt) {
#pragma unroll
                            for (int r = 0; r < 4; ++r) accY[nt][r] = Yh[(4 * lq + r) * 64 + 16 * nt + l15] + Yk[(4 * lq + r) * 64 + 16 * nt + l15];
#pragma unroll
                            for (int ks = 0; ks < 2; ++ks) { const bf16x8 sbf = *(const bf16x8*)(Sb + (16 * nt + l15) * 72 + 32 * ks + 8 * lq); accY[nt] = MFMA16(rhf[ks], sbf, accY[nt]); } }
                    }
#pragma unroll
                    for (int m = 0; m < 2; ++m) { const int vb = 16 * (2 * ws + m);
                        u32x4 af; af.x = pk2(accSA[m][0], accSA[m][1]); af.y = pk2(accSA[m][2], accSA[m][3]);
                        const u32x2 vt = *(const u32x2*)(VT + (vb + l15) * 16 + 4 * lq); af.z = vt.x; af.w = vt.y;
#pragma unroll
                        for (int n = 0; n < 4; ++n) { const bf16x8 bkf = *(const bf16x8*)(BKT + (16 * n + l15) * 32 + 8 * lq); accS[m][n] = MFMA16(as_frag(af), bkf, accS[m][n]); } }
#pragma unroll
                    for (int n = 0; n < 4; ++n) { const float w = W15[16 * n + l15];
#pragma unroll
                        for (int m = 0; m < 2; ++m) accS[m][n] = accS[m][n] * w; }
                }
                LBARW();
                if (act) {
#pragma unroll
                    for (int m = 0; m < 2; ++m)
#pragma unroll
                        for (int n = 0; n < 4; ++n)
#pragma unroll
                            for (int r = 0; r < 4; ++r) Sb[(16 * (2 * ws + m) + 4 * lq + r) * 72 + 16 * n + l15] = f2bf(accS[m][n][r]);
                }
                if (doY) {
#pragma unroll
                    for (int r = 0; r < 4; ++r) { const int t = 4 * lq + r; const size_t row = (size_t)(b * SEQL + cs * TC + t);
                        const float mu = row16_sum(accY[0][r] + accY[1][r] + accY[2][r] + accY[3][r]) * (1.0f / 64.0f);
                        float d[4], s2 = 0.f;
#pragma unroll
                        for (int nt = 0; nt < 4; ++nt) { d[nt] = accY[nt][r] - mu; s2 += d[nt] * d[nt]; }
                        const float rs = rsqrtf(row16_sum(s2) * (1.0f / 64.0f) + 64e-5f), bon = bonus[t];
#pragma unroll
                        for (int nt = 0; nt < 4; ++nt) R[row * 4096 + hc + 16 * nt + l15] = f2bf(d[nt] * rs * gng[nt] + gnb[nt] + bon * Vf[t * 64 + 16 * nt + l15]); }
                }
                LBARW();
                LBARW();
            }
        }
        __syncthreads();
    }
    return twait;
}

__global__ void __launch_bounds__(512, 2) mega(Params p) {
    extern __shared__ __attribute__((aligned(16))) unsigned char smem[];
    cg::grid_group grid = cg::this_grid();
    const int lo = p.ph_lo, hi = p.ph_hi;
#define IN(k) (lo <= (k) && (k) < hi)
#define SEAM(k) do { if (IN(k) && IN((k) + 1)) grid.sync(); if (PROBE_PH >= 0) { const unsigned long long tn_ = __builtin_amdgcn_s_memrealtime(); if ((PROBE_PH >> (k)) & 1) tp1 += tn_ - tp0; tp0 = tn_; } } while (0)
    unsigned long long tp0 = (PROBE_PH >= 0) ? __builtin_amdgcn_s_memrealtime() : 0ull, tp1 = 0;
    unsigned char* ws = p.ws;
    PG8_LAS unsigned char* glds = (PG8_LAS unsigned char*)smem;
    if (IN(0)) for (int rep_ = 0; rep_ < 1 + (REP_MASK & 1); ++rep_) {
        tconv(smem, p.in[2], 8192, 0, 8192, 2048, (u16*)(ws + OFF_W0IN), 2048);
        tconv(smem, p.in[21], 2048, 0, 2048, 4096, (u16*)(ws + OFF_W0OUT), 4096);
        prep_small(p);
        rows_phase<0>(p);
    }
    SEAM(0);
    if (IN(1)) {
        pg8::Gemm g{(const u16*)(ws + OFF_H), (const u16*)(ws + OFF_W0IN), NTOK, 8192, 2048}; pg8::StaticOrder S; S.init(NTOK, 8192, gridDim.x, blockIdx.x);
        pg8::EpiG<F1> E{F1{(u16*)(ws + OFF_XR), (u16*)(ws + OFF_XM), (u16*)(ws + OFF_Y0)}};
        pg8::gemm_phase(glds, g, S, E); if ((REP_MASK >> 1) & 1) pg8::gemm_phase(glds, g, S, E);
    }
    SEAM(1);
    if (IN(2)) {
        mqk_phase(p, smem); if ((REP_MASK >> 2) & 1) { mqk_phase(p, smem); }
        lru_phase<1>(p, smem); if ((REP_MASK >> 3) & 1) { lru_phase<1>(p, smem); }
        tconv(smem, p.in[24], 16384, 0, 8192, 2048, (u16*)(ws + OFF_W1), 2048); if ((REP_MASK >> 4) & 1) { tconv(smem, p.in[24], 16384, 0, 8192, 2048, (u16*)(ws + OFF_W1), 2048); }
    }
    SEAM(2);
    if (IN(3)) lru_carry(p); if ((REP_MASK >> 5) & 1) { lru_carry(p); }
    SEAM(3);
    if (IN(4)) {
#ifdef PROBE_SUB
        const unsigned long long ta_ = __builtin_amdgcn_s_memrealtime();
#endif
        mlstm_phase(p, smem);
#ifdef PROBE_SUB
        tp1 += __builtin_amdgcn_s_memrealtime() - ta_;
#endif
        lru_phase<2>(p, smem); }
    SEAM(4);
    if (IN(5)) mnorm_phase(p);
    SEAM(5);
    if (IN(6)) {
        pg8::Gemm g{(const u16*)(ws + OFF_Y0), (const u16*)(ws + OFF_W0OUT), NTOK, 2048, 4096}; pg8::StaticOrder S; S.init(NTOK, 2048, gridDim.x, blockIdx.x);
        pg8::EpiG<F2> E{F2{(u16*)(ws + OFF_M0)}};
        pg8::gemm_phase(glds, g, S, E); if ((REP_MASK >> 7) & 1) pg8::gemm_phase(glds, g, S, E);
    }
    SEAM(6);
    if (IN(7)) {
        rows_phase<1>(p); if ((REP_MASK >> 8) & 1) { rows_phase<1>(p); }
        tconv(smem, p.in[24], 16384, 8192, 4096, 2048, (u16*)(ws + OFF_W1) + (size_t)8192 * 2048, 2048); if ((REP_MASK >> 4) & 1) { tconv(smem, p.in[24], 16384, 8192, 4096, 2048, (u16*)(ws + OFF_W1) + (size_t)8192 * 2048, 2048); }
        prep_extras(p); if ((REP_MASK >> 4) & 1) { prep_extras(p); }
    }
    SEAM(7);
    if (IN(8)) {
        pg8::Gemm g{(const u16*)(ws + OFF_H), (const u16*)(ws + OFF_W1), NTOK, 12800, 2048}; pg8::StaticOrder S; S.init(NTOK, 12800, gridDim.x, blockIdx.x);
        pg8::EpiG<F3> E{F3{(u16*)(ws + OFF_R), (u16*)(ws + OFF_P)}};
        pg8::gemm_phase(glds, g, S, E); if ((REP_MASK >> 9) & 1) pg8::gemm_phase(glds, g, S, E);
    }
    SEAM(8);
    if (IN(9)) {
#if RWKV_CHUNKED
        ptanh_phase(p);
        grid.sync();
        { const unsigned long long tw_ = rwkv2_phase(p, smem); if (PROBE_ROLE >= 0) tp1 += tw_; }
#else
        rwkv_phase(p, smem);
#endif
        tconv(smem, p.in[24], 16384, 12288, 4096, 2048, (u16*)(ws + OFF_W1Z), 2048); if ((REP_MASK >> 4) & 1) { tconv(smem, p.in[24], 16384, 12288, 4096, 2048, (u16*)(ws + OFF_W1Z), 2048); }
        tconv(smem, p.in[39], 2048, 0, 2048, 4096, (u16*)(ws + OFF_W1OUT), 4096); if ((REP_MASK >> 4) & 1) { tconv(smem, p.in[39], 2048, 0, 2048, 4096, (u16*)(ws + OFF_W1OUT), 4096); }
    }
    SEAM(9);
    if (IN(10)) {
        pg8::Gemm g{(const u16*)(ws + OFF_H), (const u16*)(ws + OFF_W1Z), NTOK, 4096, 2048}; pg8::StaticOrder S; S.init(NTOK, 4096, gridDim.x, blockIdx.x);
        pg8::EpiG<F4> E{F4{(u16*)(ws + OFF_R)}};
        pg8::gemm_phase(glds, g, S, E);
    }
    SEAM(10);
    if (IN(11)) {
        pg8::Gemm g{(const u16*)(ws + OFF_R), (const u16*)(ws + OFF_W1OUT), NTOK, 2048, 4096}; pg8::StaticOrder S; S.init(NTOK, 2048, gridDim.x, blockIdx.x);
        pg8::EpiG<F2> E{F2{(u16*)(ws + OFF_M1)}};
        pg8::gemm_phase(glds, g, S, E); if ((REP_MASK >> 10) & 1) pg8::gemm_phase(glds, g, S, E);
    }
    SEAM(11);
    if (IN(12)) rows_phase<2>(p);
#ifdef PROBE_SUB
    { const unsigned long long te = __builtin_amdgcn_s_memrealtime(); while (__builtin_amdgcn_s_memrealtime() - te < tp1) __builtin_amdgcn_s_sleep(8); }
#endif
    if (PROBE_PH >= 0) { const unsigned long long te = __builtin_amdgcn_s_memrealtime(); while (__builtin_amdgcn_s_memrealtime() - te < tp1) __builtin_amdgcn_s_sleep(8); }
}

extern "C" void kernel_launch(void* const* d_in, const int* in_sizes, int n_in, void* d_out, int out_size, void* d_ws, size_t ws_size, hipStream_t stream) {
    static int grid_blocks = 0;
    if (!grid_blocks) {
        if (n_in != 41 || ws_size < WS_NEED) { fprintf(stderr, "kernel_launch: unexpected n_in %d / ws_size %zu (need %zu)\n", n_in, ws_size, (size_t)WS_NEED); grid_blocks = -1; }
        else {
            int dev = 0, cus = 0, per_cu = 0;
            hipGetDevice(&dev);
            hipDeviceGetAttribute(&cus, hipDeviceAttributeMultiprocessorCount, dev);
            if (hipFuncSetAttribute((const void*)mega, hipFuncAttributeMaxDynamicSharedMemorySize, LDS_BYTES) != hipSuccess) fprintf(stderr, "kernel_launch: hipFuncSetAttribute failed\n");
            hipOccupancyMaxActiveBlocksPerMultiprocessor(&per_cu, (const void*)mega, 512, LDS_BYTES);
            if (per_cu < 1) { fprintf(stderr, "kernel_launch: occupancy query says %d blocks/CU\n", per_cu); per_cu = 1; }
            grid_blocks = cus * 1;
            if (grid_blocks > cus * per_cu) grid_blocks = cus * per_cu;
        }
    }
    if (grid_blocks <= 0) return;
    Params p{};
    for (int i = 0; i < 41; ++i) p.in[i] = (const float*)d_in[i];
    p.out = (float*)d_out; p.ws = (unsigned char*)d_ws;
#if N_LAUNCH_MODE == 1
    p.ph_lo = 0; p.ph_hi = NPH;
    { void* args[] = {&p};
      hipError_t e = hipLaunchCooperativeKernel((const void*)mega, dim3(grid_blocks), dim3(512), args, LDS_BYTES, stream);
      if (e != hipSuccess) fprintf(stderr, "cooperative launch failed: %s (grid %d)\n", hipGetErrorString(e), grid_blocks); }
#else
    for (int ph = 0; ph < NPH; ++ph) { p.ph_lo = ph; p.ph_hi = ph + 1; void* args[] = {&p};
        hipError_t e = hipLaunchCooperativeKernel((const void*)mega, dim3(grid_blocks), dim3(512), args, LDS_BYTES, stream);
        if (e != hipSuccess) { fprintf(stderr, "launch %d failed: %s (grid %d)\n", ph, hipGetErrorString(e), grid_blocks); break; } }
#endif
}
```

```cpp
#include <hip/hip_runtime.h>
#include <hip/hip_cooperative_groups.h>
#include <cstdio>
namespace cg = cooperative_groups;

#ifndef REP_MASK
#define REP_MASK 0
#endif
#ifndef PROBE_PH
#define PROBE_PH -1
#endif
#define REPS(k) for (int rep_ = 0; rep_ < 1 + ((REP_MASK >> (k)) & 1); ++rep_)
#ifndef RWKV_CHUNKED
#define RWKV_CHUNKED 1
#endif
#ifndef N_LAUNCH_MODE
#define N_LAUNCH_MODE 1
#endif

typedef unsigned short u16;
typedef short bf16x8 __attribute__((ext_vector_type(8)));
typedef float f32x4 __attribute__((ext_vector_type(4)));
typedef float f32x2 __attribute__((ext_vector_type(2)));
typedef unsigned u32x4 __attribute__((ext_vector_type(4)));
typedef unsigned u32x2 __attribute__((ext_vector_type(2)));

constexpr int NTOK = 16384, DM = 2048, SEQL = 4096;
constexpr size_t MiB = (size_t)1 << 20;
constexpr size_t OFF_H = 0;
constexpr size_t OFF_XR = 64 * MiB;
constexpr size_t OFF_XM = 128 * MiB;
constexpr size_t OFF_Y0 = 192 * MiB;
constexpr size_t OFF_Q = 320 * MiB;
constexpr size_t OFF_KX = 384 * MiB;
constexpr size_t OFF_W0IN = 448 * MiB;
constexpr size_t OFF_W0OUT = 480 * MiB;
constexpr size_t OFF_SMALL = 496 * MiB;
constexpr size_t OFF_G = OFF_SMALL;
constexpr size_t OFF_LRUA = OFF_SMALL + 1 * MiB;
constexpr size_t OFF_LRUH = OFF_SMALL + 3 * MiB;
constexpr size_t OFF_LRUC = OFF_SMALL + 5 * MiB;
constexpr size_t OFF_LRUW = OFF_SMALL + 7 * MiB;
constexpr size_t OFF_WGT = OFF_SMALL + 8 * MiB;
constexpr size_t OFF_M0 = OFF_XR;
constexpr size_t OFF_R = 64 * MiB, OFF_KK = 192 * MiB, OFF_V = 320 * MiB;
constexpr size_t OFF_W1 = 448 * MiB;
constexpr size_t OFF_P = 498 * MiB;
constexpr size_t OFF_W1Z = 448 * MiB, OFF_W1OUT = 464 * MiB;
constexpr size_t OFF_M1 = OFF_V;
constexpr size_t WS_NEED = 510 * MiB;
constexpr int LDS_BYTES = 160 * 1024;
constexpr int NPH = 13;

struct Params { const float* in[41]; float* out; unsigned char* ws; int ph_lo, ph_hi; };

__device__ __forceinline__ unsigned pk2(float lo, float hi) { unsigned r; asm volatile("v_cvt_pk_bf16_f32 %0, %1, %2" : "=v"(r) : "v"(lo), "v"(hi)); return r; }
__device__ __forceinline__ u16 f2bf(float f) { return (u16)(pk2(f, 0.f) & 0xffffu); }
__device__ __forceinline__ float bf2f(u16 v) { return __uint_as_float(((unsigned)v) << 16); }
__device__ __forceinline__ float bflo(unsigned w) { return __uint_as_float(w << 16); }
__device__ __forceinline__ float bfhi(unsigned w) { return __uint_as_float(w & 0xffff0000u); }
__device__ __forceinline__ void unpack8(u32x4 w, float* f) { f[0] = bflo(w.x); f[1] = bfhi(w.x); f[2] = bflo(w.y); f[3] = bfhi(w.y); f[4] = bflo(w.z); f[5] = bfhi(w.z); f[6] = bflo(w.w); f[7] = bfhi(w.w); }
__device__ __forceinline__ u32x4 pack8(const float* f) { u32x4 w; w.x = pk2(f[0], f[1]); w.y = pk2(f[2], f[3]); w.z = pk2(f[4], f[5]); w.w = pk2(f[6], f[7]); return w; }
__device__ __forceinline__ bf16x8 as_frag(u32x4 w) { union { u32x4 u; bf16x8 b; } c; c.u = w; return c.b; }
__device__ __forceinline__ float sigmoidf_(float x) { return 1.0f / (1.0f + __expf(-x)); }
__device__ __forceinline__ float siluf_(float x) { return x / (1.0f + __expf(-x)); }
__device__ __forceinline__ float softplusf_(float x) { return fmaxf(x, 0.f) + log1pf(__expf(-fabsf(x))); }
__device__ __forceinline__ float wave_sum(float v) {
#pragma unroll
    for (int o = 32; o; o >>= 1) v += __shfl_xor(v, o);
    return v;
}
template <int CTRL> __device__ __forceinline__ float dppf(float v) { return __int_as_float(__builtin_amdgcn_update_dpp(0, __float_as_int(v), CTRL, 0xF, 0xF, false)); }
__device__ __forceinline__ float wave_sum_dpp(float v) {
    v += dppf<0xB1>(v); v += dppf<0x4E>(v); v += dppf<0x141>(v); v += dppf<0x140>(v);
    const int iv = __float_as_int(v);
    return __int_as_float(__builtin_amdgcn_readlane(iv, 0)) + __int_as_float(__builtin_amdgcn_readlane(iv, 16)) + __int_as_float(__builtin_amdgcn_readlane(iv, 32)) + __int_as_float(__builtin_amdgcn_readlane(iv, 48));
}
#define MFMA16(a, b, c) __builtin_amdgcn_mfma_f32_16x16x32_bf16((a), (b), (c), 0, 0, 0)

namespace pg8 {
#define PG8_LAS __attribute__((address_space(3)))
typedef unsigned short bf16_t;
constexpr int BM = 256, BK = 64, HALF = 128, HTB = HALF * BK * 2, STAGE_BYTES = 8 * HTB, NXCD = 8, WGM = 8;
__host__ __device__ __forceinline__ int lds_byte(int r, int c) { const int st = (r >> 4) * 2 + (c >> 5), rr = r & 15, cc = c & 31, ob = rr * 64 + cc * 2; return st * 1024 + (ob ^ (((ob >> 9) & 1) << 5)); }
__host__ __device__ __forceinline__ void stage_rc(int b, int& R, int& C) { const int st = b / 1024, sb = b % 1024, swz = sb ^ (((sb >> 9) & 1) << 5); R = (st >> 1) * 16 + swz / 64; C = (st & 1) * 32 + (swz % 64) / 2; }
__host__ __device__ __forceinline__ int perm32(int rho) { const int n = rho >> 4, i = rho & 15; return 8 * (i >> 2) + 4 * n + (i & 3); }
struct Unit { int pm, pn; };
struct Gemm { const bf16_t* A; const bf16_t* Bt; int M, N, K; };
struct StaticOrder {
    int nM, nN, nwg, G, c;
    __host__ __device__ void init(int M, int N, int G_, int c_) { nM = M / BM; nN = N / BM; nwg = nM * nN; G = G_; c = c_; }
    __host__ __device__ bool next(int i, Unit& u) const {
        const long L = (long)i * G + c; if (L >= nwg) return false;
        int wgid = (int)L; { const int q = nwg / NXCD, r = nwg % NXCD, xcd = wgid % NXCD, off = wgid / NXCD; wgid = (xcd < r ? xcd * (q + 1) : r * (q + 1) + (xcd - r) * q) + off; }
        const int nig = WGM * nN, gid = wgid / nig, fm = gid * WGM, gsz = (nM - fm) < WGM ? (nM - fm) : WGM;
        u.pm = fm + ((wgid % nig) % gsz); u.pn = (wgid % nig) / gsz; return true;
    }
};
template <class F> struct EpiG {
    static constexpr bool PERM = true;
    F f;
    __device__ __forceinline__ void operator()(const f32x4 (&acc)[2][2][4][2], const Unit& u, int wr, int wc, int fr, int fq) const {
        const int row0 = u.pm * BM + wr * 64 + fr, col0 = u.pn * BM + wc * 32 + 8 * fq;
#pragma unroll
        for (int ai = 0; ai < 2; ++ai)
#pragma unroll
            for (int m = 0; m < 4; ++m)
#pragma unroll
                for (int bj = 0; bj < 2; ++bj) f(row0 + ai * HALF + m * 16, col0 + bj * HALF, acc[ai][bj][m][0], acc[ai][bj][m][1]);
    }
};

template <class Epi>
__device__ __forceinline__ void gemm_phase(PG8_LAS unsigned char* lds, const Gemm g, const StaticOrder& S, const Epi& E) {
    const int tid = threadIdx.x, wid = __builtin_amdgcn_readfirstlane(tid >> 6), lane = tid & 63, wr = wid >> 2, wc = wid & 3, fr = lane & 15, fq = lane >> 4;
    const int K = g.K, nt = K / BK;
    unsigned voffA[2], voffB[2];
#pragma unroll
    for (int i = 0; i < 2; ++i) { int R, C; stage_rc(tid * 16 + i * 8192, R, C); const int Rb = Epi::PERM ? ((R & ~31) + perm32(R & 31)) : R;
        voffA[i] = (unsigned)(R * K + C) * 2u; voffB[i] = (unsigned)(Rb * K + C) * 2u; }
    const size_t kstep = (size_t)(BK * 2);
    const size_t hstep = (size_t)HALF * K * 2;
    const size_t tstep = 2 * hstep;
    const unsigned ldsw = (unsigned)wid * 1024u;
    const int aoff = lds_byte(wr * 64 + fr, fq * 8), boff = lds_byte(wc * 32 + fr, fq * 8);
#define PG8_SA(b, h) (((b) * 2 + (h)) * HTB)
#define PG8_SB(b, h) ((4 + (b) * 2 + (h)) * HTB)
#define PG8_STAGE(bufoff, gbase, voff) do { _Pragma("unroll") for (int _i = 0; _i < 2; ++_i) \
        __builtin_amdgcn_global_load_lds((const unsigned*)((const char*)(gbase) + (voff)[_i]), (PG8_LAS unsigned*)(lds + (bufoff) + ldsw + _i * 8192), 16, 0, 0); } while (0)
#define PG8_LDA(dst, b, h) do { _Pragma("unroll") for (int m = 0; m < 4; ++m) _Pragma("unroll") for (int k = 0; k < 2; ++k) dst[m][k] = *(const PG8_LAS bf16x8*)(lds + PG8_SA(b, h) + aoff + m * 2048 + k * 1024); } while (0)
#define PG8_LDB(dst, b, h) do { _Pragma("unroll") for (int n = 0; n < 2; ++n) _Pragma("unroll") for (int k = 0; k < 2; ++k) dst[n][k] = *(const PG8_LAS bf16x8*)(lds + PG8_SB(b, h) + boff + n * 2048 + k * 1024); } while (0)
#define PG8_MMA(ai, bj, At, Bt) do { __builtin_amdgcn_s_setprio(1); _Pragma("unroll") for (int m = 0; m < 4; ++m) _Pragma("unroll") for (int n = 0; n < 2; ++n) _Pragma("unroll") for (int k = 0; k < 2; ++k) \
        acc[ai][bj][m][n] = __builtin_amdgcn_mfma_f32_16x16x32_bf16(Bt[n][k], At[m][k], acc[ai][bj][m][n], 0, 0, 0); __builtin_amdgcn_s_setprio(0); } while (0)
#define PG8_WAIT_V(n) asm volatile("s_waitcnt vmcnt(" #n ")" ::: "memory")
#define PG8_WAIT_L(n) asm volatile("s_waitcnt lgkmcnt(" #n ")" ::: "memory")
#define PG8_BAR __builtin_amdgcn_s_barrier()
#define PG8_SCHED __builtin_amdgcn_sched_barrier(0)
    Unit cur, nxt; int ui = 0;
    if (!S.next(0, cur)) return;
    f32x4 acc[2][2][4][2];
#pragma unroll
    for (int a = 0; a < 2; ++a)
#pragma unroll
        for (int b = 0; b < 2; ++b)
#pragma unroll
            for (int m = 0; m < 4; ++m)
#pragma unroll
                for (int n = 0; n < 2; ++n) acc[a][b][m][n] = (f32x4){0.f, 0.f, 0.f, 0.f};
    bf16x8 At[4][2], B0[2][2], B1[2][2];
    const char* cA = (const char*)g.A + (size_t)cur.pm * tstep; const char* cB = (const char*)g.Bt + (size_t)cur.pn * tstep;
    PG8_STAGE(PG8_SB(0, 0), cB, voffB); PG8_STAGE(PG8_SA(0, 0), cA, voffA); PG8_STAGE(PG8_SB(0, 1), cB + hstep, voffB); PG8_STAGE(PG8_SA(0, 1), cA + hstep, voffA);
    if (wr == 1) PG8_BAR;
    PG8_WAIT_V(4); PG8_BAR;
    PG8_STAGE(PG8_SB(1, 0), cB + kstep, voffB); PG8_STAGE(PG8_SA(1, 0), cA + kstep, voffA); PG8_STAGE(PG8_SB(1, 1), cB + hstep + kstep, voffB);
    PG8_WAIT_V(6); PG8_BAR;
    for (;;) {
        const bool has_next = S.next(ui + 1, nxt);
        const char* nA = has_next ? (const char*)g.A + (size_t)nxt.pm * tstep : cA; const char* nB = has_next ? (const char*)g.Bt + (size_t)nxt.pn * tstep : cB;
        for (int t = 0; t < nt; t += 2) {
            const bool last = (t == nt - 2);
            const char* a1 = cA + (size_t)(t + 1) * kstep;
            const char* a2 = last ? nA : cA + (size_t)(t + 2) * kstep; const char* b2 = last ? nB : cB + (size_t)(t + 2) * kstep;
            const char* a3 = a2 + kstep; const char* b3 = b2 + kstep;
            PG8_LDB(B0, 0, 0); PG8_SCHED; PG8_LDA(At, 0, 0); PG8_STAGE(PG8_SA(1, 1), a1 + hstep, voffA);
            PG8_WAIT_L(8); PG8_BAR; PG8_WAIT_L(0); PG8_MMA(0, 0, At, B0); PG8_BAR; PG8_SCHED;
            PG8_LDB(B1, 0, 1); PG8_STAGE(PG8_SB(0, 0), b2, voffB);
            PG8_BAR; PG8_WAIT_L(0); PG8_MMA(0, 1, At, B1); PG8_BAR;
            PG8_LDA(At, 0, 1); PG8_STAGE(PG8_SA(0, 0), a2, voffA);
            PG8_BAR; PG8_WAIT_L(0); PG8_MMA(1, 0, At, B0); PG8_BAR; PG8_SCHED;
            PG8_STAGE(PG8_SB(0, 1), b2 + hstep, voffB);
            PG8_WAIT_V(6); PG8_BAR; PG8_MMA(1, 1, At, B1); PG8_BAR;
            PG8_LDB(B0, 1, 0); PG8_SCHED; PG8_LDA(At, 1, 0); PG8_STAGE(PG8_SA(0, 1), a2 + hstep, voffA);
            PG8_WAIT_L(8); PG8_BAR; PG8_WAIT_L(0); PG8_MMA(0, 0, At, B0); PG8_BAR; PG8_SCHED;
            PG8_LDB(B1, 1, 1); PG8_STAGE(PG8_SB(1, 0), b3, voffB);
            PG8_BAR; PG8_WAIT_L(0); PG8_MMA(0, 1, At, B1); PG8_BAR;
            PG8_LDA(At, 1, 1); PG8_STAGE(PG8_SA(1, 0), a3, voffA);
            PG8_BAR; PG8_WAIT_L(0); PG8_MMA(1, 0, At, B0); PG8_BAR; PG8_SCHED;
            PG8_STAGE(PG8_SB(1, 1), b3 + hstep, voffB);
            PG8_WAIT_V(6); PG8_BAR; PG8_MMA(1, 1, At, B1); PG8_BAR;
        }
        E(acc, cur, wr, wc, fr, fq);
        if (!has_next) break;
#pragma unroll
        for (int a = 0; a < 2; ++a)
#pragma unroll
            for (int b = 0; b < 2; ++b)
#pragma unroll
                for (int m = 0; m < 4; ++m)
#pragma unroll
                    for (int n = 0; n < 2; ++n) acc[a][b][m][n] = (f32x4){0.f, 0.f, 0.f, 0.f};
        cur = nxt; cA = nA; cB = nB; ++ui;
    }
    PG8_WAIT_V(0);
    if (wr == 0) PG8_BAR;
    PG8_BAR;
#undef PG8_SA
#undef PG8_SB
#undef PG8_STAGE
#undef PG8_LDA
#undef PG8_LDB
#undef PG8_MMA
#undef PG8_WAIT_V
#undef PG8_WAIT_L
#undef PG8_BAR
#undef PG8_SCHED
}
}

__device__ __forceinline__ void store8bf(u16* dst, f32x4 v0, f32x4 v1) { u32x4 w; w.x = pk2(v0[0], v0[1]); w.y = pk2(v0[2], v0[3]); w.z = pk2(v1[0], v1[1]); w.w = pk2(v1[2], v1[3]); *(u32x4*)dst = w; }
struct F1 { u16 *XR, *XM, *Y0;
    __device__ __forceinline__ void operator()(int row, int col, f32x4 v0, f32x4 v1) const {
        const int reg = col >> 11, cc = col & 2047;
        u16* dst = reg == 0 ? XR + (size_t)row * 2048 + cc : reg == 1 ? Y0 + (size_t)row * 4096 + cc : reg == 2 ? XM + (size_t)row * 2048 + cc : Y0 + (size_t)row * 4096 + 2048 + cc;
        store8bf(dst, v0, v1); } };
struct F2 { u16* C;
    __device__ __forceinline__ void operator()(int row, int col, f32x4 v0, f32x4 v1) const { store8bf(C + (size_t)row * 2048 + col, v0, v1); } };
struct F3 { u16 *RKV, *P;
    __device__ __forceinline__ void operator()(int row, int col, f32x4 v0, f32x4 v1) const {
        if (col < 12288) { const int reg = col >> 12, cc = col & 4095; store8bf(RKV + (size_t)reg * ((size_t)NTOK * 4096) + (size_t)row * 4096 + cc, v0, v1); }
        else { const int cc = col - 12288; if (cc < 384) store8bf(P + (size_t)row * 384 + cc, v0, v1); } } };
struct F4 { u16* R;
    __device__ __forceinline__ void operator()(int row, int col, f32x4 v0, f32x4 v1) const {
        u16* d = R + (size_t)row * 4096 + col; const u32x4 w = *(const u32x4*)d; float y[8]; unpack8(w, y);
        f32x4 o0, o1;
#pragma unroll
        for (int j = 0; j < 4; ++j) { o0[j] = y[j] * siluf_(v0[j]); o1[j] = y[4 + j] * siluf_(v1[j]); }
        store8bf(d, o0, o1); } };

__device__ void tconv(unsigned char* smem, const float* src, int ldsrc, int col0, int N, int K, u16* dst, int ldd) {
    float* T = (float*)smem;
    const int tid = threadIdx.x, tilesN = N >> 6, ntile = tilesN * (K >> 6);
    const int lr = tid >> 4, lc = (tid & 15) * 4;
    const int sn = tid >> 3, sk = (tid & 7) * 8;
    int tile = blockIdx.x;
    f32x4 v0 = {0.f, 0.f, 0.f, 0.f}, v1 = {0.f, 0.f, 0.f, 0.f};
    if (tile < ntile) { const int tn = tile % tilesN, tk = tile / tilesN; const float* s = src + (size_t)(tk * 64 + lr) * ldsrc + col0 + tn * 64 + lc;
        v0 = __builtin_nontemporal_load((const f32x4*)s); v1 = __builtin_nontemporal_load((const f32x4*)(s + (size_t)32 * ldsrc)); }
    for (; tile < ntile; tile += gridDim.x) {
        const int tn = tile % tilesN, tk = tile / tilesN;
#pragma unroll
        for (int j = 0; j < 4; ++j) { T[lr * 65 + lc + j] = v0[j]; T[(lr + 32) * 65 + lc + j] = v1[j]; }
        asm volatile("s_waitcnt lgkmcnt(0)" ::: "memory"); __builtin_amdgcn_s_barrier(); asm volatile("" ::: "memory");
        const int nx = tile + gridDim.x;
        if (nx < ntile) { const int tn2 = nx % tilesN, tk2 = nx / tilesN; const float* s = src + (size_t)(tk2 * 64 + lr) * ldsrc + col0 + tn2 * 64 + lc;
            v0 = __builtin_nontemporal_load((const f32x4*)s); v1 = __builtin_nontemporal_load((const f32x4*)(s + (size_t)32 * ldsrc)); }
        float f[8];
#pragma unroll
        for (int j = 0; j < 8; ++j) f[j] = T[(sk + j) * 65 + sn];
        *(u32x4*)(dst + (size_t)(tn * 64 + sn) * ldd + tk * 64 + sk) = pack8(f);
        asm volatile("s_waitcnt lgkmcnt(0)" ::: "memory"); __builtin_amdgcn_s_barrier(); asm volatile("" ::: "memory");
    }
    __syncthreads();
}

template <int MODE> __device__ void rows_phase(const Params& p) {
    const int lane = threadIdx.x & 63, gw = blockIdx.x * 8 + (threadIdx.x >> 6), nw = gridDim.x * 8;
    const float* x = p.in[0];
    for (int row = gw; row < NTOK; row += nw) {
        if (MODE == 0) {
            f32x4 v[8]; float ss = 0.f;
#pragma unroll
            for (int i = 0; i < 8; ++i) { v[i] = __builtin_nontemporal_load((const f32x4*)(x + (size_t)row * DM + i * 256 + lane * 4)); ss += v[i][0] * v[i][0] + v[i][1] * v[i][1] + v[i][2] * v[i][2] + v[i][3] * v[i][3]; }
            ss = wave_sum(ss); const float r = rsqrtf(ss * (1.0f / DM) + 1e-6f);
            u16* H = (u16*)(p.ws + OFF_H);
#pragma unroll
            for (int i = 0; i < 8; ++i) { const int c = i * 256 + lane * 4; const f32x4 g = *(const f32x4*)(p.in[1] + c);
                u32x2 w; w.x = pk2(v[i][0] * r * g[0], v[i][1] * r * g[1]); w.y = pk2(v[i][2] * r * g[2], v[i][3] * r * g[3]); *(u32x2*)(H + (size_t)row * DM + c) = w; }
        } else {
            const u16* Mx = (const u16*)(p.ws + (MODE == 1 ? OFF_M0 : OFF_M1));
            const float* base = MODE == 1 ? x : p.out;
            const float* gpost = p.in[MODE == 1 ? 22 : 40];
            f32x4 m[8]; float ss = 0.f;
#pragma unroll
            for (int i = 0; i < 8; ++i) { const u32x2 w_ = __builtin_nontemporal_load((const u32x2*)(Mx + (size_t)row * DM + i * 256 + lane * 4)); m[i] = (f32x4){bflo(w_.x), bfhi(w_.x), bflo(w_.y), bfhi(w_.y)};
                ss += m[i][0] * m[i][0] + m[i][1] * m[i][1] + m[i][2] * m[i][2] + m[i][3] * m[i][3]; }
            ss = wave_sum(ss); const float r = rsqrtf(ss * (1.0f / DM) + 1e-6f);
            float ss1 = 0.f;
#pragma unroll
            for (int i = 0; i < 8; ++i) { const int c = i * 256 + lane * 4; const f32x4 g = *(const f32x4*)(gpost + c); const f32x4 b = __builtin_nontemporal_load((const f32x4*)(base + (size_t)row * DM + c));
                m[i] = b + m[i] * r * g; ss1 += m[i][0] * m[i][0] + m[i][1] * m[i][1] + m[i][2] * m[i][2] + m[i][3] * m[i][3];
                __builtin_nontemporal_store(m[i], (f32x4*)(p.out + (size_t)row * DM + c)); }
            if (MODE == 1) {
                ss1 = wave_sum(ss1); const float r1 = rsqrtf(ss1 * (1.0f / DM) + 1e-6f);
                u16* H = (u16*)(p.ws + OFF_H);
#pragma unroll
                for (int i = 0; i < 8; ++i) { const int c = i * 256 + lane * 4; const f32x4 g = *(const f32x4*)(p.in[23] + c);
                    u32x2 w; w.x = pk2(m[i][0] * r1 * g[0], m[i][1] * r1 * g[1]); w.y = pk2(m[i][2] * r1 * g[2], m[i][3] * r1 * g[3]); *(u32x2*)(H + (size_t)row * DM + c) = w; }
            }
        }
    }
}

__device__ void prep_small(const Params& p) {
    const int gt = blockIdx.x * 512 + threadIdx.x, nt = gridDim.x * 512;
    u16* LW = (u16*)(p.ws + OFF_LRUW);
    for (int e = gt; e < 2 * 16 * 128 * 128; e += nt) { const int i = e & 127, j = (e >> 7) & 127, blk = (e >> 14) & 15, g = e >> 18;
        LW[e] = f2bf(p.in[g ? 7 : 5][(size_t)(blk * 128 + i) * 128 + j]); }
    u16* WG = (u16*)(p.ws + OFF_WGT);
    for (int e = gt; e < 16 * 6144; e += nt) { const int c = e % 6144, n = e / 6144; WG[e] = f2bf(n < 8 ? p.in[15][c * 8 + n] : p.in[17][c * 8 + n - 8]); }
}
__device__ void prep_extras(const Params& p) {
    const int gt = blockIdx.x * 512 + threadIdx.x, nt = gridDim.x * 512;
    u16* W = (u16*)(p.ws + OFF_W1) + (size_t)12288 * 2048;
    for (int e = gt; e < 512 * 2048; e += nt) { const int k = e & 2047, n = e >> 11; float v = 0.f;
        if (n < 96) v = (1.f - p.in[26][k]) * p.in[29][k * 96 + n];
        else if (n < 192) v = p.in[26][k] * p.in[29][k * 96 + n - 96];
        else if (n < 288) v = (1.f - p.in[27][k]) * p.in[32][k * 96 + n - 192];
        else if (n < 384) v = p.in[27][k] * p.in[32][k * 96 + n - 288];
        W[e] = f2bf(v); }
}

#define LBAR0() do { asm volatile("s_waitcnt lgkmcnt(0)" ::: "memory"); __builtin_amdgcn_s_barrier(); asm volatile("" ::: "memory"); } while (0)
__device__ __forceinline__ float fsig0(float x) { return __builtin_amdgcn_rcpf(1.0f + __expf(-x)); }
template <int PASS> __device__ void lru_phase(const Params& p, unsigned char* smem) {
    float* xcf = (float*)smem;
    float* As = xcf + 64 * 132;
    float* Us = As + 64 * 132;
    float* qA = Us + 64 * 132;
    float* qH = qA + 512;
    const int tid = threadIdx.x, lane = tid & 63, wave = __builtin_amdgcn_readfirstlane(tid >> 6);
    const u16* XR = (const u16*)(p.ws + OFF_XR);
    u16* Y0 = (u16*)(p.ws + OFF_Y0);
    const u16* LW = (const u16*)(p.ws + OFF_LRUW);
    float* LA = (float*)(p.ws + OFF_LRUA); float* LH = (float*)(p.ws + OFF_LRUH); const float* LC = (const float*)(p.ws + OFF_LRUC);
    const float* cw = p.in[3]; const float* cb = p.in[4];
    u32x4 craw[2][4];
#define LRU_CLOAD(tl_) do { const int jb_ = (tl_) & 15, c_ = ((tl_) >> 4) & 63, b_ = (tl_) >> 10; \
        _Pragma("unroll") for (int it = 0; it < 2; ++it) { const int t_ = (tid >> 4) + 32 * it, ch_ = jb_ * 128 + (tid & 15) * 8; \
            _Pragma("unroll") for (int j = 0; j < 4; ++j) { const int s_ = c_ * 64 + t_ - 3 + j; \
                craw[it][j] = (s_ >= 0) ? *(const u32x4*)(XR + (size_t)(b_ * SEQL + s_) * 2048 + ch_) : (u32x4){0u, 0u, 0u, 0u}; } } } while (0)
    if ((int)blockIdx.x < 4096) LRU_CLOAD((int)blockIdx.x);
    for (int tile = blockIdx.x; tile < 4096; tile += gridDim.x) {
        const int jb = tile & 15, c = (tile >> 4) & 63, b = tile >> 10;
        const int row0 = b * SEQL + c * 64;
        u16 zpre[16];
        if (PASS == 2) {
#pragma unroll
            for (int tt = 0; tt < 16; ++tt) zpre[tt] = Y0[(size_t)(row0 + (tid >> 7) * 16 + tt) * 4096 + jb * 128 + (tid & 127)];
        }
#pragma unroll
        for (int it = 0; it < 2; ++it) {
            const int t = (tid >> 4) + 32 * it, c8 = (tid & 15) * 8, ch = jb * 128 + c8;
            float acc[8];
            { const f32x4 b0 = *(const f32x4*)(cb + ch), b1 = *(const f32x4*)(cb + ch + 4);
#pragma unroll
              for (int i = 0; i < 4; ++i) { acc[i] = b0[i]; acc[4 + i] = b1[i]; } }
#pragma unroll
            for (int j = 0; j < 4; ++j) { float xv[8]; unpack8(craw[it][j], xv);
                const f32x4 w0 = *(const f32x4*)(cw + j * 2048 + ch), w1 = *(const f32x4*)(cw + j * 2048 + ch + 4);
#pragma unroll
                for (int i = 0; i < 4; ++i) { acc[i] += w0[i] * xv[i]; acc[4 + i] += w1[i] * xv[4 + i]; } }
            *(f32x4*)(xcf + t * 132 + c8) = (f32x4){acc[0], acc[1], acc[2], acc[3]}; *(f32x4*)(xcf + t * 132 + c8 + 4) = (f32x4){acc[4], acc[5], acc[6], acc[7]};
        }
        if (tile + (int)gridDim.x < 4096) LRU_CLOAD(tile + (int)gridDim.x);
        LBAR0();
        f32x4 accA[4], accX[4];
#pragma unroll
        for (int m = 0; m < 4; ++m) { accA[m] = (f32x4){0.f, 0.f, 0.f, 0.f}; accX[m] = (f32x4){0.f, 0.f, 0.f, 0.f}; }
#pragma unroll
        for (int ks = 0; ks < 4; ++ks) {
            const size_t wo = (size_t)((jb * 128 + 16 * wave + (lane & 15)) * 128 + ks * 32 + 8 * (lane >> 4));
            const bf16x8 ba = *(const bf16x8*)(LW + wo), bx = *(const bf16x8*)(LW + (size_t)16 * 128 * 128 + wo);
#pragma unroll
            for (int m = 0; m < 4; ++m) { const float* s = xcf + (16 * m + (lane & 15)) * 132 + ks * 32 + 8 * (lane >> 4);
                const f32x4 lo = *(const f32x4*)s, hi = *(const f32x4*)(s + 4); float f[8] = {lo[0], lo[1], lo[2], lo[3], hi[0], hi[1], hi[2], hi[3]};
                const bf16x8 af = as_frag(pack8(f));
                accA[m] = MFMA16(af, ba, accA[m]); accX[m] = MFMA16(af, bx, accX[m]); }
        }
        {
            const int ch = 16 * wave + (lane & 15), cgl = jb * 128 + ch;
            const float ba_ = p.in[6][cgl], bx_ = p.in[8][cgl], sp = softplusf_(-p.in[9][cgl]);
#pragma unroll
            for (int m = 0; m < 4; ++m)
#pragma unroll
                for (int r = 0; r < 4; ++r) { const int t = 16 * m + 4 * (lane >> 4) + r;
                    const float rg = fsig0(accA[m][r] + ba_), ig = fsig0(accX[m][r] + bx_);
                    const float la = -8.0f * rg * sp, a = __expf(la), u = __builtin_amdgcn_sqrtf(fmaxf(1.0f - a * a, 0.f)) * (ig * xcf[t * 132 + ch]);
                    As[t * 132 + ch] = a; Us[t * 132 + ch] = u; }
        }
        LBAR0();
        const int ch = tid & 127, q = tid >> 7, cgl = jb * 128 + ch;
        { float h = 0.f, A = 1.f;
#pragma unroll
          for (int tt = 0; tt < 16; ++tt) { const int t = q * 16 + tt; const float a = As[t * 132 + ch], u = Us[t * 132 + ch]; h = a * h + u; A *= a;
              if (PASS == 2) { Us[t * 132 + ch] = h; As[t * 132 + ch] = A; } }
          qA[q * 128 + ch] = A; qH[q * 128 + ch] = h; }
        LBAR0();
        if (PASS == 1) {
            if (q == 0) { float h = 0.f, A = 1.f;
#pragma unroll
                for (int qq = 0; qq < 4; ++qq) { h = qA[qq * 128 + ch] * h + qH[qq * 128 + ch]; A *= qA[qq * 128 + ch]; }
                LA[(size_t)(b * 64 + c) * 2048 + cgl] = A; LH[(size_t)(b * 64 + c) * 2048 + cgl] = h; }
        } else {
            float carry = LC[(size_t)(b * 64 + c) * 2048 + cgl];
            for (int qq = 0; qq < q; ++qq) carry = qA[qq * 128 + ch] * carry + qH[qq * 128 + ch];
#pragma unroll
            for (int tt = 0; tt < 16; ++tt) { const int t = q * 16 + tt; const float hh = Us[t * 132 + ch] + As[t * 132 + ch] * carry; const float z = bf2f(zpre[tt]);
                Y0[(size_t)(row0 + t) * 4096 + cgl] = f2bf(hh * z * fsig0(z)); }
        }
        LBAR0();
    }
}
__device__ void lru_carry(const Params& p) {
    const float* LA = (const float*)(p.ws + OFF_LRUA); const float* LH = (const float*)(p.ws + OFF_LRUH); float* LC = (float*)(p.ws + OFF_LRUC);
    for (int idx = blockIdx.x * 512 + threadIdx.x; idx < 4 * 2048; idx += gridDim.x * 512) { const int b = idx >> 11, cg_ = idx & 2047; float c = 0.f;
#pragma unroll 8
        for (int k = 0; k < 64; ++k) { const size_t o = (size_t)(b * 64 + k) * 2048 + cg_; LC[o] = c; c = LA[o] * c + LH[o]; } }
}

__device__ void mqk_phase(const Params& p, unsigned char* smem) {
    float* red = (float*)smem;
    const int tid = threadIdx.x, lane = tid & 63, wave = __builtin_amdgcn_readfirstlane(tid >> 6);
    const u16* XM = (const u16*)(p.ws + OFF_XM); u16* Q = (u16*)(p.ws + OFF_Q); u16* KX = (u16*)(p.ws + OFF_KX);
    const u16* WG = (const u16*)(p.ws + OFF_WGT); float* G = (float*)(p.ws + OFF_G);
    for (int tile = blockIdx.x; tile < 256; tile += gridDim.x) {
        const int row0 = tile * 64;
        f32x4 acc[4];
#pragma unroll
        for (int m = 0; m < 4; ++m) acc[m] = (f32x4){0.f, 0.f, 0.f, 0.f};
        for (int ks = 0; ks < 8; ++ks) {
            const int c0 = 256 * wave + 32 * ks + 8 * (lane >> 4);
            float cw[4][8], cbv[8];
#pragma unroll
            for (int j = 0; j < 4; ++j) { const f32x4 a = *(const f32x4*)(p.in[10] + j * 2048 + c0), b = *(const f32x4*)(p.in[10] + j * 2048 + c0 + 4);
#pragma unroll
                for (int i = 0; i < 4; ++i) { cw[j][i] = a[i]; cw[j][4 + i] = b[i]; } }
            { const f32x4 a = *(const f32x4*)(p.in[11] + c0), b = *(const f32x4*)(p.in[11] + c0 + 4);
#pragma unroll
              for (int i = 0; i < 4; ++i) { cbv[i] = a[i]; cbv[4 + i] = b[i]; } }
            const bf16x8 bq = *(const bf16x8*)(WG + (size_t)(lane & 15) * 6144 + c0), bk = *(const bf16x8*)(WG + (size_t)(lane & 15) * 6144 + 2048 + c0), bv = *(const bf16x8*)(WG + (size_t)(lane & 15) * 6144 + 4096 + c0);
            const float* wqp = p.in[12] + (size_t)(c0 >> 2) * 16; const float* wkp = p.in[13] + (size_t)(c0 >> 2) * 16; const float* wvp = p.in[14] + (size_t)(c0 >> 2) * 16;
            u32x4 xraw[4];
#define MQ_LOAD(dst, mm) do { const int tk_ = row0 + 16 * (mm) + (lane & 15), s_ = tk_ & (SEQL - 1); \
                _Pragma("unroll") for (int j = 0; j < 4; ++j) dst[j] = (s_ - 3 + j >= 0) ? *(const u32x4*)(XM + (size_t)(tk_ - 3 + j) * 2048 + c0) : (u32x4){0u, 0u, 0u, 0u}; } while (0)
            MQ_LOAD(xraw, 0);
#pragma unroll
            for (int m = 0; m < 4; ++m) {
                const int tk = row0 + 16 * m + (lane & 15);
                u32x4 xnx[4];
                if (m < 3) MQ_LOAD(xnx, m + 1);
                float xmc[8], xcur[8];
#pragma unroll
                for (int i = 0; i < 8; ++i) xmc[i] = cbv[i];
#pragma unroll
                for (int j = 0; j < 4; ++j) { float xv[8]; unpack8(xraw[j], xv);
#pragma unroll
                    for (int i = 0; i < 8; ++i) { xmc[i] += cw[j][i] * xv[i]; if (j == 3) xcur[i] = xv[i]; } }
                if (m < 3) {
#pragma unroll
                    for (int j = 0; j < 4; ++j) xraw[j] = xnx[j]; }
#pragma unroll
                for (int i = 0; i < 8; ++i) xmc[i] = xmc[i] * fsig0(xmc[i]);
                float qv[8], kv[8], vv[8];
#pragma unroll
                for (int bb = 0; bb < 2; ++bb)
#pragma unroll
                    for (int jj = 0; jj < 4; ++jj) { float aq = 0.f, ak = 0.f, av = 0.f;
#pragma unroll
                        for (int ii = 0; ii < 4; ++ii) { aq += xmc[4 * bb + ii] * wqp[bb * 16 + ii * 4 + jj]; ak += xmc[4 * bb + ii] * wkp[bb * 16 + ii * 4 + jj]; av += xcur[4 * bb + ii] * wvp[bb * 16 + ii * 4 + jj]; }
                        qv[4 * bb + jj] = aq; kv[4 * bb + jj] = ak; vv[4 * bb + jj] = av; }
                const u32x4 qw = pack8(qv), kw = pack8(kv), vw = pack8(vv);
                acc[m] = MFMA16(as_frag(qw), bq, acc[m]); acc[m] = MFMA16(as_frag(kw), bk, acc[m]); acc[m] = MFMA16(as_frag(vw), bv, acc[m]);
#pragma unroll
                for (int i = 0; i < 8; ++i) kv[i] *= 0.0625f;
                *(u32x4*)(Q + (size_t)tk * 2048 + c0) = qw; *(u32x4*)(KX + (size_t)tk * 2048 + c0) = pack8(kv);
            }
        }
#pragma unroll
        for (int m = 0; m < 4; ++m)
#pragma unroll
            for (int r = 0; r < 4; ++r) red[(wave * 64 + 16 * m + 4 * (lane >> 4) + r) * 16 + (lane & 15)] = acc[m][r];
        __syncthreads();
        for (int e = tid; e < 1024; e += 512) { const int tok = e >> 4, n = e & 15; float s = (n < 8) ? p.in[16][n] : p.in[18][n - 8];
#pragma unroll
            for (int w = 0; w < 8; ++w) s += red[(w * 64 + tok) * 16 + n];
            G[(size_t)(row0 + tok) * 16 + n] = s; }
        __syncthreads();
    }
}

__device__ void mlstm_phase(const Params& p, unsigned char* smem) {
    u16* Ks = (u16*)smem;
    u16* Vt = Ks + 128 * 264;
    u16* Vwt = Vt + 48 * 136;
    u16* Ps = Vwt + 48 * 136;
    u16* Ct = Ps + 128 * 136;
    float* gc = (float*)(Ct + 48 * 264);
    float* gM = gc + 128; float* gE = gM + 128; float* gF = gE + 128; float* gW = gF + 128; float* gS = gW + 128;
    const int tid = threadIdx.x, lane = tid & 63, wave = __builtin_amdgcn_readfirstlane(tid >> 6);
    const int l15 = lane & 15, lq = lane >> 4;
    const u16* XM = (const u16*)(p.ws + OFF_XM); const u16* Q = (const u16*)(p.ws + OFF_Q); const u16* KX = (const u16*)(p.ws + OFF_KX);
    const float* G = (const float*)(p.ws + OFF_G); u16* Hm = (u16*)(p.ws + OFF_H);
    for (int unit = blockIdx.x; unit < 256; unit += gridDim.x) {
        int sl = unit & 7, bh_ = unit >> 3;
        if (gridDim.x == 256) { const int xcd_ = unit & 7, j_ = unit >> 3; bh_ = xcd_ * 4 + (j_ >> 3); sl = j_ & 7; }
        const int h = bh_ & 7, b = bh_ >> 3;
        f32x4 accC[3][2];
#pragma unroll
        for (int a = 0; a < 3; ++a)
#pragma unroll
            for (int c = 0; c < 2; ++c) accC[a][c] = (f32x4){0.f, 0.f, 0.f, 0.f};
        float m_prev = 0.f;
        for (int e = tid; e < 16 * 136; e += 512) { const int r = e / 136; Vt[32 * 136 + e] = (r == 0) ? (u16)0x3F80 : (u16)0; Vwt[32 * 136 + e] = 0; }
        for (int e = tid; e < 48 * 264; e += 512) Ct[e] = 0;
        const int vc = 256 * h + 32 * sl + 4 * (tid & 7);
        const float* wvp = p.in[14] + (size_t)(vc >> 2) * 16;
        __syncthreads();
        for (int chunk = 0; chunk < 32; ++chunk) {
            const int row0 = b * SEQL + chunk * 128;
#pragma unroll
            for (int i = 0; i < 8; ++i) { const int idx = tid + 512 * i, r = idx >> 5, cc = (idx & 31) * 8;
                *(u32x4*)(Ks + r * 264 + cc) = *(const u32x4*)(KX + (size_t)(row0 + r) * 2048 + 256 * h + cc); }
            bf16x8 qf[8];
#pragma unroll
            for (int ks = 0; ks < 8; ++ks) qf[ks] = *(const bf16x8*)(Q + (size_t)(row0 + 16 * wave + l15) * 2048 + 256 * h + 32 * ks + 8 * lq);
            float vv[2][4];
#pragma unroll
            for (int i = 0; i < 2; ++i) { const int t = (tid + 512 * i) >> 3; const u32x2 raw = *(const u32x2*)(XM + (size_t)(row0 + t) * 2048 + vc);
                const float x0 = bflo(raw.x), x1 = bfhi(raw.x), x2 = bflo(raw.y), x3 = bfhi(raw.y);
#pragma unroll
                for (int jj = 0; jj < 4; ++jj) vv[i][jj] = x0 * wvp[jj] + x1 * wvp[4 + jj] + x2 * wvp[8 + jj] + x3 * wvp[12 + jj]; }
            if (wave == 0) {
                const int t0 = 2 * lane;
                const float ig0 = G[(size_t)(row0 + t0) * 16 + h], fg0 = G[(size_t)(row0 + t0) * 16 + 8 + h];
                const float ig1 = G[(size_t)(row0 + t0 + 1) * 16 + h], fg1 = G[(size_t)(row0 + t0 + 1) * 16 + 8 + h];
                const float lf0 = -softplusf_(-fg0), lf1 = -softplusf_(-fg1);
                float s = lf0 + lf1;
#pragma unroll
                for (int d = 1; d < 64; d <<= 1) { const float o = __shfl_up(s, d); if (lane >= d) s += o; }
                const float b1 = s, b0 = s - lf1;
                const float c0 = ig0 - b0, c1 = ig1 - b1;
                float mx = fmaxf(c0, c1);
#pragma unroll
                for (int d = 1; d < 64; d <<= 1) { const float o = __shfl_up(mx, d); if (lane >= d) mx = fmaxf(mx, o); }
                float pm = __shfl_up(mx, 1); if (lane == 0) pm = -3.0e38f;
                const float M0 = fmaxf(fmaxf(pm, c0), m_prev), M1 = fmaxf(mx, m_prev);
                const float Ml = __shfl(M1, 63), bL = __shfl(b1, 63);
                gc[t0] = c0; gc[t0 + 1] = c1; gM[t0] = M0; gM[t0 + 1] = M1;
                gE[t0] = __expf(m_prev - M0); gE[t0 + 1] = __expf(m_prev - M1);
                gF[t0] = __expf(-(b0 + M0)); gF[t0 + 1] = __expf(-(b1 + M1));
                gW[t0] = __expf(c0 - Ml); gW[t0 + 1] = __expf(c1 - Ml);
                if (lane == 0) gS[0] = __expf(m_prev - Ml);
                m_prev = bL + Ml;
            }
            LBAR0();
#pragma unroll
            for (int i = 0; i < 2; ++i) { const int t = (tid + 512 * i) >> 3; const float w = gW[t];
#pragma unroll
                for (int jj = 0; jj < 4; ++jj) { const int dv = 4 * (tid & 7) + jj; Vt[dv * 136 + t] = f2bf(vv[i][jj]); Vwt[dv * 136 + t] = f2bf(vv[i][jj] * w); } }
            if (tid < 128) Vwt[32 * 136 + tid] = f2bf(gW[tid]);
            f32x4 accS[8];
#pragma unroll
            for (int n = 0; n < 8; ++n) { accS[n] = (f32x4){0.f, 0.f, 0.f, 0.f};
                if (n <= wave) {
#pragma unroll
                    for (int ks = 0; ks < 8; ++ks) { const bf16x8 kf = *(const bf16x8*)(Ks + (16 * n + l15) * 264 + 32 * ks + 8 * lq); accS[n] = MFMA16(qf[ks], kf, accS[n]); } } }
#pragma unroll
            for (int n = 0; n < 8; ++n) if (n <= (wave | 1)) { const int s = 16 * n + l15; const float cs = gc[s];
#pragma unroll
                for (int r = 0; r < 4; ++r) { const int t = 16 * wave + 4 * lq + r; const float val = (n <= wave && s <= t) ? accS[n][r] * __expf(cs - gM[t]) : 0.f; Ps[t * 136 + s] = f2bf(val); } }
            LBAR0();
            f32x4 oi[3], oc[3];
#pragma unroll
            for (int nt = 0; nt < 3; ++nt) { oi[nt] = (f32x4){0.f, 0.f, 0.f, 0.f}; oc[nt] = (f32x4){0.f, 0.f, 0.f, 0.f}; }
#pragma unroll
            for (int kk = 0; kk < 4; ++kk) if (kk <= (wave >> 1)) { const bf16x8 pf = *(const bf16x8*)(Ps + (16 * wave + l15) * 136 + 32 * kk + 8 * lq);
#pragma unroll
                for (int nt = 0; nt < 3; ++nt) { const bf16x8 vf = *(const bf16x8*)(Vt + (16 * nt + l15) * 136 + 32 * kk + 8 * lq); oi[nt] = MFMA16(pf, vf, oi[nt]); } }
#pragma unroll
            for (int ks = 0; ks < 8; ++ks)
#pragma unroll
                for (int nt = 0; nt < 3; ++nt) { const bf16x8 cf = *(const bf16x8*)(Ct + (16 * nt + l15) * 264 + 32 * ks + 8 * lq); oc[nt] = MFMA16(qf[ks], cf, oc[nt]); }
#pragma unroll
            for (int r = 0; r < 4; ++r) { const int t = 16 * wave + 4 * lq + r; const float E = gE[t], F = gF[t];
                float den = oi[2][r] + E * oc[2][r]; den = __shfl(den, lane & 48);
                const float inv = 1.0f / fmaxf(fabsf(den), F);
#pragma unroll
                for (int nt = 0; nt < 2; ++nt) Hm[(size_t)(row0 + t) * 2048 + 256 * h + 32 * sl + 16 * nt + l15] = f2bf((oi[nt][r] + E * oc[nt][r]) * inv); }
            { const float decay = gS[0];
#pragma unroll
              for (int a = 0; a < 3; ++a)
#pragma unroll
                for (int c = 0; c < 2; ++c) accC[a][c] = accC[a][c] * decay; }
#pragma unroll
            for (int kk = 0; kk < 4; ++kk) {
                bf16x8 ktf[2];
#pragma unroll
                for (int ntk = 0; ntk < 2; ++ntk) { const int dk = 32 * wave + 16 * ntk + l15;
#pragma unroll
                    for (int j = 0; j < 8; ++j) ktf[ntk][j] = (short)Ks[(32 * kk + 8 * lq + j) * 264 + dk]; }
#pragma unroll
                for (int mt = 0; mt < 3; ++mt) { const bf16x8 vwf = *(const bf16x8*)(Vwt + (16 * mt + l15) * 136 + 32 * kk + 8 * lq);
#pragma unroll
                    for (int ntk = 0; ntk < 2; ++ntk) accC[mt][ntk] = MFMA16(vwf, ktf[ntk], accC[mt][ntk]); }
            }
            LBAR0();
#pragma unroll
            for (int mt = 0; mt < 3; ++mt)
#pragma unroll
                for (int ntk = 0; ntk < 2; ++ntk)
#pragma unroll
                    for (int r = 0; r < 4; ++r) Ct[(16 * mt + 4 * lq + r) * 264 + 32 * wave + 16 * ntk + l15] = f2bf(accC[mt][ntk][r]);
        }
        __syncthreads();
    }
}

__device__ void mnorm_phase(const Params& p) {
    const int lane = threadIdx.x & 63, wave = threadIdx.x >> 6;
    const u16* XM = (const u16*)(p.ws + OFF_XM); const u16* Hm = (const u16*)(p.ws + OFF_H); u16* Y0 = (u16*)(p.ws + OFF_Y0);
    const int c = 256 * wave + 4 * lane;
    float cw[4][4];
#pragma unroll
    for (int j = 0; j < 4; ++j) { const f32x4 a = *(const f32x4*)(p.in[10] + j * 2048 + c);
#pragma unroll
        for (int i = 0; i < 4; ++i) cw[j][i] = a[i]; }
    const f32x4 cbv = *(const f32x4*)(p.in[11] + c), skip = *(const f32x4*)(p.in[19] + c), gn = *(const f32x4*)(p.in[20] + c);
    for (int blk = blockIdx.x; blk < 256; blk += gridDim.x) {
        u32x2 hr, xr[4], zr;
#define MN_LOAD(tk_) do { const int s_ = (tk_) & (SEQL - 1); hr = *(const u32x2*)(Hm + (size_t)(tk_) * 2048 + c); zr = *(const u32x2*)(Y0 + (size_t)(tk_) * 4096 + 2048 + c); \
            _Pragma("unroll") for (int j = 0; j < 4; ++j) xr[j] = (s_ - 3 + j >= 0) ? *(const u32x2*)(XM + (size_t)((tk_) - 3 + j) * 2048 + c) : (u32x2){0u, 0u}; } while (0)
        MN_LOAD(blk * 64);
#pragma unroll 2
        for (int tt = 0; tt < 64; ++tt) {
            const int tk = blk * 64 + tt;
            const u32x2 hc_ = hr, zc_ = zr; const u32x2 xc0 = xr[0], xc1 = xr[1], xc2 = xr[2], xc3 = xr[3];
            if (tt < 63) MN_LOAD(tk + 1);
            float hv[4] = {bflo(hc_.x), bfhi(hc_.x), bflo(hc_.y), bfhi(hc_.y)};
            const float mu = wave_sum_dpp(hv[0] + hv[1] + hv[2] + hv[3]) * (1.0f / 256.0f);
            float d[4], sq = 0.f;
#pragma unroll
            for (int i = 0; i < 4; ++i) { d[i] = hv[i] - mu; sq += d[i] * d[i]; }
            const float rs = rsqrtf(wave_sum_dpp(sq) * (1.0f / 256.0f) + 1e-6f);
            float xmc[4] = {cbv[0], cbv[1], cbv[2], cbv[3]};
            const u32x2 xs[4] = {xc0, xc1, xc2, xc3};
#pragma unroll
            for (int j = 0; j < 4; ++j) { xmc[0] += cw[j][0] * bflo(xs[j].x); xmc[1] += cw[j][1] * bfhi(xs[j].x); xmc[2] += cw[j][2] * bflo(xs[j].y); xmc[3] += cw[j][3] * bfhi(xs[j].y); }
            const float z[4] = {bflo(zc_.x), bfhi(zc_.x), bflo(zc_.y), bfhi(zc_.y)};
            float o[4];
#pragma unroll
            for (int i = 0; i < 4; ++i) o[i] = (d[i] * rs * gn[i] + skip[i] * xmc[i] * fsig0(xmc[i])) * z[i] * fsig0(z[i]);
            u32x2 w; w.x = pk2(o[0], o[1]); w.y = pk2(o[2], o[3]); *(u32x2*)(Y0 + (size_t)tk * 4096 + 2048 + c) = w;
        }
#undef MN_LOAD
    }
}

__device__ __forceinline__ float fsigmoid(float x) { return __builtin_amdgcn_rcpf(1.0f + __expf(-x)); }
__device__ __forceinline__ float ftanh(float x) { return 1.0f - 2.0f * __builtin_amdgcn_rcpf(1.0f + __expf(2.0f * x)); }
__device__ __forceinline__ float row16_sum(float v) { v += dppf<0xB1>(v); v += dppf<0x4E>(v); v += dppf<0x141>(v); v += dppf<0x140>(v); return v; }
#define LBAR() do { asm volatile("s_waitcnt lgkmcnt(0)" ::: "memory"); __builtin_amdgcn_s_barrier(); asm volatile("" ::: "memory"); } while (0)
struct RwStep { f32x4 d0, d1, a0, a1, b0, b1, k0, k1, w0, w1; float v0, v1; f32x2 sc; };
__device__ __forceinline__ RwStep rw_load(const float* vb, const float* vrow, const float* sb) {
    RwStep s;
    s.d0 = *(const f32x4*)vb; s.d1 = *(const f32x4*)(vb + 4); s.a0 = *(const f32x4*)(vb + 64); s.a1 = *(const f32x4*)(vb + 68);
    s.b0 = *(const f32x4*)(vb + 128); s.b1 = *(const f32x4*)(vb + 132); s.k0 = *(const f32x4*)(vb + 192); s.k1 = *(const f32x4*)(vb + 196);
    s.w0 = *(const f32x4*)(vb + 256); s.w1 = *(const f32x4*)(vb + 260);
    s.v0 = vrow[320]; s.v1 = vrow[352]; s.sc = *(const f32x2*)sb;
    return s;
}
__device__ void rwkv_phase(const Params& p, unsigned char* smem) {
    constexpr int TC = 16, NCH = SEQL / TC;
    u16* W2t = (u16*)smem;
    u16* A2t = W2t + 64 * 104;
    float* vec = (float*)(A2t + 64 * 104);
    float* scal = vec + 2 * TC * 384;
    float* Yraw = scal + 2 * TC * 4;
    u16* raw = (u16*)(Yraw + 2 * TC * 64);
    u16* twa = raw + 3 * 17 * 64;
    const int tid = threadIdx.x, lane = tid & 63, wave = __builtin_amdgcn_readfirstlane(tid >> 6);
    const int l15 = lane & 15, lq = lane >> 4;
    u16* R = (u16*)(p.ws + OFF_R); const u16* Kb = (const u16*)(p.ws + OFF_KK); const u16* Vb = (const u16*)(p.ws + OFF_V); const u16* P = (const u16*)(p.ws + OFF_P);
    for (int unit = blockIdx.x; unit < 256; unit += gridDim.x) {
        const int b = unit >> 6, h = unit & 63, hc = 64 * h;
        for (int e = tid; e < 6144; e += 512) { const int j = e >> 6, k = e & 63; W2t[k * 104 + j] = f2bf(p.in[30][(size_t)j * 4096 + hc + k]); A2t[k * 104 + j] = f2bf(p.in[33][(size_t)j * 4096 + hc + k]); }
        __syncthreads();
        if (wave < 4) {
            const int rp = tid >> 3, j8 = tid & 7;
            f32x2 S0[4], S1[4];
#pragma unroll
            for (int i = 0; i < 4; ++i) { S0[i] = (f32x2){0.f, 0.f}; S1[i] = (f32x2){0.f, 0.f}; }
            for (int pc = -1; pc <= NCH; ++pc) {
                const bool act = (pc >= 0 && pc < NCH);
                const float* vbase = vec + (pc & 1) * TC * 384;
                const float* sbase = scal + (pc & 1) * TC * 4;
                float* ybase = Yraw + (pc & 1) * TC * 64;
#pragma unroll 1
                for (int q = 0; q < 2; ++q) {
                    if (act) {
                        RwStep cur = rw_load(vbase + (8 * q) * 384 + 8 * j8, vbase + (8 * q) * 384 + rp, sbase + (8 * q) * 4);
#pragma unroll
                        for (int tt = 0; tt < 8; ++tt) {
                            const int t = 8 * q + tt;
                            RwStep nxt = cur;
                            if (tt < 7) nxt = rw_load(vbase + (t + 1) * 384 + 8 * j8, vbase + (t + 1) * 384 + rp, sbase + (t + 1) * 4);
                            __builtin_amdgcn_sched_barrier(0);
                            const f32x2 av[4] = {{cur.a0[0], cur.a0[1]}, {cur.a0[2], cur.a0[3]}, {cur.a1[0], cur.a1[1]}, {cur.a1[2], cur.a1[3]}};
                            const f32x2 wv[4] = {{cur.w0[0], cur.w0[1]}, {cur.w0[2], cur.w0[3]}, {cur.w1[0], cur.w1[1]}, {cur.w1[2], cur.w1[3]}};
                            const f32x2 dv[4] = {{cur.d0[0], cur.d0[1]}, {cur.d0[2], cur.d0[3]}, {cur.d1[0], cur.d1[1]}, {cur.d1[2], cur.d1[3]}};
                            const f32x2 bv[4] = {{cur.b0[0], cur.b0[1]}, {cur.b0[2], cur.b0[3]}, {cur.b1[0], cur.b1[1]}, {cur.b1[2], cur.b1[3]}};
                            const f32x2 kv[4] = {{cur.k0[0], cur.k0[1]}, {cur.k0[2], cur.k0[3]}, {cur.k1[0], cur.k1[1]}, {cur.k1[2], cur.k1[3]}};
                            f32x2 q1 = S0[0] * av[0], q2 = S0[0] * wv[0], q3 = S1[0] * av[0], q4 = S1[0] * wv[0];
#pragma unroll
                            for (int i = 1; i < 4; ++i) { q1 += S0[i] * av[i]; q2 += S0[i] * wv[i]; q3 += S1[i] * av[i]; q4 += S1[i] * wv[i]; }
                            float p1 = q1.x + q1.y, p2 = q2.x + q2.y, p3 = q3.x + q3.y, p4 = q4.x + q4.y;
                            p1 += dppf<0xB1>(p1); p2 += dppf<0xB1>(p2); p3 += dppf<0xB1>(p3); p4 += dppf<0xB1>(p4);
                            p1 += dppf<0x4E>(p1); p2 += dppf<0x4E>(p2); p3 += dppf<0x4E>(p3); p4 += dppf<0x4E>(p4);
                            p1 += dppf<0x141>(p1); p2 += dppf<0x141>(p2); p3 += dppf<0x141>(p3); p4 += dppf<0x141>(p4);
                            { const float y0 = p2 + p1 * cur.sc.x + cur.v0 * cur.sc.y, y1 = p4 + p3 * cur.sc.x + cur.v1 * cur.sc.y;
                              if (j8 == 0) { ybase[t * 64 + rp] = y0; ybase[t * 64 + 32 + rp] = y1; } }
                            const f32x2 sa0 = {p1, p1}, sa1 = {p3, p3}, vv0 = {cur.v0, cur.v0}, vv1 = {cur.v1, cur.v1};
#pragma unroll
                            for (int i = 0; i < 4; ++i) { S0[i] = (S0[i] * dv[i] + vv0 * kv[i]) + sa0 * bv[i]; S1[i] = (S1[i] * dv[i] + vv1 * kv[i]) + sa1 * bv[i]; }
                            cur = nxt;
                        }
                    }
                    LBAR();
                }
            }
        } else {
            const int w4 = wave - 4, ptid = tid - 256, tl = 4 * lq + w4;
            float mu_r[4], mu_k[4], mu_v[4], w0k[4], a0k[4], kkk[4], kak[4], rkk[4], gng[4], gnb[4];
#pragma unroll
            for (int nt = 0; nt < 4; ++nt) { const int k = hc + 16 * nt + l15;
                mu_r[nt] = p.in[25][k]; mu_k[nt] = p.in[25][4096 + k]; mu_v[nt] = p.in[25][8192 + k];
                w0k[nt] = p.in[28][k]; a0k[nt] = p.in[31][k]; kkk[nt] = p.in[34][k]; kak[nt] = p.in[35][k]; rkk[nt] = p.in[36][k]; gng[nt] = p.in[37][k]; gnb[nt] = p.in[38][k]; }
            u32x4 pfP[4]; u32x2 pfR[4];
#define RW_PREFETCH(c) do { const int row0_ = b * SEQL + (c) * TC; \
                _Pragma("unroll") for (int i = 0; i < 2; ++i) { const int it = ptid + 256 * i; const int mt = it / 192, rem = it - mt * 192, t_ = rem / 12, g_ = rem - t_ * 12; \
                    if (it < 384) { const size_t row_ = (size_t)(row0_ + t_); pfP[2 * i] = *(const u32x4*)(P + row_ * 384 + mt * 192 + 8 * g_); \
                        pfP[2 * i + 1] = ((c) == 0 && t_ == 0) ? (u32x4){0u, 0u, 0u, 0u} : *(const u32x4*)(P + (row_ - 1) * 384 + mt * 192 + 96 + 8 * g_); } } \
                _Pragma("unroll") for (int i = 0; i < 4; ++i) { const int it = ptid + 256 * i; const int ar = it / 272, rem = it - ar * 272, rr_ = rem >> 4, c4 = rem & 15; \
                    if (it < 816) { const u16* src_ = ar == 0 ? (const u16*)R : ar == 1 ? Kb : Vb; \
                        pfR[i] = ((c) == 0 && rr_ == 0) ? (u32x2){0u, 0u} : *(const u32x2*)(src_ + (size_t)(row0_ - 1 + rr_) * 4096 + hc + 4 * c4); } } } while (0)
            RW_PREFETCH(0);
            for (int pc = -1; pc <= NCH; ++pc) {
                const int cn = pc + 1;
                const bool prep = (cn < NCH);
                float* vnext = vec + (cn & 1) * TC * 384;
                float* snext = scal + (cn & 1) * TC * 4;
                if (prep) {
#pragma unroll
                    for (int i = 0; i < 2; ++i) { const int it = ptid + 256 * i; const int mt = it / 192, rem = it - mt * 192, t_ = rem / 12, g_ = rem - t_ * 12;
                        if (it < 384) { float c8[8], p8[8]; unpack8(pfP[2 * i], c8); unpack8(pfP[2 * i + 1], p8);
#pragma unroll
                            for (int j = 0; j < 8; ++j) { const float s = c8[j] + p8[j]; c8[j] = mt == 0 ? ftanh(s) : s; }
                            *(u32x4*)(twa + (mt * 16 + t_) * 104 + 8 * g_) = pack8(c8); } }
#pragma unroll
                    for (int i = 0; i < 4; ++i) { const int it = ptid + 256 * i; const int ar = it / 272, rem = it - ar * 272, rr_ = rem >> 4, c4 = rem & 15;
                        if (it < 816) *(u32x2*)(raw + (ar * 17 + rr_) * 64 + 4 * c4) = pfR[i]; }
                }
                if (cn + 1 < NCH) RW_PREFETCH(cn + 1);
                if (pc >= 1) {
                    const int cp = pc - 1; const float* vprev = vec + (cp & 1) * TC * 384; const float* sprev = scal + (cp & 1) * TC * 4; const float* yprev = Yraw + (cp & 1) * TC * 64;
                    const size_t row = (size_t)(b * SEQL + cp * TC + tl);
                    float y[4], s1 = 0.f;
#pragma unroll
                    for (int nt = 0; nt < 4; ++nt) { y[nt] = yprev[tl * 64 + 16 * nt + l15]; s1 += y[nt]; }
                    const float mu = row16_sum(s1) * (1.0f / 64.0f); float s2 = 0.f;
#pragma unroll
                    for (int nt = 0; nt < 4; ++nt) { y[nt] -= mu; s2 += y[nt] * y[nt]; }
                    const float rs = rsqrtf(row16_sum(s2) * (1.0f / 64.0f) + 64e-5f), bon = sprev[tl * 4 + 2];
#pragma unroll
                    for (int nt = 0; nt < 4; ++nt) R[row * 4096 + hc + 16 * nt + l15] = f2bf(y[nt] * rs * gng[nt] + gnb[nt] + bon * vprev[tl * 384 + 320 + 16 * nt + l15]);
                }
                LBAR();
                if (prep) {
                    f32x4 accW[4], accA[4];
#pragma unroll
                    for (int nt = 0; nt < 4; ++nt) { accW[nt] = (f32x4){0.f, 0.f, 0.f, 0.f}; accA[nt] = (f32x4){0.f, 0.f, 0.f, 0.f}; }
#pragma unroll
                    for (int ks = 0; ks < 3; ++ks) { const bf16x8 afw = *(const bf16x8*)(twa + l15 * 104 + 32 * ks + 8 * lq), afa = *(const bf16x8*)(twa + (16 + l15) * 104 + 32 * ks + 8 * lq);
#pragma unroll
                        for (int nt = 0; nt < 4; ++nt) { const bf16x8 bw = *(const bf16x8*)(W2t + (16 * nt + l15) * 104 + 32 * ks + 8 * lq), ba = *(const bf16x8*)(A2t + (16 * nt + l15) * 104 + 32 * ks + 8 * lq);
                            accW[nt] = MFMA16(afw, bw, accW[nt]); accA[nt] = MFMA16(afa, ba, accA[nt]); } }
                    float r_[4], kx0[4], v_[4], dec[4], a_[4], kkv[4]; float ss = 0.f;
#pragma unroll
                    for (int nt = 0; nt < 4; ++nt) { const int k = 16 * nt + l15;
                        const float wl = w0k[nt] + (w4 == 0 ? accW[nt][0] : w4 == 1 ? accW[nt][1] : w4 == 2 ? accW[nt][2] : accW[nt][3]);
                        const float al = a0k[nt] + (w4 == 0 ? accA[nt][0] : w4 == 1 ? accA[nt][1] : w4 == 2 ? accA[nt][2] : accA[nt][3]);
                        const float rr = bf2f(raw[(0 * 17 + tl + 1) * 64 + k]), rp_ = bf2f(raw[(0 * 17 + tl) * 64 + k]);
                        const float kr_ = bf2f(raw[(1 * 17 + tl + 1) * 64 + k]), kp = bf2f(raw[(1 * 17 + tl) * 64 + k]);
                        const float vr = bf2f(raw[(2 * 17 + tl + 1) * 64 + k]), vp = bf2f(raw[(2 * 17 + tl) * 64 + k]);
                        r_[nt] = rr + (rp_ - rr) * mu_r[nt]; kx0[nt] = kr_ + (kp - kr_) * mu_k[nt]; v_[nt] = vr + (vp - vr) * mu_v[nt];
                        dec[nt] = __expf(-0.60653066f * fsigmoid(wl)); a_[nt] = fsigmoid(al);
                        kkv[nt] = kx0[nt] * kkk[nt]; ss += kkv[nt] * kkv[nt]; }
                    const float rinv = rsqrtf(fmaxf(row16_sum(ss), 1e-24f));
                    float br = 0.f, krs = 0.f, bon = 0.f; float* vb = vnext + tl * 384;
#pragma unroll
                    for (int nt = 0; nt < 4; ++nt) { const int k = 16 * nt + l15;
                        const float kk = kkv[nt] * rinv, kmod = kx0[nt] * (1.0f + (a_[nt] - 1.0f) * kak[nt]), kb = kk * a_[nt];
                        br += kb * r_[nt]; krs += kmod * r_[nt]; bon += r_[nt] * kmod * rkk[nt];
                        vb[k] = dec[nt]; vb[64 + k] = -kk; vb[128 + k] = kb; vb[192 + k] = kmod; vb[256 + k] = dec[nt] * r_[nt]; vb[320 + k] = v_[nt]; }
                    br = row16_sum(br); krs = row16_sum(krs); bon = row16_sum(bon);
                    if (l15 == 0) { snext[tl * 4] = br; snext[tl * 4 + 1] = krs; snext[tl * 4 + 2] = bon; }
                }
                LBAR();
            }
#undef RW_PREFETCH
        }
        __syncthreads();
    }
}

#ifndef PROBE_ROLE
#define PROBE_ROLE -1
#endif
#define LBARW() do { if (PROBE_ROLE >= 0 && wave == PROBE_ROLE) { const unsigned long long tb_ = __builtin_amdgcn_s_memrealtime(); LBAR(); twait += __builtin_amdgcn_s_memrealtime() - tb_; } else { LBAR(); } } while (0)
__device__ void ptanh_phase(const Params& p) {
    u16* P = (u16*)(p.ws + OFF_P);
    const int gt = blockIdx.x * 512 + threadIdx.x, nth = gridDim.x * 512;
    for (int it = gt; it < NTOK * 24; it += nth) { const int row = it / 24, rem = it - row * 24, mt = rem / 12, g = rem - mt * 12;
        u16* cp = P + (size_t)row * 384 + mt * 192 + 8 * g;
        float c8[8], p8[8]; unpack8(*(const u32x4*)cp, c8);
        if ((row & (SEQL - 1)) != 0) unpack8(*(const u32x4*)(cp - 384 + 96), p8);
        else {
#pragma unroll
            for (int j = 0; j < 8; ++j) p8[j] = 0.f; }
#pragma unroll
        for (int j = 0; j < 8; ++j) { const float s = c8[j] + p8[j]; c8[j] = mt == 0 ? (1.0f - 2.0f * __builtin_amdgcn_rcpf(1.0f + __expf(2.0f * s))) : s; }
        *(u32x4*)cp = pack8(c8); }
}

__device__ unsigned long long rwkv2_phase(const Params& p, unsigned char* smem) {
    unsigned long long twait = 0;
    constexpr int TC = 16, NCH = SEQL / TC;
    u16* W2t = (u16*)smem;
    u16* A2t = W2t + 64 * 104;
    u16* raw = A2t + 64 * 104;
    u16* twa = raw + 3 * 17 * 64;
    u16* S1 = twa + 2 * 16 * 104;
    unsigned char* S1b = (unsigned char*)(S1 + 2 * 4 * 16 * 72);
    float* Mx = (float*)(S1b + 3 * 10560);
    u16* Mxb = (u16*)(Mx + 1024);
    u16* AhT = Mxb + 3 * 16 * 32;
    u16* VhT = AhT + 64 * 16;
    float* MVs = (float*)(VhT + 64 * 16);
    float* ssP = MVs + 16 * 64;
    float* bonP = ssP + 64;
    unsigned char* S2 = (unsigned char*)(bonP + 64);
    u16* Sb = (u16*)(S2 + 2 * 16896);
    const int tid = threadIdx.x, lane = tid & 63, wave = __builtin_amdgcn_readfirstlane(tid >> 6);
    const int l15 = lane & 15, lq = lane >> 4;
    u16* R = (u16*)(p.ws + OFF_R); const u16* Kb = (const u16*)(p.ws + OFF_KK); const u16* Vb = (const u16*)(p.ws + OFF_V); const u16* P = (const u16*)(p.ws + OFF_P);
    for (int unit = blockIdx.x; unit < 256; unit += gridDim.x) {
        const int b = unit >> 6, h = unit & 63, hc = 64 * h;
        for (int e = tid; e < 6144; e += 512) { const int j = e >> 6, k = e & 63; W2t[k * 104 + j] = f2bf(p.in[30][(size_t)j * 4096 + hc + k]); A2t[k * 104 + j] = f2bf(p.in[33][(size_t)j * 4096 + hc + k]); }
        for (int e = tid; e < 64 * 72; e += 512) Sb[e] = 0;
        for (int e = tid; e < 3 * 16 * 32; e += 512) Mxb[e] = 0;
        __syncthreads();
        if (wave < 4) {
            const int w4 = wave, ptid = tid, k = 16 * w4 + l15, kg = hc + k;
            const float mu_r = p.in[25][kg], mu_k = p.in[25][4096 + kg], mu_v = p.in[25][8192 + kg];
            const float w0k = p.in[28][kg], a0k = p.in[31][kg], kkk = p.in[34][kg], kak = p.in[35][kg], rkk = p.in[36][kg];
            u32x4 pfP[2]; u32x2 pfR[4];
#define RW_PREFETCH(c) do { const int row0_ = b * SEQL + (c) * TC; \
                _Pragma("unroll") for (int i = 0; i < 2; ++i) { const int it = ptid + 256 * i; const int mt = it / 192, rem = it - mt * 192, t_ = rem / 12, g_ = rem - t_ * 12; \
                    if (it < 384) pfP[i] = *(const u32x4*)(P + (size_t)(row0_ + t_) * 384 + mt * 192 + 8 * g_); } \
                _Pragma("unroll") for (int i = 0; i < 4; ++i) { const int it = ptid + 256 * i; const int ar = it / 272, rem = it - ar * 272, rr_ = rem >> 4, c4 = rem & 15; \
                    if (it < 816) { const u16* src_ = ar == 0 ? (const u16*)R : ar == 1 ? Kb : Vb; \
                        pfR[i] = ((c) == 0 && rr_ == 0) ? (u32x2){0u, 0u} : *(const u32x2*)(src_ + (size_t)(row0_ - 1 + rr_) * 4096 + hc + 4 * c4); } } } while (0)
            RW_PREFETCH(0);
            for (int pc = 0; pc <= NCH + 1; ++pc) {
                const bool prep = (pc < NCH);
                int ln_ = lane; asm volatile("" : "+v"(ln_)); const int l15 = ln_ & 15, lq = ln_ >> 4;
                u16* set1 = S1 + (pc & 1) * (4 * 16 * 72);
                u16* At = set1; u16* Rt = set1 + 16 * 72; u16* Bt = set1 + 2 * 16 * 72; u16* Kt = set1 + 3 * 16 * 72;
                unsigned char* set1b = S1b + (pc % 3) * 10560;
                float* Vf = (float*)set1b; u16* BKT = (u16*)(set1b + 4096); u16* VT = (u16*)(set1b + 8192); float* W15 = (float*)(set1b + 10240); float* bonus = (float*)(set1b + 10496);
                if (prep) {
#pragma unroll
                    for (int i = 0; i < 2; ++i) { const int it = ptid + 256 * i; const int mt = it / 192, rem = it - mt * 192, t_ = rem / 12, g_ = rem - t_ * 12;
                        if (it < 384) *(u32x4*)(twa + (mt * 16 + t_) * 104 + 8 * g_) = pfP[i]; }
#pragma unroll
                    for (int i = 0; i < 4; ++i) { const int it = ptid + 256 * i; const int ar = it / 272, rem = it - ar * 272, rr_ = rem >> 4, c4 = rem & 15;
                        if (it < 816) *(u32x2*)(raw + (ar * 17 + rr_) * 64 + 4 * c4) = pfR[i]; }
                }
                if (pc + 1 < NCH) RW_PREFETCH(pc + 1);
                LBARW();
                float au[4], bu[4];
                if (prep) {
                    float kkv[4], a_[4], eP[4], eTi[4];
                    f32x4 accW = {0.f, 0.f, 0.f, 0.f}, accA = {0.f, 0.f, 0.f, 0.f};
#pragma unroll
                    for (int ks = 0; ks < 3; ++ks) { const bf16x8 afw = *(const bf16x8*)(twa + l15 * 104 + 32 * ks + 8 * lq), afa = *(const bf16x8*)(twa + (16 + l15) * 104 + 32 * ks + 8 * lq);
                        const bf16x8 bwf = *(const bf16x8*)(W2t + k * 104 + 32 * ks + 8 * lq), baf = *(const bf16x8*)(A2t + k * 104 + 32 * ks + 8 * lq);
                        accW = MFMA16(afw, bwf, accW); accA = MFMA16(afa, baf, accA); }
                    float ld[4]; f32x4 cum = {0.f, 0.f, 0.f, 0.f};
#pragma unroll
                    for (int r = 0; r < 4; ++r) ld[r] = -0.60653066f * fsigmoid(w0k + accW[r]);
#pragma unroll
                    for (int r = 0; r < 4; ++r) cum = __builtin_amdgcn_mfma_f32_16x16x4f32((4 * lq + r <= l15) ? 1.0f : 0.0f, ld[r], cum, 0, 0, 0);
                    float kmq[4], vq[4];
#pragma unroll
                    for (int r = 0; r < 4; ++r) { const int t = 4 * lq + r;
                        const float rr = bf2f(raw[(0 * 17 + t + 1) * 64 + k]), rp_ = bf2f(raw[(0 * 17 + t) * 64 + k]);
                        const float kr_ = bf2f(raw[(1 * 17 + t + 1) * 64 + k]), kp = bf2f(raw[(1 * 17 + t) * 64 + k]);
                        const float vr = bf2f(raw[(2 * 17 + t + 1) * 64 + k]), vp = bf2f(raw[(2 * 17 + t) * 64 + k]);
                        const float r_ = rr + (rp_ - rr) * mu_r, kx0 = kr_ + (kp - kr_) * mu_k, v_ = vr + (vp - vr) * mu_v;
                        a_[r] = fsigmoid(a0k + accA[r]); kkv[r] = kx0 * kkk;
                        const float kmod = kx0 * (1.0f + (a_[r] - 1.0f) * kak);
                        const float eT = __expf(cum[r]); eTi[r] = __builtin_amdgcn_rcpf(eT); eP[r] = __expf(cum[r] - ld[r]);
                        const float ssp = row16_sum(kkv[r] * kkv[r]), bop = row16_sum(r_ * kmod * rkk);
                        if (l15 == 0) { ssP[t * 4 + w4] = ssp; bonP[t * 4 + w4] = bop; }
                        Rt[t * 72 + k] = f2bf(r_ * eT); kmq[r] = kmod * eTi[r]; Kt[t * 72 + k] = f2bf(kmq[r]);
                        Vf[t * 64 + k] = v_; vq[r] = v_;
                        au[r] = -kkv[r] * eP[r]; bu[r] = kkv[r] * a_[r] * eTi[r];
                        if (t == 15) W15[k] = eT; }
                    { u32x2 w_; w_.x = pk2(kmq[0], kmq[1]); w_.y = pk2(kmq[2], kmq[3]); *(u32x2*)(BKT + k * 32 + lq * 8 + 4) = w_; }
                    { u32x2 w_; w_.x = pk2(vq[0], vq[1]); w_.y = pk2(vq[2], vq[3]); *(u32x2*)(VT + k * 16 + 4 * lq) = w_; }
                }
                LBARW();
                if (prep) {
                    float bq[4];
#pragma unroll
                    for (int r = 0; r < 4; ++r) { const int t = 4 * lq + r; const f32x4 s4 = *(const f32x4*)(ssP + t * 4);
                        const float rinv = rsqrtf(fmaxf((s4[0] + s4[1]) + (s4[2] + s4[3]), 1e-24f));
                        At[t * 72 + k] = f2bf(au[r] * rinv); bq[r] = bu[r] * rinv; Bt[t * 72 + k] = f2bf(bq[r]);
                        if (w4 == 0 && l15 == 0) { const f32x4 b4 = *(const f32x4*)(bonP + t * 4); bonus[t] = (b4[0] + b4[1]) + (b4[2] + b4[3]); } }
                    { u32x2 w_; w_.x = pk2(bq[0], bq[1]); w_.y = pk2(bq[2], bq[3]); *(u32x2*)(BKT + k * 32 + lq * 8) = w_; }
                }
                LBARW();
            }
#undef RW_PREFETCH
        } else if (wave < 6) {
            for (int pc = 0; pc <= NCH + 1; ++pc) {
                const int cm = pc - 1; const bool act = (cm >= 0 && cm < NCH);
                int ln_ = lane; asm volatile("" : "+v"(ln_)); const int lane = ln_, l15 = ln_ & 15, lq = ln_ >> 4; (void)lane;
                const u16* set1 = S1 + (cm & 1) * (4 * 16 * 72);
                const u16* At = set1; const u16* Rt = set1 + 16 * 72; const u16* Bt = set1 + 2 * 16 * 72; const u16* Kt = set1 + 3 * 16 * 72;
                if (act) {
                    f32x4 m0 = {0.f, 0.f, 0.f, 0.f}, m1 = {0.f, 0.f, 0.f, 0.f};
                    const u16* Xt = (wave == 4) ? At : Rt;
#pragma unroll
                    for (int ks = 0; ks < 2; ++ks) { const int o = l15 * 72 + 32 * ks + 8 * lq;
                        const bf16x8 xf = *(const bf16x8*)(Xt + o), bf_ = *(const bf16x8*)(Bt + o), kf = *(const bf16x8*)(Kt + o);
                        m0 = MFMA16(xf, bf_, m0); m1 = MFMA16(xf, kf, m1); }
#pragma unroll
                    for (int r = 0; r < 4; ++r) { const int t = 4 * lq + r, s = l15;
                        if (wave == 4) { Mx[t * 16 + s] = (s < t) ? m0[r] : 0.f; Mxb[1024 + t * 32 + s] = f2bf((s < t) ? m1[r] : 0.f); }
                        else { Mxb[t * 32 + s] = f2bf((s <= t) ? m0[r] : 0.f); Mxb[512 + t * 32 + s] = f2bf((s <= t) ? m1[r] : 0.f); } }
                }
                LBARW();
                if (act) {
                    unsigned char* set2 = S2 + (cm & 1) * 16896;
                    const float* Vf = (const float*)(S1b + (cm % 3) * 10560);
#define TRI_ROW(dst, base, t) do { dst[0] = *(const f32x4*)(Mx + (base) + (t) * 16); dst[1] = *(const f32x4*)(Mx + (base) + (t) * 16 + 4); dst[2] = *(const f32x4*)(Mx + (base) + (t) * 16 + 8); dst[3] = *(const f32x4*)(Mx + (base) + (t) * 16 + 12); } while (0)
#define TRI_NEXT(rc, rn) do { _Pragma("unroll") for (int i_ = 0; i_ < 4; ++i_) rc[i_] = rn[i_]; asm volatile("" ::: "memory"); } while (0)
                    if (wave == 4) {
                        u16* Ah = (u16*)set2;
                        float ah[16], x0[16];
#pragma unroll
                        for (int t = 0; t < 16; ++t) x0[t] = bf2f(At[t * 72 + lane]);
                        f32x4 rc[4], rn[4];
                        TRI_ROW(rc, 0, 0);
#pragma unroll
                        for (int t = 0; t < 16; ++t) { if (t < 15) TRI_ROW(rn, 0, t + 1);
                            float pa[4] = {x0[t], 0.f, 0.f, 0.f};
#pragma unroll
                            for (int s = 0; s + 1 < t; ++s) pa[s & 3] += rc[s >> 2][s & 3] * ah[s];
                            float acc = (pa[0] + pa[1]) + (pa[2] + pa[3]);
                            if (t >= 1) acc += rc[(t - 1) >> 2][(t - 1) & 3] * ah[t - 1];
                            ah[t] = acc; Ah[t * 72 + lane] = f2bf(acc);
                            TRI_NEXT(rc, rn); }
                        { u32x4 q0, q1; q0.x = pk2(ah[0], ah[1]); q0.y = pk2(ah[2], ah[3]); q0.z = pk2(ah[4], ah[5]); q0.w = pk2(ah[6], ah[7]);
                          q1.x = pk2(ah[8], ah[9]); q1.y = pk2(ah[10], ah[11]); q1.z = pk2(ah[12], ah[13]); q1.w = pk2(ah[14], ah[15]);
                          *(u32x4*)(AhT + lane * 16) = q0; *(u32x4*)(AhT + lane * 16 + 8) = q1; }
                    } else {
                        float* Vh = (float*)(set2 + 4608);
                        { const u16* VT = (const u16*)(S1b + (cm % 3) * 10560 + 8192);
                          const bf16x8 makf = *(const bf16x8*)(Mxb + 1024 + l15 * 32 + 8 * lq);
#pragma unroll
                          for (int nt = 0; nt < 4; ++nt) { u32x4 vz = {0u, 0u, 0u, 0u}; if (lq < 2) vz = *(const u32x4*)(VT + (16 * nt + l15) * 16 + 8 * lq);
                              const f32x4 d = MFMA16(makf, as_frag(vz), ((f32x4){0.f, 0.f, 0.f, 0.f}));
#pragma unroll
                              for (int r = 0; r < 4; ++r) MVs[(4 * lq + r) * 64 + 16 * nt + l15] = d[r]; }
                          asm volatile("s_waitcnt lgkmcnt(0)" ::: "memory"); }
                        float vh[16], x0[16];
#pragma unroll
                        for (int t = 0; t < 16; ++t) x0[t] = MVs[t * 64 + lane];
                        f32x4 rc[4], rn[4];
                        TRI_ROW(rc, 0, 0);
#pragma unroll
                        for (int t = 0; t < 16; ++t) { if (t < 15) TRI_ROW(rn, 0, t + 1);
                            float pa[4] = {x0[t], 0.f, 0.f, 0.f};
#pragma unroll
                            for (int s = 0; s + 1 < t; ++s) pa[s & 3] += rc[s >> 2][s & 3] * vh[s];
                            float acc = (pa[0] + pa[1]) + (pa[2] + pa[3]);
                            if (t >= 1) acc += rc[(t - 1) >> 2][(t - 1) & 3] * vh[t - 1];
                            vh[t] = acc; Vh[t * 64 + lane] = acc;
                            TRI_NEXT(rc, rn); }
                        { u32x4 q0, q1; q0.x = pk2(vh[0], vh[1]); q0.y = pk2(vh[2], vh[3]); q0.z = pk2(vh[4], vh[5]); q0.w = pk2(vh[6], vh[7]);
                          q1.x = pk2(vh[8], vh[9]); q1.y = pk2(vh[10], vh[11]); q1.z = pk2(vh[12], vh[13]); q1.w = pk2(vh[14], vh[15]);
                          *(u32x4*)(VhT + lane * 16) = q0; *(u32x4*)(VhT + lane * 16 + 8) = q1; }
                    }
                }
#undef TRI_ROW
#undef TRI_NEXT
                LBARW();
                if (act) {
                    unsigned char* set2 = S2 + (cm & 1) * 16896;
                    const bf16x8 mrbf = *(const bf16x8*)(Mxb + l15 * 32 + 8 * lq);
                    if (wave == 4) {
                        u16* Rh = (u16*)(set2 + 2304); float* Yk = (float*)(set2 + 12800);
                        const u16* VT = (const u16*)(S1b + (cm % 3) * 10560 + 8192);
                        const bf16x8 mrkf = *(const bf16x8*)(Mxb + 512 + l15 * 32 + 8 * lq);
#pragma unroll
                        for (int nt = 0; nt < 4; ++nt) { u32x4 az = {0u, 0u, 0u, 0u}, vz = {0u, 0u, 0u, 0u};
                            if (lq < 2) { az = *(const u32x4*)(AhT + (16 * nt + l15) * 16 + 8 * lq); vz = *(const u32x4*)(VT + (16 * nt + l15) * 16 + 8 * lq); }
                            const f32x4 d = MFMA16(mrbf, as_frag(az), ((f32x4){0.f, 0.f, 0.f, 0.f})), e = MFMA16(mrkf, as_frag(vz), ((f32x4){0.f, 0.f, 0.f, 0.f}));
#pragma unroll
                            for (int r = 0; r < 4; ++r) { const int o = (4 * lq + r) * 72 + 16 * nt + l15; Rh[o] = f2bf(d[r] + bf2f(Rt[o])); Yk[(4 * lq + r) * 64 + 16 * nt + l15] = e[r]; } }
                    } else {
                        float* Yh = (float*)(set2 + 8704);
#pragma unroll
                        for (int nt = 0; nt < 4; ++nt) { u32x4 vz = {0u, 0u, 0u, 0u}; if (lq < 2) vz = *(const u32x4*)(VhT + (16 * nt + l15) * 16 + 8 * lq);
                            const f32x4 d = MFMA16(mrbf, as_frag(vz), ((f32x4){0.f, 0.f, 0.f, 0.f}));
#pragma unroll
                            for (int r = 0; r < 4; ++r) Yh[(4 * lq + r) * 64 + 16 * nt + l15] = d[r]; }
                    }
                }
                LBARW();
            }
        } else {
            const int ws = wave - 6;
            float gng[4], gnb[4];
#pragma unroll
            for (int nt = 0; nt < 4; ++nt) { gng[nt] = p.in[37][hc + 16 * nt + l15]; gnb[nt] = p.in[38][hc + 16 * nt + l15]; }
            f32x4 accS[2][4];
#pragma unroll
            for (int m = 0; m < 2; ++m)
#pragma unroll
                for (int n = 0; n < 4; ++n) accS[m][n] = (f32x4){0.f, 0.f, 0.f, 0.f};
            for (int pc = 0; pc <= NCH + 1; ++pc) {
                const int cs = pc - 2; const bool act = (cs >= 0 && cs < NCH); const bool doY = act && ((cs & 1) == ws);
                int ln_ = lane; asm volatile("" : "+v"(ln_)); const int lane = ln_, l15 = ln_ & 15, lq = ln_ >> 4; (void)lane;
                const unsigned char* set2 = S2 + (cs & 1) * 16896;
                const u16* Ah = (const u16*)set2; const u16* Rh = (const u16*)(set2 + 2304); const float* Vh = (const float*)(set2 + 4608); const float* Yh = (const float*)(set2 + 8704); const float* Yk = (const float*)(set2 + 12800);
                const unsigned char* set1b = S1b + (((cs % 3) + 3) % 3) * 10560;
                const float* Vf = (const float*)set1b; const u16* BKT = (const u16*)(set1b + 4096); const u16* VT = (const u16*)(set1b + 8192); const float* W15 = (const float*)(set1b + 10240); const float* bonus = (const float*)(set1b + 10496);
                f32x4 accY[4];
                if (act) {
                    bf16x8 ahf[2];
#pragma unroll
                    for (int ks = 0; ks < 2; ++ks) ahf[ks] = *(const bf16x8*)(Ah + l15 * 72 + 32 * ks + 8 * lq);
                    f32x4 accSA[2];
#pragma unroll
                    for (int m = 0; m < 2; ++m) { const int vb = 16 * (2 * ws + m);
#pragma unroll
                        for (int r = 0; r < 4; ++r) accSA[m][r] = Vh[(4 * lq + r) * 64 + vb + l15];
#pragma unroll
                        for (int ks = 0; ks < 2; ++ks) { const bf16x8 sbf = *(const bf16x8*)(Sb + (vb + l15) * 72 + 32 * ks + 8 * lq); accSA[m] = MFMA16(ahf[ks], sbf, accSA[m]); } }
                    if (doY) {
                        bf16x8 rhf[2];
#pragma unroll
                        for (int ks = 0; ks < 2; ++ks) rhf[ks] = *(const bf16x8*)(Rh + l15 * 72 + 32 * ks + 8 * lq);
#pragma unroll
                        for (int nt = 0; nt < 4; ++nt) {
#pragma unroll
                            for (int r = 0; r < 4; ++r) accY[nt][r] = Yh[(4 * lq + r) * 64 + 16 * nt + l15] + Yk[(4 * lq + r) * 64 + 16 * nt + l15];
#pragma unroll
                            for (int ks = 0; ks < 2; ++ks) { const bf16x8 sbf = *(const bf16x8*)(Sb + (16 * nt + l15) * 72 + 32 * ks + 8 * lq); accY[nt] = MFMA16(rhf[ks], sbf, accY[nt]); } }
                    }
#pragma unroll
                    for (int m = 0; m < 2; ++m) { const int vb = 16 * (2 * ws + m);
                        u32x4 af; af.x = pk2(accSA[m][0], accSA[m][1]); af.y = pk2(accSA[m][2], accSA[m][3]);
                        const u32x2 vt = *(const u32x2*)(VT + (vb + l15) * 16 + 4 * lq); af.z = vt.x; af.w = vt.y;
#pragma unroll
                        for (int n = 0; n < 4; ++n) { const bf16x8 bkf = *(const bf16x8*)(BKT + (16 * n + l15) * 32 + 8 * lq); accS[m][n] = MFMA16(as_frag(af), bkf, accS[m][n]); } }
#pragma unroll
                    for (int n = 0; n < 4; ++n) { const float w = W15[16 * n + l15];
#pragma unroll
                        for (int m = 0; m < 2; ++m) accS[m][n] = accS[m][n] * w; }
                }
                LBARW();
                if (act) {
#pragma unroll
                    for (int m = 0; m < 2; ++m)
#pragma unroll
                        for (int n = 0; n < 4; ++n)
#pragma unroll
                            for (int r = 0; r < 4; ++r) Sb[(16 * (2 * ws + m) + 4 * lq + r) * 72 + 16 * n + l15] = f2bf(accS[m][n][r]);
                }
                if (doY) {
#pragma unroll
                    for (int r = 0; r < 4; ++r) { const int t = 4 * lq + r; const size_t row = (size_t)(b * SEQL + cs * TC + t);
                        const float mu = row16_sum(accY[0][r] + accY[1][r] + accY[2][r] + accY[3][r]) * (1.0f / 64.0f);
                        float d[4], s2 = 0.f;
#pragma unroll
                        for (int nt = 0; nt < 4; ++nt) { d[nt] = accY[nt][r] - mu; s2 += d[nt] * d[nt]; }
                        const float rs = rsqrtf(row16_sum(s2) * (1.0f / 64.0f) + 64e-5f), bon = bonus[t];
#pragma unroll
                        for (int nt = 0; nt < 4; ++nt) R[row * 4096 + hc + 16 * nt + l15] = f2bf(d[nt] * rs * gng[nt] + gnb[nt] + bon * Vf[t * 64 + 16 * nt + l15]); }
                }
                LBARW();
                LBARW();
            }
        }
        __syncthreads();
    }
    return twait;
}

__global__ void __launch_bounds__(512, 2) mega(Params p) {
    extern __shared__ __attribute__((aligned(16))) unsigned char smem[];
    cg::grid_group grid = cg::this_grid();
    const int lo = p.ph_lo, hi = p.ph_hi;
#define IN(k) (lo <= (k) && (k) < hi)
#define SEAM(k) do { if (IN(k) && IN((k) + 1)) grid.sync(); if (PROBE_PH >= 0) { const unsigned long long tn_ = __builtin_amdgcn_s_memrealtime(); if ((PROBE_PH >> (k)) & 1) tp1 += tn_ - tp0; tp0 = tn_; } } while (0)
    unsigned long long tp0 = (PROBE_PH >= 0) ? __builtin_amdgcn_s_memrealtime() : 0ull, tp1 = 0;
    unsigned char* ws = p.ws;
    PG8_LAS unsigned char* glds = (PG8_LAS unsigned char*)smem;
    if (IN(0)) for (int rep_ = 0; rep_ < 1 + (REP_MASK & 1); ++rep_) {
        tconv(smem, p.in[2], 8192, 0, 8192, 2048, (u16*)(ws + OFF_W0IN), 2048);
        tconv(smem, p.in[21], 2048, 0, 2048, 4096, (u16*)(ws + OFF_W0OUT), 4096);
        prep_small(p);
        rows_phase<0>(p);
    }
    SEAM(0);
    if (IN(1)) {
        pg8::Gemm g{(const u16*)(ws + OFF_H), (const u16*)(ws + OFF_W0IN), NTOK, 8192, 2048}; pg8::StaticOrder S; S.init(NTOK, 8192, gridDim.x, blockIdx.x);
        pg8::EpiG<F1> E{F1{(u16*)(ws + OFF_XR), (u16*)(ws + OFF_XM), (u16*)(ws + OFF_Y0)}};
        pg8::gemm_phase(glds, g, S, E); if ((REP_MASK >> 1) & 1) pg8::gemm_phase(glds, g, S, E);
    }
    SEAM(1);
    if (IN(2)) {
        mqk_phase(p, smem); if ((REP_MASK >> 2) & 1) { mqk_phase(p, smem); }
        lru_phase<1>(p, smem); if ((REP_MASK >> 3) & 1) { lru_phase<1>(p, smem); }
        tconv(smem, p.in[24], 16384, 0, 8192, 2048, (u16*)(ws + OFF_W1), 2048); if ((REP_MASK >> 4) & 1) { tconv(smem, p.in[24], 16384, 0, 8192, 2048, (u16*)(ws + OFF_W1), 2048); }
    }
    SEAM(2);
    if (IN(3)) lru_carry(p); if ((REP_MASK >> 5) & 1) { lru_carry(p); }
    SEAM(3);
    if (IN(4)) {
#ifdef PROBE_SUB
        const unsigned long long ta_ = __builtin_amdgcn_s_memrealtime();
#endif
        mlstm_phase(p, smem);
#ifdef PROBE_SUB
        tp1 += __builtin_amdgcn_s_memrealtime() - ta_;
#endif
        lru_phase<2>(p, smem); }
    SEAM(4);
    if (IN(5)) mnorm_phase(p);
    SEAM(5);
    if (IN(6)) {
        pg8::Gemm g{(const u16*)(ws + OFF_Y0), (const u16*)(ws + OFF_W0OUT), NTOK, 2048, 4096}; pg8::StaticOrder S; S.init(NTOK, 2048, gridDim.x, blockIdx.x);
        pg8::EpiG<F2> E{F2{(u16*)(ws + OFF_M0)}};
        pg8::gemm_phase(glds, g, S, E); if ((REP_MASK >> 7) & 1) pg8::gemm_phase(glds, g, S, E);
    }
    SEAM(6);
    if (IN(7)) {
        rows_phase<1>(p); if ((REP_MASK >> 8) & 1) { rows_phase<1>(p); }
        tconv(smem, p.in[24], 16384, 8192, 4096, 2048, (u16*)(ws + OFF_W1) + (size_t)8192 * 2048, 2048); if ((REP_MASK >> 4) & 1) { tconv(smem, p.in[24], 16384, 8192, 4096, 2048, (u16*)(ws + OFF_W1) + (size_t)8192 * 2048, 2048); }
        prep_extras(p); if ((REP_MASK >> 4) & 1) { prep_extras(p); }
    }
    SEAM(7);
    if (IN(8)) {
        pg8::Gemm g{(const u16*)(ws + OFF_H), (const u16*)(ws + OFF_W1), NTOK, 12800, 2048}; pg8::StaticOrder S; S.init(NTOK, 12800, gridDim.x, blockIdx.x);
        pg8::EpiG<F3> E{F3{(u16*)(ws + OFF_R), (u16*)(ws + OFF_P)}};
        pg8::gemm_phase(glds, g, S, E); if ((REP_MASK >> 9) & 1) pg8::gemm_phase(glds, g, S, E);
    }
    SEAM(8);
    if (IN(9)) {
#if RWKV_CHUNKED
        ptanh_phase(p);
        grid.sync();
        { const unsigned long long tw_ = rwkv2_phase(p, smem); if (PROBE_ROLE >= 0) tp1 += tw_; }
#else
        rwkv_phase(p, smem);
#endif
        tconv(smem, p.in[24], 16384, 12288, 4096, 2048, (u16*)(ws + OFF_W1Z), 2048); if ((REP_MASK >> 4) & 1) { tconv(smem, p.in[24], 16384, 12288, 4096, 2048, (u16*)(ws + OFF_W1Z), 2048); }
        tconv(smem, p.in[39], 2048, 0, 2048, 4096, (u16*)(ws + OFF_W1OUT), 4096); if ((REP_MASK >> 4) & 1) { tconv(smem, p.in[39], 2048, 0, 2048, 4096, (u16*)(ws + OFF_W1OUT), 4096); }
    }
    SEAM(9);
    if (IN(10)) {
        pg8::Gemm g{(const u16*)(ws + OFF_H), (const u16*)(ws + OFF_W1Z), NTOK, 4096, 2048}; pg8::StaticOrder S; S.init(NTOK, 4096, gridDim.x, blockIdx.x);
        pg8::EpiG<F4> E{F4{(u16*)(ws + OFF_R)}};
        pg8::gemm_phase(glds, g, S, E);
    }
    SEAM(10);
    if (IN(11)) {
        pg8::Gemm g{(const u16*)(ws + OFF_R), (const u16*)(ws + OFF_W1OUT), NTOK, 2048, 4096}; pg8::StaticOrder S; S.init(NTOK, 2048, gridDim.x, blockIdx.x);
        pg8::EpiG<F2> E{F2{(u16*)(ws + OFF_M1)}};
        pg8::gemm_phase(glds, g, S, E); if ((REP_MASK >> 10) & 1) pg8::gemm_phase(glds, g, S, E);
    }
    SEAM(11);
    if (IN(12)) rows_phase<2>(p);
#ifdef PROBE_SUB
    { const unsigned long long te = __builtin_amdgcn_s_memrealtime(); while (__builtin_amdgcn_s_memrealtime() - te < tp1) __builtin_amdgcn_s_sleep(8); }
#endif
    if (PROBE_PH >= 0) { const unsigned long long te = __builtin_amdgcn_s_memrealtime(); while (__builtin_amdgcn_s_memrealtime() - te < tp1) __builtin_amdgcn_s_sleep(8); }
}

extern "C" void kernel_launch(void* const* d_in, const int* in_sizes, int n_in, void* d_out, int out_size, void* d_ws, size_t ws_size, hipStream_t stream) {
    static int grid_blocks = 0;
    if (!grid_blocks) {
        if (n_in != 41 || ws_size < WS_NEED) { fprintf(stderr, "kernel_launch: unexpected n_in %d / ws_size %zu (need %zu)\n", n_in, ws_size, (size_t)WS_NEED); grid_blocks = -1; }
        else {
            int dev = 0, cus = 0, per_cu = 0;
            hipGetDevice(&dev);
            hipDeviceGetAttribute(&cus, hipDeviceAttributeMultiprocessorCount, dev);
            if (hipFuncSetAttribute((const void*)mega, hipFuncAttributeMaxDynamicSharedMemorySize, LDS_BYTES) != hipSuccess) fprintf(stderr, "kernel_launch: hipFuncSetAttribute failed\n");
            hipOccupancyMaxActiveBlocksPerMultiprocessor(&per_cu, (const void*)mega, 512, LDS_BYTES);
            if (per_cu < 1) { fprintf(stderr, "kernel_launch: occupancy query says %d blocks/CU\n", per_cu); per_cu = 1; }
            grid_blocks = cus * 1;
            if (grid_blocks > cus * per_cu) grid_blocks = cus * per_cu;
        }
    }
    if (grid_blocks <= 0) return;
    Params p{};
    for (int i = 0; i < 41; ++i) p.in[i] = (const float*)d_in[i];
    p.out = (float*)d_out; p.ws = (unsigned char*)d_ws;
#if N_LAUNCH_MODE == 1
    p.ph_lo = 0; p.ph_hi = NPH;
    { void* args[] = {&p};
      hipError_t e = hipLaunchCooperativeKernel((const void*)mega, dim3(grid_blocks), dim3(512), args, LDS_BYTES, stream);
      if (e != hipSuccess) fprintf(stderr, "cooperative launch failed: %s (grid %d)\n", hipGetErrorString(e), grid_blocks); }
#else
    for (int ph = 0; ph < NPH; ++ph) { p.ph_lo = ph; p.ph_hi = ph + 1; void* args[] = {&p};
        hipError_t e = hipLaunchCooperativeKernel((const void*)mega, dim3(grid_blocks), dim3(512), args, LDS_BYTES, stream);
        if (e != hipSuccess) { fprintf(stderr, "launch %d failed: %s (grid %d)\n", ph, hipGetErrorString(e), grid_blocks); break; } }
#endif
}
```

```cpp
#include <hip/hip_runtime.h>
#include <hip/hip_cooperative_groups.h>
#include <cstdio>
namespace cg = cooperative_groups;

#ifndef REP_MASK
#define REP_MASK 0
#endif
#ifndef PROBE_PH
#define PROBE_PH -1
#endif
#define REPS(k) for (int rep_ = 0; rep_ < 1 + ((REP_MASK >> (k)) & 1); ++rep_)
#ifndef RWKV_CHUNKED
#define RWKV_CHUNKED 1
#endif
#ifndef N_LAUNCH_MODE
#define N_LAUNCH_MODE 1
#endif

typedef unsigned short u16;
typedef short bf16x8 __attribute__((ext_vector_type(8)));
typedef float f32x4 __attribute__((ext_vector_type(4)));
typedef float f32x2 __attribute__((ext_vector_type(2)));
typedef unsigned u32x4 __attribute__((ext_vector_type(4)));
typedef unsigned u32x2 __attribute__((ext_vector_type(2)));

constexpr int NTOK = 16384, DM = 2048, SEQL = 4096;
constexpr size_t MiB = (size_t)1 << 20;
constexpr size_t OFF_H = 0;
constexpr size_t OFF_XR = 64 * MiB;
constexpr size_t OFF_XM = 128 * MiB;
constexpr size_t OFF_Y0 = 192 * MiB;
constexpr size_t OFF_Q = 320 * MiB;
constexpr size_t OFF_KX = 384 * MiB;
constexpr size_t OFF_W0IN = 448 * MiB;
constexpr size_t OFF_W0OUT = 480 * MiB;
constexpr size_t OFF_SMALL = 496 * MiB;
constexpr size_t OFF_G = OFF_SMALL;
constexpr size_t OFF_LRUA = OFF_SMALL + 1 * MiB;
constexpr size_t OFF_LRUH = OFF_SMALL + 3 * MiB;
constexpr size_t OFF_LRUC = OFF_SMALL + 5 * MiB;
constexpr size_t OFF_LRUW = OFF_SMALL + 7 * MiB;
constexpr size_t OFF_WGT = OFF_SMALL + 8 * MiB;
constexpr size_t OFF_M0 = OFF_XR;
constexpr size_t OFF_R = 64 * MiB, OFF_KK = 192 * MiB, OFF_V = 320 * MiB;
constexpr size_t OFF_W1 = 448 * MiB;
constexpr size_t OFF_P = 498 * MiB;
constexpr size_t OFF_W1Z = 448 * MiB, OFF_W1OUT = 464 * MiB;
constexpr size_t OFF_M1 = OFF_V;
constexpr size_t WS_NEED = 510 * MiB;
constexpr int LDS_BYTES = 160 * 1024;
constexpr int NPH = 13;

struct Params { const float* in[41]; float* out; unsigned char* ws; int ph_lo, ph_hi; };

__device__ __forceinline__ unsigned pk2(float lo, float hi) { unsigned r; asm volatile("v_cvt_pk_bf16_f32 %0, %1, %2" : "=v"(r) : "v"(lo), "v"(hi)); return r; }
__device__ __forceinline__ u16 f2bf(float f) { return (u16)(pk2(f, 0.f) & 0xffffu); }
__device__ __forceinline__ float bf2f(u16 v) { return __uint_as_float(((unsigned)v) << 16); }
__device__ __forceinline__ float bflo(unsigned w) { return __uint_as_float(w << 16); }
__device__ __forceinline__ float bfhi(unsigned w) { return __uint_as_float(w & 0xffff0000u); }
__device__ __forceinline__ void unpack8(u32x4 w, float* f) { f[0] = bflo(w.x); f[1] = bfhi(w.x); f[2] = bflo(w.y); f[3] = bfhi(w.y); f[4] = bflo(w.z); f[5] = bfhi(w.z); f[6] = bflo(w.w); f[7] = bfhi(w.w); }
__device__ __forceinline__ u32x4 pack8(const float* f) { u32x4 w; w.x = pk2(f[0], f[1]); w.y = pk2(f[2], f[3]); w.z = pk2(f[4], f[5]); w.w = pk2(f[6], f[7]); return w; }
__device__ __forceinline__ bf16x8 as_frag(u32x4 w) { union { u32x4 u; bf16x8 b; } c; c.u = w; return c.b; }
__device__ __forceinline__ float sigmoidf_(float x) { return 1.0f / (1.0f + __expf(-x)); }
__device__ __forceinline__ float siluf_(float x) { return x / (1.0f + __expf(-x)); }
__device__ __forceinline__ float softplusf_(float x) { return fmaxf(x, 0.f) + log1pf(__expf(-fabsf(x))); }
__device__ __forceinline__ float wave_sum(float v) {
#pragma unroll
    for (int o = 32; o; o >>= 1) v += __shfl_xor(v, o);
    return v;
}
template <int CTRL> __device__ __forceinline__ float dppf(float v) { return __int_as_float(__builtin_amdgcn_update_dpp(0, __float_as_int(v), CTRL, 0xF, 0xF, false)); }
__device__ __forceinline__ float wave_sum_dpp(float v) {
    v += dppf<0xB1>(v); v += dppf<0x4E>(v); v += dppf<0x141>(v); v += dppf<0x140>(v);
    const int iv = __float_as_int(v);
    return __int_as_float(__builtin_amdgcn_readlane(iv, 0)) + __int_as_float(__builtin_amdgcn_readlane(iv, 16)) + __int_as_float(__builtin_amdgcn_readlane(iv, 32)) + __int_as_float(__builtin_amdgcn_readlane(iv, 48));
}
#define MFMA16(a, b, c) __builtin_amdgcn_mfma_f32_16x16x32_bf16((a), (b), (c), 0, 0, 0)

namespace pg8 {
#define PG8_LAS __attribute__((address_space(3)))
typedef unsigned short bf16_t;
constexpr int BM = 256, BK = 64, HALF = 128, HTB = HALF * BK * 2, STAGE_BYTES = 8 * HTB, NXCD = 8, WGM = 8;
__host__ __device__ __forceinline__ int lds_byte(int r, int c) { const int st = (r >> 4) * 2 + (c >> 5), rr = r & 15, cc = c & 31, ob = rr * 64 + cc * 2; return st * 1024 + (ob ^ (((ob >> 9) & 1) << 5)); }
__host__ __device__ __forceinline__ void stage_rc(int b, int& R, int& C) { const int st = b / 1024, sb = b % 1024, swz = sb ^ (((sb >> 9) & 1) << 5); R = (st >> 1) * 16 + swz / 64; C = (st & 1) * 32 + (swz % 64) / 2; }
__host__ __device__ __forceinline__ int perm32(int rho) { const int n = rho >> 4, i = rho & 15; return 8 * (i >> 2) + 4 * n + (i & 3); }
struct Unit { int pm, pn; };
struct Gemm { const bf16_t* A; const bf16_t* Bt; int M, N, K; };
struct StaticOrder {
    int nM, nN, nwg, G, c;
    __host__ __device__ void init(int M, int N, int G_, int c_) { nM = M / BM; nN = N / BM; nwg = nM * nN; G = G_; c = c_; }
    __host__ __device__ bool next(int i, Unit& u) const {
        const long L = (long)i * G + c; if (L >= nwg) return false;
        int wgid = (int)L; { const int q = nwg / NXCD, r = nwg % NXCD, xcd = wgid % NXCD, off = wgid / NXCD; wgid = (xcd < r ? xcd * (q + 1) : r * (q + 1) + (xcd - r) * q) + off; }
        const int nig = WGM * nN, gid = wgid / nig, fm = gid * WGM, gsz = (nM - fm) < WGM ? (nM - fm) : WGM;
        u.pm = fm + ((wgid % nig) % gsz); u.pn = (wgid % nig) / gsz; return true;
    }
};
template <class F> struct EpiG {
    static constexpr bool PERM = true;
    F f;
    __device__ __forceinline__ void operator()(const f32x4 (&acc)[2][2][4][2], const Unit& u, int wr, int wc, int fr, int fq) const {
        const int row0 = u.pm * BM + wr * 64 + fr, col0 = u.pn * BM + wc * 32 + 8 * fq;
#pragma unroll
        for (int ai = 0; ai < 2; ++ai)
#pragma unroll
            for (int m = 0; m < 4; ++m)
#pragma unroll
                for (int bj = 0; bj < 2; ++bj) f(row0 + ai * HALF + m * 16, col0 + bj * HALF, acc[ai][bj][m][0], acc[ai][bj][m][1]);
    }
};

template <class Epi>
__device__ __forceinline__ void gemm_phase(PG8_LAS unsigned char* lds, const Gemm g, const StaticOrder& S, const Epi& E) {
    const int tid = threadIdx.x, wid = __builtin_amdgcn_readfirstlane(tid >> 6), lane = tid & 63, wr = wid >> 2, wc = wid & 3, fr = lane & 15, fq = lane >> 4;
    const int K = g.K, nt = K / BK;
    unsigned voffA[2], voffB[2];
#pragma unroll
    for (int i = 0; i < 2; ++i) { int R, C; stage_rc(tid * 16 + i * 8192, R, C); const int Rb = Epi::PERM ? ((R & ~31) + perm32(R & 31)) : R;
        voffA[i] = (unsigned)(R * K + C) * 2u; voffB[i] = (unsigned)(Rb * K + C) * 2u; }
    const size_t kstep = (size_t)(BK * 2);
    const size_t hstep = (size_t)HALF * K * 2;
    const size_t tstep = 2 * hstep;
    const unsigned ldsw = (unsigned)wid * 1024u;
    const int aoff = lds_byte(wr * 64 + fr, fq * 8), boff = lds_byte(wc * 32 + fr, fq * 8);
#define PG8_SA(b, h) (((b) * 2 + (h)) * HTB)
#define PG8_SB(b, h) ((4 + (b) * 2 + (h)) * HTB)
#define PG8_STAGE(bufoff, gbase, voff) do { _Pragma("unroll") for (int _i = 0; _i < 2; ++_i) \
        __builtin_amdgcn_global_load_lds((const unsigned*)((const char*)(gbase) + (voff)[_i]), (PG8_LAS unsigned*)(lds + (bufoff) + ldsw + _i * 8192), 16, 0, 0); } while (0)
#define PG8_LDA(dst, b, h) do { _Pragma("unroll") for (int m = 0; m < 4; ++m) _Pragma("unroll") for (int k = 0; k < 2; ++k) dst[m][k] = *(const PG8_LAS bf16x8*)(lds + PG8_SA(b, h) + aoff + m * 2048 + k * 1024); } while (0)
#define PG8_LDB(dst, b, h) do { _Pragma("unroll") for (int n = 0; n < 2; ++n) _Pragma("unroll") for (int k = 0; k < 2; ++k) dst[n][k] = *(const PG8_LAS bf16x8*)(lds + PG8_SB(b, h) + boff + n * 2048 + k * 1024); } while (0)
#define PG8_MMA(ai, bj, At, Bt) do { __builtin_amdgcn_s_setprio(1); _Pragma("unroll") for (int m = 0; m < 4; ++m) _Pragma("unroll") for (int n = 0; n < 2; ++n) _Pragma("unroll") for (int k = 0; k < 2; ++k) \
        acc[ai][bj][m][n] = __builtin_amdgcn_mfma_f32_16x16x32_bf16(Bt[n][k], At[m][k], acc[ai][bj][m][n], 0, 0, 0); __builtin_amdgcn_s_setprio(0); } while (0)
#define PG8_WAIT_V(n) asm volatile("s_waitcnt vmcnt(" #n ")" ::: "memory")
#define PG8_WAIT_L(n) asm volatile("s_waitcnt lgkmcnt(" #n ")" ::: "memory")
#define PG8_BAR __builtin_amdgcn_s_barrier()
#define PG8_SCHED __builtin_amdgcn_sched_barrier(0)
    Unit cur, nxt; int ui = 0;
    if (!S.next(0, cur)) return;
    f32x4 acc[2][2][4][2];
#pragma unroll
    for (int a = 0; a < 2; ++a)
#pragma unroll
        for (int b = 0; b < 2; ++b)
#pragma unroll
            for (int m = 0; m < 4; ++m)
#pragma unroll
                for (int n = 0; n < 2; ++n) acc[a][b][m][n] = (f32x4){0.f, 0.f, 0.f, 0.f};
    bf16x8 At[4][2], B0[2][2], B1[2][2];
    const char* cA = (const char*)g.A + (size_t)cur.pm * tstep; const char* cB = (const char*)g.Bt + (size_t)cur.pn * tstep;
    PG8_STAGE(PG8_SB(0, 0), cB, voffB); PG8_STAGE(PG8_SA(0, 0), cA, voffA); PG8_STAGE(PG8_SB(0, 1), cB + hstep, voffB); PG8_STAGE(PG8_SA(0, 1), cA + hstep, voffA);
    if (wr == 1) PG8_BAR;
    PG8_WAIT_V(4); PG8_BAR;
    PG8_STAGE(PG8_SB(1, 0), cB + kstep, voffB); PG8_STAGE(PG8_SA(1, 0), cA + kstep, voffA); PG8_STAGE(PG8_SB(1, 1), cB + hstep + kstep, voffB);
    PG8_WAIT_V(6); PG8_BAR;
    for (;;) {
        const bool has_next = S.next(ui + 1, nxt);
        const char* nA = has_next ? (const char*)g.A + (size_t)nxt.pm * tstep : cA; const char* nB = has_next ? (const char*)g.Bt + (size_t)nxt.pn * tstep : cB;
        for (int t = 0; t < nt; t += 2) {
            const bool last = (t == nt - 2);
            const char* a1 = cA + (size_t)(t + 1) * kstep;
            const char* a2 = last ? nA : cA + (size_t)(t + 2) * kstep; const char* b2 = last ? nB : cB + (size_t)(t + 2) * kstep;
            const char* a3 = a2 + kstep; const char* b3 = b2 + kstep;
            PG8_LDB(B0, 0, 0); PG8_SCHED; PG8_LDA(At, 0, 0); PG8_STAGE(PG8_SA(1, 1), a1 + hstep, voffA);
            PG8_WAIT_L(8); PG8_BAR; PG8_WAIT_L(0); PG8_MMA(0, 0, At, B0); PG8_BAR; PG8_SCHED;
            PG8_LDB(B1, 0, 1); PG8_STAGE(PG8_SB(0, 0), b2, voffB);
            PG8_BAR; PG8_WAIT_L(0); PG8_MMA(0, 1, At, B1); PG8_BAR;
            PG8_LDA(At, 0, 1); PG8_STAGE(PG8_SA(0, 0), a2, voffA);
            PG8_BAR; PG8_WAIT_L(0); PG8_MMA(1, 0, At, B0); PG8_BAR; PG8_SCHED;
            PG8_STAGE(PG8_SB(0, 1), b2 + hstep, voffB);
            PG8_WAIT_V(6); PG8_BAR; PG8_MMA(1, 1, At, B1); PG8_BAR;
            PG8_LDB(B0, 1, 0); PG8_SCHED; PG8_LDA(At, 1, 0); PG8_STAGE(PG8_SA(0, 1), a2 + hstep, voffA);
            PG8_WAIT_L(8); PG8_BAR; PG8_WAIT_L(0); PG8_MMA(0, 0, At, B0); PG8_BAR; PG8_SCHED;
            PG8_LDB(B1, 1, 1); PG8_STAGE(PG8_SB(1, 0), b3, voffB);
            PG8_BAR; PG8_WAIT_L(0); PG8_MMA(0, 1, At, B1); PG8_BAR;
            PG8_LDA(At, 1, 1); PG8_STAGE(PG8_SA(1, 0), a3, voffA);
            PG8_BAR; PG8_WAIT_L(0); PG8_MMA(1, 0, At, B0); PG8_BAR; PG8_SCHED;
            PG8_STAGE(PG8_SB(1, 1), b3 + hstep, voffB);
            PG8_WAIT_V(6); PG8_BAR; PG8_MMA(1, 1, At, B1); PG8_BAR;
        }
        E(acc, cur, wr, wc, fr, fq);
        if (!has_next) break;
#pragma unroll
        for (int a = 0; a < 2; ++a)
#pragma unroll
            for (int b = 0; b < 2; ++b)
#pragma unroll
                for (int m = 0; m < 4; ++m)
#pragma unroll
                    for (int n = 0; n < 2; ++n) acc[a][b][m][n] = (f32x4){0.f, 0.f, 0.f, 0.f};
        cur = nxt; cA = nA; cB = nB; ++ui;
    }
    PG8_WAIT_V(0);
    if (wr == 0) PG8_BAR;
    PG8_BAR;
#undef PG8_SA
#undef PG8_SB
#undef PG8_STAGE
#undef PG8_LDA
#undef PG8_LDB
#undef PG8_MMA
#undef PG8_WAIT_V
#undef PG8_WAIT_L
#undef PG8_BAR
#undef PG8_SCHED
}
}

__device__ __forceinline__ void store8bf(u16* dst, f32x4 v0, f32x4 v1) { u32x4 w; w.x = pk2(v0[0], v0[1]); w.y = pk2(v0[2], v0[3]); w.z = pk2(v1[0], v1[1]); w.w = pk2(v1[2], v1[3]); *(u32x4*)dst = w; }
struct F1 { u16 *XR, *XM, *Y0;
    __device__ __forceinline__ void operator()(int row, int col, f32x4 v0, f32x4 v1) const {
        const int reg = col >> 11, cc = col & 2047;
        u16* dst = reg == 0 ? XR + (size_t)row * 2048 + cc : reg == 1 ? Y0 + (size_t)row * 4096 + cc : reg == 2 ? XM + (size_t)row * 2048 + cc : Y0 + (size_t)row * 4096 + 2048 + cc;
        store8bf(dst, v0, v1); } };
struct F2 { u16* C;
    __device__ __forceinline__ void operator()(int row, int col, f32x4 v0, f32x4 v1) const { store8bf(C + (size_t)row * 2048 + col, v0, v1); } };
struct F3 { u16 *RKV, *P;
    __device__ __forceinline__ void operator()(int row, int col, f32x4 v0, f32x4 v1) const {
        if (col < 12288) { const int reg = col >> 12, cc = col & 4095; store8bf(RKV + (size_t)reg * ((size_t)NTOK * 4096) + (size_t)row * 4096 + cc, v0, v1); }
        else { const int cc = col - 12288; if (cc < 384) store8bf(P + (size_t)row * 384 + cc, v0, v1); } } };
struct F4 { u16* R;
    __device__ __forceinline__ void operator()(int row, int col, f32x4 v0, f32x4 v1) const {
        u16* d = R + (size_t)row * 4096 + col; const u32x4 w = *(const u32x4*)d; float y[8]; unpack8(w, y);
        f32x4 o0, o1;
#pragma unroll
        for (int j = 0; j < 4; ++j) { o0[j] = y[j] * siluf_(v0[j]); o1[j] = y[4 + j] * siluf_(v1[j]); }
        store8bf(d, o0, o1); } };

__device__ void tconv(unsigned char* smem, const float* src, int ldsrc, int col0, int N, int K, u16* dst, int ldd) {
    float* T = (float*)smem;
    const int tid = threadIdx.x, tilesN = N >> 6, ntile = tilesN * (K >> 6);
    const int lr = tid >> 4, lc = (tid & 15) * 4;
    const int sn = tid >> 3, sk = (tid & 7) * 8;
    int tile = blockIdx.x;
    f32x4 v0 = {0.f, 0.f, 0.f, 0.f}, v1 = {0.f, 0.f, 0.f, 0.f};
    if (tile < ntile) { const int tn = tile % tilesN, tk = tile / tilesN; const float* s = src + (size_t)(tk * 64 + lr) * ldsrc + col0 + tn * 64 + lc;
        v0 = __builtin_nontemporal_load((const f32x4*)s); v1 = __builtin_nontemporal_load((const f32x4*)(s + (size_t)32 * ldsrc)); }
    for (; tile < ntile; tile += gridDim.x) {
        const int tn = tile % tilesN, tk = tile / tilesN;
#pragma unroll
        for (int j = 0; j < 4; ++j) { T[lr * 65 + lc + j] = v0[j]; T[(lr + 32) * 65 + lc + j] = v1[j]; }
        asm volatile("s_waitcnt lgkmcnt(0)" ::: "memory"); __builtin_amdgcn_s_barrier(); asm volatile("" ::: "memory");
        const int nx = tile + gridDim.x;
        if (nx < ntile) { const int tn2 = nx % tilesN, tk2 = nx / tilesN; const float* s = src + (size_t)(tk2 * 64 + lr) * ldsrc + col0 + tn2 * 64 + lc;
            v0 = __builtin_nontemporal_load((const f32x4*)s); v1 = __builtin_nontemporal_load((const f32x4*)(s + (size_t)32 * ldsrc)); }
        float f[8];
#pragma unroll
        for (int j = 0; j < 8; ++j) f[j] = T[(sk + j) * 65 + sn];
        *(u32x4*)(dst + (size_t)(tn * 64 + sn) * ldd + tk * 64 + sk) = pack8(f);
        asm volatile("s_waitcnt lgkmcnt(0)" ::: "memory"); __builtin_amdgcn_s_barrier(); asm volatile("" ::: "memory");
    }
    __syncthreads();
}

template <int MODE> __device__ void rows_phase(const Params& p) {
    const int lane = threadIdx.x & 63, gw = blockIdx.x * 8 + (threadIdx.x >> 6), nw = gridDim.x * 8;
    const float* x = p.in[0];
    for (int row = gw; row < NTOK; row += nw) {
        if (MODE == 0) {
            f32x4 v[8]; float ss = 0.f;
#pragma unroll
            for (int i = 0; i < 8; ++i) { v[i] = __builtin_nontemporal_load((const f32x4*)(x + (size_t)row * DM + i * 256 + lane * 4)); ss += v[i][0] * v[i][0] + v[i][1] * v[i][1] + v[i][2] * v[i][2] + v[i][3] * v[i][3]; }
            ss = wave_sum(ss); const float r = rsqrtf(ss * (1.0f / DM) + 1e-6f);
            u16* H = (u16*)(p.ws + OFF_H);
#pragma unroll
            for (int i = 0; i < 8; ++i) { const int c = i * 256 + lane * 4; const f32x4 g = *(const f32x4*)(p.in[1] + c);
                u32x2 w; w.x = pk2(v[i][0] * r * g[0], v[i][1] * r * g[1]); w.y = pk2(v[i][2] * r * g[2], v[i][3] * r * g[3]); *(u32x2*)(H + (size_t)row * DM + c) = w; }
        } else {
            const u16* Mx = (const u16*)(p.ws + (MODE == 1 ? OFF_M0 : OFF_M1));
            const float* base = MODE == 1 ? x : p.out;
            const float* gpost = p.in[MODE == 1 ? 22 : 40];
            f32x4 m[8]; float ss = 0.f;
#pragma unroll
            for (int i = 0; i < 8; ++i) { const u32x2 w_ = __builtin_nontemporal_load((const u32x2*)(Mx + (size_t)row * DM + i * 256 + lane * 4)); m[i] = (f32x4){bflo(w_.x), bfhi(w_.x), bflo(w_.y), bfhi(w_.y)};
                ss += m[i][0] * m[i][0] + m[i][1] * m[i][1] + m[i][2] * m[i][2] + m[i][3] * m[i][3]; }
            ss = wave_sum(ss); const float r = rsqrtf(ss * (1.0f / DM) + 1e-6f);
            float ss1 = 0.f;
#pragma unroll
            for (int i = 0; i < 8; ++i) { const int c = i * 256 + lane * 4; const f32x4 g = *(const f32x4*)(gpost + c); const f32x4 b = __builtin_nontemporal_load((const f32x4*)(base + (size_t)row * DM + c));
                m[i] = b + m[i] * r * g; ss1 += m[i][0] * m[i][0] + m[i][1] * m[i][1] + m[i][2] * m[i][2] + m[i][3] * m[i][3];
                __builtin_nontemporal_store(m[i], (f32x4*)(p.out + (size_t)row * DM + c)); }
            if (MODE == 1) {
                ss1 = wave_sum(ss1); const float r1 = rsqrtf(ss1 * (1.0f / DM) + 1e-6f);
                u16* H = (u16*)(p.ws + OFF_H);
#pragma unroll
                for (int i = 0; i < 8; ++i) { const int c = i * 256 + lane * 4; const f32x4 g = *(const f32x4*)(p.in[23] + c);
                    u32x2 w; w.x = pk2(m[i][0] * r1 * g[0], m[i][1] * r1 * g[1]); w.y = pk2(m[i][2] * r1 * g[2], m[i][3] * r1 * g[3]); *(u32x2*)(H + (size_t)row * DM + c) = w; }
            }
        }
    }
}

__device__ void prep_small(const Params& p) {
    const int gt = blockIdx.x * 512 + threadIdx.x, nt = gridDim.x * 512;
    u16* LW = (u16*)(p.ws + OFF_LRUW);
    for (int e = gt; e < 2 * 16 * 128 * 128; e += nt) { const int i = e & 127, j = (e >> 7) & 127, blk = (e >> 14) & 15, g = e >> 18;
        LW[e] = f2bf(p.in[g ? 7 : 5][(size_t)(blk * 128 + i) * 128 + j]); }
    u16* WG = (u16*)(p.ws + OFF_WGT);
    for (int e = gt; e < 16 * 6144; e += nt) { const int c = e % 6144, n = e / 6144; WG[e] = f2bf(n < 8 ? p.in[15][c * 8 + n] : p.in[17][c * 8 + n - 8]); }
}
__device__ void prep_extras(const Params& p) {
    const int gt = blockIdx.x * 512 + threadIdx.x, nt = gridDim.x * 512;
    u16* W = (u16*)(p.ws + OFF_W1) + (size_t)12288 * 2048;
    for (int e = gt; e < 512 * 2048; e += nt) { const int k = e & 2047, n = e >> 11; float v = 0.f;
        if (n < 96) v = (1.f - p.in[26][k]) * p.in[29][k * 96 + n];
        else if (n < 192) v = p.in[26][k] * p.in[29][k * 96 + n - 96];
        else if (n < 288) v = (1.f - p.in[27][k]) * p.in[32][k * 96 + n - 192];
        else if (n < 384) v = p.in[27][k] * p.in[32][k * 96 + n - 288];
        W[e] = f2bf(v); }
}

#define LBAR0() do { asm volatile("s_waitcnt lgkmcnt(0)" ::: "memory"); __builtin_amdgcn_s_barrier(); asm volatile("" ::: "memory"); } while (0)
__device__ __forceinline__ float fsig0(float x) { return __builtin_amdgcn_rcpf(1.0f + __expf(-x)); }
template <int PASS> __device__ void lru_phase(const Params& p, unsigned char* smem) {
    float* xcf = (float*)smem;
    float* As = xcf + 64 * 132;
    float* Us = As + 64 * 132;
    float* qA = Us + 64 * 132;
    float* qH = qA + 512;
    const int tid = threadIdx.x, lane = tid & 63, wave = __builtin_amdgcn_readfirstlane(tid >> 6);
    const u16* XR = (const u16*)(p.ws + OFF_XR);
    u16* Y0 = (u16*)(p.ws + OFF_Y0);
    const u16* LW = (const u16*)(p.ws + OFF_LRUW);
    float* LA = (float*)(p.ws + OFF_LRUA); float* LH = (float*)(p.ws + OFF_LRUH); const float* LC = (const float*)(p.ws + OFF_LRUC);
    const float* cw = p.in[3]; const float* cb = p.in[4];
    u32x4 craw[2][4];
#define LRU_CLOAD(tl_) do { const int jb_ = (tl_) & 15, c_ = ((tl_) >> 4) & 63, b_ = (tl_) >> 10; \
        _Pragma("unroll") for (int it = 0; it < 2; ++it) { const int t_ = (tid >> 4) + 32 * it, ch_ = jb_ * 128 + (tid & 15) * 8; \
            _Pragma("unroll") for (int j = 0; j < 4; ++j) { const int s_ = c_ * 64 + t_ - 3 + j; \
                craw[it][j] = (s_ >= 0) ? *(const u32x4*)(XR + (size_t)(b_ * SEQL + s_) * 2048 + ch_) : (u32x4){0u, 0u, 0u, 0u}; } } } while (0)
    if ((int)blockIdx.x < 4096) LRU_CLOAD((int)blockIdx.x);
    const bool jb_fixed = (gridDim.x & 15) == 0;
    bf16x8 hba[4], hbx[4]; float hb_a = 0.f, hb_x = 0.f, hsp = 0.f;
    if (jb_fixed) { const int jb0 = blockIdx.x & 15, cg0 = jb0 * 128 + 16 * wave + (lane & 15);
#pragma unroll
        for (int ks = 0; ks < 4; ++ks) { const size_t wo = (size_t)((jb0 * 128 + 16 * wave + (lane & 15)) * 128 + ks * 32 + 8 * (lane >> 4));
            hba[ks] = *(const bf16x8*)(LW + wo); hbx[ks] = *(const bf16x8*)(LW + (size_t)16 * 128 * 128 + wo); }
        hb_a = p.in[6][cg0]; hb_x = p.in[8][cg0]; hsp = softplusf_(-p.in[9][cg0]); }
    for (int tile = blockIdx.x; tile < 4096; tile += gridDim.x) {
        const int jb = tile & 15, c = (tile >> 4) & 63, b = tile >> 10;
        const int row0 = b * SEQL + c * 64;
        u16 zpre[16];
        if (PASS == 2) {
#pragma unroll
            for (int tt = 0; tt < 16; ++tt) zpre[tt] = Y0[(size_t)(row0 + (tid >> 7) * 16 + tt) * 4096 + jb * 128 + (tid & 127)];
        }
#pragma unroll
        for (int it = 0; it < 2; ++it) {
            const int t = (tid >> 4) + 32 * it, c8 = (tid & 15) * 8, ch = jb * 128 + c8;
            float acc[8];
            { const f32x4 b0 = *(const f32x4*)(cb + ch), b1 = *(const f32x4*)(cb + ch + 4);
#pragma unroll
              for (int i = 0; i < 4; ++i) { acc[i] = b0[i]; acc[4 + i] = b1[i]; } }
#pragma unroll
            for (int j = 0; j < 4; ++j) { float xv[8]; unpack8(craw[it][j], xv);
                const f32x4 w0 = *(const f32x4*)(cw + j * 2048 + ch), w1 = *(const f32x4*)(cw + j * 2048 + ch + 4);
#pragma unroll
                for (int i = 0; i < 4; ++i) { acc[i] += w0[i] * xv[i]; acc[4 + i] += w1[i] * xv[4 + i]; } }
            *(f32x4*)(xcf + t * 132 + c8) = (f32x4){acc[0], acc[1], acc[2], acc[3]}; *(f32x4*)(xcf + t * 132 + c8 + 4) = (f32x4){acc[4], acc[5], acc[6], acc[7]};
        }
        if (tile + (int)gridDim.x < 4096) LRU_CLOAD(tile + (int)gridDim.x);
        LBAR0();
        f32x4 accA[4], accX[4];
#pragma unroll
        for (int m = 0; m < 4; ++m) { accA[m] = (f32x4){0.f, 0.f, 0.f, 0.f}; accX[m] = (f32x4){0.f, 0.f, 0.f, 0.f}; }
#pragma unroll
        for (int ks = 0; ks < 4; ++ks) {
            const size_t wo = (size_t)((jb * 128 + 16 * wave + (lane & 15)) * 128 + ks * 32 + 8 * (lane >> 4));
            const bf16x8 ba = jb_fixed ? hba[ks] : *(const bf16x8*)(LW + wo), bx = jb_fixed ? hbx[ks] : *(const bf16x8*)(LW + (size_t)16 * 128 * 128 + wo);
#pragma unroll
            for (int m = 0; m < 4; ++m) { const float* s = xcf + (16 * m + (lane & 15)) * 132 + ks * 32 + 8 * (lane >> 4);
                const f32x4 lo = *(const f32x4*)s, hi = *(const f32x4*)(s + 4); float f[8] = {lo[0], lo[1], lo[2], lo[3], hi[0], hi[1], hi[2], hi[3]};
                const bf16x8 af = as_frag(pack8(f));
                accA[m] = MFMA16(af, ba, accA[m]); accX[m] = MFMA16(af, bx, accX[m]); }
        }
        {
            const int ch = 16 * wave + (lane & 15), cgl = jb * 128 + ch;
            const float ba_ = jb_fixed ? hb_a : p.in[6][cgl], bx_ = jb_fixed ? hb_x : p.in[8][cgl], sp = jb_fixed ? hsp : softplusf_(-p.in[9][cgl]);
#pragma unroll
            for (int m = 0; m < 4; ++m)
#pragma unroll
                for (int r = 0; r < 4; ++r) { const int t = 16 * m + 4 * (lane >> 4) + r;
                    const float rg = fsig0(accA[m][r] + ba_), ig = fsig0(accX[m][r] + bx_);
                    const float la = -8.0f * rg * sp, a = __expf(la), u = __builtin_amdgcn_sqrtf(fmaxf(1.0f - a * a, 0.f)) * (ig * xcf[t * 132 + ch]);
                    As[t * 132 + ch] = a; Us[t * 132 + ch] = u; }
        }
        LBAR0();
        const int ch = tid & 127, q = tid >> 7, cgl = jb * 128 + ch;
        { float h = 0.f, A = 1.f;
#pragma unroll
          for (int tt = 0; tt < 16; ++tt) { const int t = q * 16 + tt; const float a = As[t * 132 + ch], u = Us[t * 132 + ch]; h = a * h + u; A *= a;
              if (PASS == 2) { Us[t * 132 + ch] = h; As[t * 132 + ch] = A; } }
          qA[q * 128 + ch] = A; qH[q * 128 + ch] = h; }
        LBAR0();
        if (PASS == 1) {
            if (q == 0) { float h = 0.f, A = 1.f;
#pragma unroll
                for (int qq = 0; qq < 4; ++qq) { h = qA[qq * 128 + ch] * h + qH[qq * 128 + ch]; A *= qA[qq * 128 + ch]; }
                LA[(size_t)(b * 64 + c) * 2048 + cgl] = A; LH[(size_t)(b * 64 + c) * 2048 + cgl] = h; }
        } else {
            float carry = LC[(size_t)(b * 64 + c) * 2048 + cgl];
            for (int qq = 0; qq < q; ++qq) carry = qA[qq * 128 + ch] * carry + qH[qq * 128 + ch];
#pragma unroll
            for (int tt = 0; tt < 16; ++tt) { const int t = q * 16 + tt; const float hh = Us[t * 132 + ch] + As[t * 132 + ch] * carry; const float z = bf2f(zpre[tt]);
                Y0[(size_t)(row0 + t) * 4096 + cgl] = f2bf(hh * z * fsig0(z)); }
        }
        LBAR0();
    }
}
__device__ void lru_carry(const Params& p) {
    const float* LA = (const float*)(p.ws + OFF_LRUA); const float* LH = (const float*)(p.ws + OFF_LRUH); float* LC = (float*)(p.ws + OFF_LRUC);
    for (int idx = blockIdx.x * 512 + threadIdx.x; idx < 4 * 2048; idx += gridDim.x * 512) { const int b = idx >> 11, cg_ = idx & 2047; float c = 0.f;
#pragma unroll 8
        for (int k = 0; k < 64; ++k) { const size_t o = (size_t)(b * 64 + k) * 2048 + cg_; LC[o] = c; c = LA[o] * c + LH[o]; } }
}

__device__ void mqk_phase(const Params& p, unsigned char* smem) {
    float* red = (float*)smem;
    const int tid = threadIdx.x, lane = tid & 63, wave = __builtin_amdgcn_readfirstlane(tid >> 6);
    const u16* XM = (const u16*)(p.ws + OFF_XM); u16* Q = (u16*)(p.ws + OFF_Q); u16* KX = (u16*)(p.ws + OFF_KX);
    const u16* WG = (const u16*)(p.ws + OFF_WGT); float* G = (float*)(p.ws + OFF_G);
    for (int tile = blockIdx.x; tile < 256; tile += gridDim.x) {
        const int row0 = tile * 64;
        f32x4 acc[4];
#pragma unroll
        for (int m = 0; m < 4; ++m) acc[m] = (f32x4){0.f, 0.f, 0.f, 0.f};
        for (int ks = 0; ks < 8; ++ks) {
            const int c0 = 256 * wave + 32 * ks + 8 * (lane >> 4);
            float cw[4][8], cbv[8];
#pragma unroll
            for (int j = 0; j < 4; ++j) { const f32x4 a = *(const f32x4*)(p.in[10] + j * 2048 + c0), b = *(const f32x4*)(p.in[10] + j * 2048 + c0 + 4);
#pragma unroll
                for (int i = 0; i < 4; ++i) { cw[j][i] = a[i]; cw[j][4 + i] = b[i]; } }
            { const f32x4 a = *(const f32x4*)(p.in[11] + c0), b = *(const f32x4*)(p.in[11] + c0 + 4);
#pragma unroll
              for (int i = 0; i < 4; ++i) { cbv[i] = a[i]; cbv[4 + i] = b[i]; } }
            const bf16x8 bq = *(const bf16x8*)(WG + (size_t)(lane & 15) * 6144 + c0), bk = *(const bf16x8*)(WG + (size_t)(lane & 15) * 6144 + 2048 + c0), bv = *(const bf16x8*)(WG + (size_t)(lane & 15) * 6144 + 4096 + c0);
            const float* wqp = p.in[12] + (size_t)(c0 >> 2) * 16; const float* wkp = p.in[13] + (size_t)(c0 >> 2) * 16; const float* wvp = p.in[14] + (size_t)(c0 >> 2) * 16;
            u32x4 xraw[4];
#define MQ_LOAD(dst, mm) do { const int tk_ = row0 + 16 * (mm) + (lane & 15), s_ = tk_ & (SEQL - 1); \
                _Pragma("unroll") for (int j = 0; j < 4; ++j) dst[j] = (s_ - 3 + j >= 0) ? *(const u32x4*)(XM + (size_t)(tk_ - 3 + j) * 2048 + c0) : (u32x4){0u, 0u, 0u, 0u}; } while (0)
            MQ_LOAD(xraw, 0);
#pragma unroll
            for (int m = 0; m < 4; ++m) {
                const int tk = row0 + 16 * m + (lane & 15);
                u32x4 xnx[4];
                if (m < 3) MQ_LOAD(xnx, m + 1);
                float xmc[8], xcur[8];
#pragma unroll
                for (int i = 0; i < 8; ++i) xmc[i] = cbv[i];
#pragma unroll
                for (int j = 0; j < 4; ++j) { float xv[8]; unpack8(xraw[j], xv);
#pragma unroll
                    for (int i = 0; i < 8; ++i) { xmc[i] += cw[j][i] * xv[i]; if (j == 3) xcur[i] = xv[i]; } }
                if (m < 3) {
#pragma unroll
                    for (int j = 0; j < 4; ++j) xraw[j] = xnx[j]; }
#pragma unroll
                for (int i = 0; i < 8; ++i) xmc[i] = xmc[i] * fsig0(xmc[i]);
                float qv[8], kv[8], vv[8];
#pragma unroll
                for (int bb = 0; bb < 2; ++bb)
#pragma unroll
                    for (int jj = 0; jj < 4; ++jj) { float aq = 0.f, ak = 0.f, av = 0.f;
#pragma unroll
                        for (int ii = 0; ii < 4; ++ii) { aq += xmc[4 * bb + ii] * wqp[bb * 16 + ii * 4 + jj]; ak += xmc[4 * bb + ii] * wkp[bb * 16 + ii * 4 + jj]; av += xcur[4 * bb + ii] * wvp[bb * 16 + ii * 4 + jj]; }
                        qv[4 * bb + jj] = aq; kv[4 * bb + jj] = ak; vv[4 * bb + jj] = av; }
                const u32x4 qw = pack8(qv), kw = pack8(kv), vw = pack8(vv);
                acc[m] = MFMA16(as_frag(qw), bq, acc[m]); acc[m] = MFMA16(as_frag(kw), bk, acc[m]); acc[m] = MFMA16(as_frag(vw), bv, acc[m]);
#pragma unroll
                for (int i = 0; i < 8; ++i) kv[i] *= 0.0625f;
                *(u32x4*)(Q + (size_t)tk * 2048 + c0) = qw; *(u32x4*)(KX + (size_t)tk * 2048 + c0) = pack8(kv);
            }
        }
#pragma unroll
        for (int m = 0; m < 4; ++m)
#pragma unroll
            for (int r = 0; r < 4; ++r) red[(wave * 64 + 16 * m + 4 * (lane >> 4) + r) * 16 + (lane & 15)] = acc[m][r];
        __syncthreads();
        for (int e = tid; e < 1024; e += 512) { const int tok = e >> 4, n = e & 15; float s = (n < 8) ? p.in[16][n] : p.in[18][n - 8];
#pragma unroll
            for (int w = 0; w < 8; ++w) s += red[(w * 64 + tok) * 16 + n];
            G[(size_t)(row0 + tok) * 16 + n] = s; }
        __syncthreads();
    }
}

__device__ void mlstm_phase(const Params& p, unsigned char* smem) {
    u16* Ks = (u16*)smem;
    u16* Vt = Ks + 128 * 264;
    u16* Vwt = Vt + 48 * 136;
    u16* Ps = Vwt + 48 * 136;
    u16* Ct = Ps + 128 * 136;
    float* gc = (float*)(Ct + 48 * 264);
    float* gM = gc + 128; float* gE = gM + 128; float* gF = gE + 128; float* gW = gF + 128; float* gS = gW + 128;
    const int tid = threadIdx.x, lane = tid & 63, wave = __builtin_amdgcn_readfirstlane(tid >> 6);
    const int l15 = lane & 15, lq = lane >> 4;
    const u16* XM = (const u16*)(p.ws + OFF_XM); const u16* Q = (const u16*)(p.ws + OFF_Q); const u16* KX = (const u16*)(p.ws + OFF_KX);
    const float* G = (const float*)(p.ws + OFF_G); u16* Hm = (u16*)(p.ws + OFF_H);
    for (int unit = blockIdx.x; unit < 256; unit += gridDim.x) {
        int sl = unit & 7, bh_ = unit >> 3;
        if (gridDim.x == 256) { const int xcd_ = unit & 7, j_ = unit >> 3; bh_ = xcd_ * 4 + (j_ >> 3); sl = j_ & 7; }
        const int h = bh_ & 7, b = bh_ >> 3;
        f32x4 accC[3][2];
#pragma unroll
        for (int a = 0; a < 3; ++a)
#pragma unroll
            for (int c = 0; c < 2; ++c) accC[a][c] = (f32x4){0.f, 0.f, 0.f, 0.f};
        float m_prev = 0.f;
        for (int e = tid; e < 16 * 136; e += 512) { const int r = e / 136; Vt[32 * 136 + e] = (r == 0) ? (u16)0x3F80 : (u16)0; Vwt[32 * 136 + e] = 0; }
        for (int e = tid; e < 48 * 264; e += 512) Ct[e] = 0;
        const int vc = 256 * h + 32 * sl + 4 * (tid & 7);
        const float* wvp = p.in[14] + (size_t)(vc >> 2) * 16;
        __syncthreads();
        for (int chunk = 0; chunk < 32; ++chunk) {
            const int row0 = b * SEQL + chunk * 128;
#pragma unroll
            for (int i = 0; i < 8; ++i) { const int idx = tid + 512 * i, r = idx >> 5, cc = (idx & 31) * 8;
                *(u32x4*)(Ks + r * 264 + cc) = *(const u32x4*)(KX + (size_t)(row0 + r) * 2048 + 256 * h + cc); }
            bf16x8 qf[8];
#pragma unroll
            for (int ks = 0; ks < 8; ++ks) qf[ks] = *(const bf16x8*)(Q + (size_t)(row0 + 16 * wave + l15) * 2048 + 256 * h + 32 * ks + 8 * lq);
            float vv[2][4];
#pragma unroll
            for (int i = 0; i < 2; ++i) { const int t = (tid + 512 * i) >> 3; const u32x2 raw = *(const u32x2*)(XM + (size_t)(row0 + t) * 2048 + vc);
                const float x0 = bflo(raw.x), x1 = bfhi(raw.x), x2 = bflo(raw.y), x3 = bfhi(raw.y);
#pragma unroll
                for (int jj = 0; jj < 4; ++jj) vv[i][jj] = x0 * wvp[jj] + x1 * wvp[4 + jj] + x2 * wvp[8 + jj] + x3 * wvp[12 + jj]; }
            if (wave == 0) {
                const int t0 = 2 * lane;
                const float ig0 = G[(size_t)(row0 + t0) * 16 + h], fg0 = G[(size_t)(row0 + t0) * 16 + 8 + h];
                const float ig1 = G[(size_t)(row0 + t0 + 1) * 16 + h], fg1 = G[(size_t)(row0 + t0 + 1) * 16 + 8 + h];
                const float lf0 = -softplusf_(-fg0), lf1 = -softplusf_(-fg1);
                float s = lf0 + lf1;
#pragma unroll
                for (int d = 1; d < 64; d <<= 1) { const float o = __shfl_up(s, d); if (lane >= d) s += o; }
                const float b1 = s, b0 = s - lf1;
                const float c0 = ig0 - b0, c1 = ig1 - b1;
                float mx = fmaxf(c0, c1);
#pragma unroll
                for (int d = 1; d < 64; d <<= 1) { const float o = __shfl_up(mx, d); if (lane >= d) mx = fmaxf(mx, o); }
                float pm = __shfl_up(mx, 1); if (lane == 0) pm = -3.0e38f;
                const float M0 = fmaxf(fmaxf(pm, c0), m_prev), M1 = fmaxf(mx, m_prev);
                const float Ml = __shfl(M1, 63), bL = __shfl(b1, 63);
                gc[t0] = c0; gc[t0 + 1] = c1; gM[t0] = M0; gM[t0 + 1] = M1;
                gE[t0] = __expf(m_prev - M0); gE[t0 + 1] = __expf(m_prev - M1);
                gF[t0] = __expf(-(b0 + M0)); gF[t0 + 1] = __expf(-(b1 + M1));
                gW[t0] = __expf(c0 - Ml); gW[t0 + 1] = __expf(c1 - Ml);
                if (lane == 0) gS[0] = __expf(m_prev - Ml);
                m_prev = bL + Ml;
            }
            LBAR0();
#pragma unroll
            for (int i = 0; i < 2; ++i) { const int t = (tid + 512 * i) >> 3; const float w = gW[t];
#pragma unroll
                for (int jj = 0; jj < 4; ++jj) { const int dv = 4 * (tid & 7) + jj; Vt[dv * 136 + t] = f2bf(vv[i][jj]); Vwt[dv * 136 + t] = f2bf(vv[i][jj] * w); } }
            if (tid < 128) Vwt[32 * 136 + tid] = f2bf(gW[tid]);
            f32x4 accS[8];
#pragma unroll
            for (int n = 0; n < 8; ++n) { accS[n] = (f32x4){0.f, 0.f, 0.f, 0.f};
                if (n <= wave) {
#pragma unroll
                    for (int ks = 0; ks < 8; ++ks) { const bf16x8 kf = *(const bf16x8*)(Ks + (16 * n + l15) * 264 + 32 * ks + 8 * lq); accS[n] = MFMA16(qf[ks], kf, accS[n]); } } }
#pragma unroll
            for (int n = 0; n < 8; ++n) if (n <= (wave | 1)) { const int s = 16 * n + l15; const float cs = gc[s];
#pragma unroll
                for (int r = 0; r < 4; ++r) { const int t = 16 * wave + 4 * lq + r; const float val = (n <= wave && s <= t) ? accS[n][r] * __expf(cs - gM[t]) : 0.f; Ps[t * 136 + s] = f2bf(val); } }
            LBAR0();
            f32x4 oi[3], oc[3];
#pragma unroll
            for (int nt = 0; nt < 3; ++nt) { oi[nt] = (f32x4){0.f, 0.f, 0.f, 0.f}; oc[nt] = (f32x4){0.f, 0.f, 0.f, 0.f}; }
#pragma unroll
            for (int kk = 0; kk < 4; ++kk) if (kk <= (wave >> 1)) { const bf16x8 pf = *(const bf16x8*)(Ps + (16 * wave + l15) * 136 + 32 * kk + 8 * lq);
#pragma unroll
                for (int nt = 0; nt < 3; ++nt) { const bf16x8 vf = *(const bf16x8*)(Vt + (16 * nt + l15) * 136 + 32 * kk + 8 * lq); oi[nt] = MFMA16(pf, vf, oi[nt]); } }
#pragma unroll
            for (int ks = 0; ks < 8; ++ks)
#pragma unroll
                for (int nt = 0; nt < 3; ++nt) { const bf16x8 cf = *(const bf16x8*)(Ct + (16 * nt + l15) * 264 + 32 * ks + 8 * lq); oc[nt] = MFMA16(qf[ks], cf, oc[nt]); }
#pragma unroll
            for (int r = 0; r < 4; ++r) { const int t = 16 * wave + 4 * lq + r; const float E = gE[t], F = gF[t];
                float den = oi[2][r] + E * oc[2][r]; den = __shfl(den, lane & 48);
                const float inv = 1.0f / fmaxf(fabsf(den), F);
#pragma unroll
                for (int nt = 0; nt < 2; ++nt) Hm[(size_t)(row0 + t) * 2048 + 256 * h + 32 * sl + 16 * nt + l15] = f2bf((oi[nt][r] + E * oc[nt][r]) * inv); }
            { const float decay = gS[0];
#pragma unroll
              for (int a = 0; a < 3; ++a)
#pragma unroll
                for (int c = 0; c < 2; ++c) accC[a][c] = accC[a][c] * decay; }
#pragma unroll
            for (int kk = 0; kk < 4; ++kk) {
                bf16x8 ktf[2];
#pragma unroll
                for (int ntk = 0; ntk < 2; ++ntk) { const int dk = 32 * wave + 16 * ntk + l15;
#pragma unroll
                    for (int j = 0; j < 8; ++j) ktf[ntk][j] = (short)Ks[(32 * kk + 8 * lq + j) * 264 + dk]; }
#pragma unroll
                for (int mt = 0; mt < 3; ++mt) { const bf16x8 vwf = *(const bf16x8*)(Vwt + (16 * mt + l15) * 136 + 32 * kk + 8 * lq);
#pragma unroll
                    for (int ntk = 0; ntk < 2; ++ntk) accC[mt][ntk] = MFMA16(vwf, ktf[ntk], accC[mt][ntk]); }
            }
            LBAR0();
#pragma unroll
            for (int mt = 0; mt < 3; ++mt)
#pragma unroll
                for (int ntk = 0; ntk < 2; ++ntk)
#pragma unroll
                    for (int r = 0; r < 4; ++r) Ct[(16 * mt + 4 * lq + r) * 264 + 32 * wave + 16 * ntk + l15] = f2bf(accC[mt][ntk][r]);
        }
        __syncthreads();
    }
}

__device__ void mnorm_phase(const Params& p) {
    const int lane = threadIdx.x & 63, wave = threadIdx.x >> 6;
    const u16* XM = (const u16*)(p.ws + OFF_XM); const u16* Hm = (const u16*)(p.ws + OFF_H); u16* Y0 = (u16*)(p.ws + OFF_Y0);
    const int c = 256 * wave + 4 * lane;
    float cw[4][4];
#pragma unroll
    for (int j = 0; j < 4; ++j) { const f32x4 a = *(const f32x4*)(p.in[10] + j * 2048 + c);
#pragma unroll
        for (int i = 0; i < 4; ++i) cw[j][i] = a[i]; }
    const f32x4 cbv = *(const f32x4*)(p.in[11] + c), skip = *(const f32x4*)(p.in[19] + c), gn = *(const f32x4*)(p.in[20] + c);
    for (int blk = blockIdx.x; blk < 256; blk += gridDim.x) {
        u32x2 hr, xr[4], zr;
#define MN_LOAD(tk_) do { const int s_ = (tk_) & (SEQL - 1); hr = *(const u32x2*)(Hm + (size_t)(tk_) * 2048 + c); zr = *(const u32x2*)(Y0 + (size_t)(tk_) * 4096 + 2048 + c); \
            _Pragma("unroll") for (int j = 0; j < 4; ++j) xr[j] = (s_ - 3 + j >= 0) ? *(const u32x2*)(XM + (size_t)((tk_) - 3 + j) * 2048 + c) : (u32x2){0u, 0u}; } while (0)
        MN_LOAD(blk * 64);
#pragma unroll 2
        for (int tt = 0; tt < 64; ++tt) {
            const int tk = blk * 64 + tt;
            const u32x2 hc_ = hr, zc_ = zr; const u32x2 xc0 = xr[0], xc1 = xr[1], xc2 = xr[2], xc3 = xr[3];
            if (tt < 63) MN_LOAD(tk + 1);
            float hv[4] = {bflo(hc_.x), bfhi(hc_.x), bflo(hc_.y), bfhi(hc_.y)};
            const float mu = wave_sum_dpp(hv[0] + hv[1] + hv[2] + hv[3]) * (1.0f / 256.0f);
            float d[4], sq = 0.f;
#pragma unroll
            for (int i = 0; i < 4; ++i) { d[i] = hv[i] - mu; sq += d[i] * d[i]; }
            const float rs = rsqrtf(wave_sum_dpp(sq) * (1.0f / 256.0f) + 1e-6f);
            float xmc[4] = {cbv[0], cbv[1], cbv[2], cbv[3]};
            const u32x2 xs[4] = {xc0, xc1, xc2, xc3};
#pragma unroll
            for (int j = 0; j < 4; ++j) { xmc[0] += cw[j][0] * bflo(xs[j].x); xmc[1] += cw[j][1] * bfhi(xs[j].x); xmc[2] += cw[j][2] * bflo(xs[j].y); xmc[3] += cw[j][3] * bfhi(xs[j].y); }
            const float z[4] = {bflo(zc_.x), bfhi(zc_.x), bflo(zc_.y), bfhi(zc_.y)};
            float o[4];
#pragma unroll
            for (int i = 0; i < 4; ++i) o[i] = (d[i] * rs * gn[i] + skip[i] * xmc[i] * fsig0(xmc[i])) * z[i] * fsig0(z[i]);
            u32x2 w; w.x = pk2(o[0], o[1]); w.y = pk2(o[2], o[3]); *(u32x2*)(Y0 + (size_t)tk * 4096 + 2048 + c) = w;
        }
#undef MN_LOAD
    }
}

__device__ __forceinline__ float fsigmoid(float x) { return __builtin_amdgcn_rcpf(1.0f + __expf(-x)); }
__device__ __forceinline__ float ftanh(float x) { return 1.0f - 2.0f * __builtin_amdgcn_rcpf(1.0f + __expf(2.0f * x)); }
__device__ __forceinline__ float row16_sum(float v) { v += dppf<0xB1>(v); v += dppf<0x4E>(v); v += dppf<0x141>(v); v += dppf<0x140>(v); return v; }
#define LBAR() do { asm volatile("s_waitcnt lgkmcnt(0)" ::: "memory"); __builtin_amdgcn_s_barrier(); asm volatile("" ::: "memory"); } while (0)
struct RwStep { f32x4 d0, d1, a0, a1, b0, b1, k0, k1, w0, w1; float v0, v1; f32x2 sc; };
__device__ __forceinline__ RwStep rw_load(const float* vb, const float* vrow, const float* sb) {
    RwStep s;
    s.d0 = *(const f32x4*)vb; s.d1 = *(const f32x4*)(vb + 4); s.a0 = *(const f32x4*)(vb + 64); s.a1 = *(const f32x4*)(vb + 68);
    s.b0 = *(const f32x4*)(vb + 128); s.b1 = *(const f32x4*)(vb + 132); s.k0 = *(const f32x4*)(vb + 192); s.k1 = *(const f32x4*)(vb + 196);
    s.w0 = *(const f32x4*)(vb + 256); s.w1 = *(const f32x4*)(vb + 260);
    s.v0 = vrow[320]; s.v1 = vrow[352]; s.sc = *(const f32x2*)sb;
    return s;
}
__device__ void rwkv_phase(const Params& p, unsigned char* smem) {
    constexpr int TC = 16, NCH = SEQL / TC;
    u16* W2t = (u16*)smem;
    u16* A2t = W2t + 64 * 104;
    float* vec = (float*)(A2t + 64 * 104);
    float* scal = vec + 2 * TC * 384;
    float* Yraw = scal + 2 * TC * 4;
    u16* raw = (u16*)(Yraw + 2 * TC * 64);
    u16* twa = raw + 3 * 17 * 64;
    const int tid = threadIdx.x, lane = tid & 63, wave = __builtin_amdgcn_readfirstlane(tid >> 6);
    const int l15 = lane & 15, lq = lane >> 4;
    u16* R = (u16*)(p.ws + OFF_R); const u16* Kb = (const u16*)(p.ws + OFF_KK); const u16* Vb = (const u16*)(p.ws + OFF_V); const u16* P = (const u16*)(p.ws + OFF_P);
    for (int unit = blockIdx.x; unit < 256; unit += gridDim.x) {
        const int b = unit >> 6, h = unit & 63, hc = 64 * h;
        for (int e = tid; e < 6144; e += 512) { const int j = e >> 6, k = e & 63; W2t[k * 104 + j] = f2bf(p.in[30][(size_t)j * 4096 + hc + k]); A2t[k * 104 + j] = f2bf(p.in[33][(size_t)j * 4096 + hc + k]); }
        __syncthreads();
        if (wave < 4) {
            const int rp = tid >> 3, j8 = tid & 7;
            f32x2 S0[4], S1[4];
#pragma unroll
            for (int i = 0; i < 4; ++i) { S0[i] = (f32x2){0.f, 0.f}; S1[i] = (f32x2){0.f, 0.f}; }
            for (int pc = -1; pc <= NCH; ++pc) {
                const bool act = (pc >= 0 && pc < NCH);
                const float* vbase = vec + (pc & 1) * TC * 384;
                const float* sbase = scal + (pc & 1) * TC * 4;
                float* ybase = Yraw + (pc & 1) * TC * 64;
#pragma unroll 1
                for (int q = 0; q < 2; ++q) {
                    if (act) {
                        RwStep cur = rw_load(vbase + (8 * q) * 384 + 8 * j8, vbase + (8 * q) * 384 + rp, sbase + (8 * q) * 4);
#pragma unroll
                        for (int tt = 0; tt < 8; ++tt) {
                            const int t = 8 * q + tt;
                            RwStep nxt = cur;
                            if (tt < 7) nxt = rw_load(vbase + (t + 1) * 384 + 8 * j8, vbase + (t + 1) * 384 + rp, sbase + (t + 1) * 4);
                            __builtin_amdgcn_sched_barrier(0);
                            const f32x2 av[4] = {{cur.a0[0], cur.a0[1]}, {cur.a0[2], cur.a0[3]}, {cur.a1[0], cur.a1[1]}, {cur.a1[2], cur.a1[3]}};
                            const f32x2 wv[4] = {{cur.w0[0], cur.w0[1]}, {cur.w0[2], cur.w0[3]}, {cur.w1[0], cur.w1[1]}, {cur.w1[2], cur.w1[3]}};
                            const f32x2 dv[4] = {{cur.d0[0], cur.d0[1]}, {cur.d0[2], cur.d0[3]}, {cur.d1[0], cur.d1[1]}, {cur.d1[2], cur.d1[3]}};
                            const f32x2 bv[4] = {{cur.b0[0], cur.b0[1]}, {cur.b0[2], cur.b0[3]}, {cur.b1[0], cur.b1[1]}, {cur.b1[2], cur.b1[3]}};
                            const f32x2 kv[4] = {{cur.k0[0], cur.k0[1]}, {cur.k0[2], cur.k0[3]}, {cur.k1[0], cur.k1[1]}, {cur.k1[2], cur.k1[3]}};
                            f32x2 q1 = S0[0] * av[0], q2 = S0[0] * wv[0], q3 = S1[0] * av[0], q4 = S1[0] * wv[0];
#pragma unroll
                            for (int i = 1; i < 4; ++i) { q1 += S0[i] * av[i]; q2 += S0[i] * wv[i]; q3 += S1[i] * av[i]; q4 += S1[i] * wv[i]; }
                            float p1 = q1.x + q1.y, p2 = q2.x + q2.y, p3 = q3.x + q3.y, p4 = q4.x + q4.y;
                            p1 += dppf<0xB1>(p1); p2 += dppf<0xB1>(p2); p3 += dppf<0xB1>(p3); p4 += dppf<0xB1>(p4);
                            p1 += dppf<0x4E>(p1); p2 += dppf<0x4E>(p2); p3 += dppf<0x4E>(p3); p4 += dppf<0x4E>(p4);
                            p1 += dppf<0x141>(p1); p2 += dppf<0x141>(p2); p3 += dppf<0x141>(p3); p4 += dppf<0x141>(p4);
                            { const float y0 = p2 + p1 * cur.sc.x + cur.v0 * cur.sc.y, y1 = p4 + p3 * cur.sc.x + cur.v1 * cur.sc.y;
                              if (j8 == 0) { ybase[t * 64 + rp] = y0; ybase[t * 64 + 32 + rp] = y1; } }
                            const f32x2 sa0 = {p1, p1}, sa1 = {p3, p3}, vv0 = {cur.v0, cur.v0}, vv1 = {cur.v1, cur.v1};
#pragma unroll
                            for (int i = 0; i < 4; ++i) { S0[i] = (S0[i] * dv[i] + vv0 * kv[i]) + sa0 * bv[i]; S1[i] = (S1[i] * dv[i] + vv1 * kv[i]) + sa1 * bv[i]; }
                            cur = nxt;
                        }
                    }
                    LBAR();
                }
            }
        } else {
            const int w4 = wave - 4, ptid = tid - 256, tl = 4 * lq + w4;
            float mu_r[4], mu_k[4], mu_v[4], w0k[4], a0k[4], kkk[4], kak[4], rkk[4], gng[4], gnb[4];
#pragma unroll
            for (int nt = 0; nt < 4; ++nt) { const int k = hc + 16 * nt + l15;
                mu_r[nt] = p.in[25][k]; mu_k[nt] = p.in[25][4096 + k]; mu_v[nt] = p.in[25][8192 + k];
                w0k[nt] = p.in[28][k]; a0k[nt] = p.in[31][k]; kkk[nt] = p.in[34][k]; kak[nt] = p.in[35][k]; rkk[nt] = p.in[36][k]; gng[nt] = p.in[37][k]; gnb[nt] = p.in[38][k]; }
            u32x4 pfP[4]; u32x2 pfR[4];
#define RW_PREFETCH(c) do { const int row0_ = b * SEQL + (c) * TC; \
                _Pragma("unroll") for (int i = 0; i < 2; ++i) { const int it = ptid + 256 * i; const int mt = it / 192, rem = it - mt * 192, t_ = rem / 12, g_ = rem - t_ * 12; \
                    if (it < 384) { const size_t row_ = (size_t)(row0_ + t_); pfP[2 * i] = *(const u32x4*)(P + row_ * 384 + mt * 192 + 8 * g_); \
                        pfP[2 * i + 1] = ((c) == 0 && t_ == 0) ? (u32x4){0u, 0u, 0u, 0u} : *(const u32x4*)(P + (row_ - 1) * 384 + mt * 192 + 96 + 8 * g_); } } \
                _Pragma("unroll") for (int i = 0; i < 4; ++i) { const int it = ptid + 256 * i; const int ar = it / 272, rem = it - ar * 272, rr_ = rem >> 4, c4 = rem & 15; \
                    if (it < 816) { const u16* src_ = ar == 0 ? (const u16*)R : ar == 1 ? Kb : Vb; \
                        pfR[i] = ((c) == 0 && rr_ == 0) ? (u32x2){0u, 0u} : *(const u32x2*)(src_ + (size_t)(row0_ - 1 + rr_) * 4096 + hc + 4 * c4); } } } while (0)
            RW_PREFETCH(0);
            for (int pc = -1; pc <= NCH; ++pc) {
                const int cn = pc + 1;
                const bool prep = (cn < NCH);
                float* vnext = vec + (cn & 1) * TC * 384;
                float* snext = scal + (cn & 1) * TC * 4;
                if (prep) {
#pragma unroll
                    for (int i = 0; i < 2; ++i) { const int it = ptid + 256 * i; const int mt = it / 192, rem = it - mt * 192, t_ = rem / 12, g_ = rem - t_ * 12;
                        if (it < 384) { float c8[8], p8[8]; unpack8(pfP[2 * i], c8); unpack8(pfP[2 * i + 1], p8);
#pragma unroll
                            for (int j = 0; j < 8; ++j) { const float s = c8[j] + p8[j]; c8[j] = mt == 0 ? ftanh(s) : s; }
                            *(u32x4*)(twa + (mt * 16 + t_) * 104 + 8 * g_) = pack8(c8); } }
#pragma unroll
                    for (int i = 0; i < 4; ++i) { const int it = ptid + 256 * i; const int ar = it / 272, rem = it - ar * 272, rr_ = rem >> 4, c4 = rem & 15;
                        if (it < 816) *(u32x2*)(raw + (ar * 17 + rr_) * 64 + 4 * c4) = pfR[i]; }
                }
                if (cn + 1 < NCH) RW_PREFETCH(cn + 1);
                if (pc >= 1) {
                    const int cp = pc - 1; const float* vprev = vec + (cp & 1) * TC * 384; const float* sprev = scal + (cp & 1) * TC * 4; const float* yprev = Yraw + (cp & 1) * TC * 64;
                    const size_t row = (size_t)(b * SEQL + cp * TC + tl);
                    float y[4], s1 = 0.f;
#pragma unroll
                    for (int nt = 0; nt < 4; ++nt) { y[nt] = yprev[tl * 64 + 16 * nt + l15]; s1 += y[nt]; }
                    const float mu = row16_sum(s1) * (1.0f / 64.0f); float s2 = 0.f;
#pragma unroll
                    for (int nt = 0; nt < 4; ++nt) { y[nt] -= mu; s2 += y[nt] * y[nt]; }
                    const float rs = rsqrtf(row16_sum(s2) * (1.0f / 64.0f) + 64e-5f), bon = sprev[tl * 4 + 2];
#pragma unroll
                    for (int nt = 0; nt < 4; ++nt) R[row * 4096 + hc + 16 * nt + l15] = f2bf(y[nt] * rs * gng[nt] + gnb[nt] + bon * vprev[tl * 384 + 320 + 16 * nt + l15]);
                }
                LBAR();
                if (prep) {
                    f32x4 accW[4], accA[4];
#pragma unroll
                    for (int nt = 0; nt < 4; ++nt) { accW[nt] = (f32x4){0.f, 0.f, 0.f, 0.f}; accA[nt] = (f32x4){0.f, 0.f, 0.f, 0.f}; }
#pragma unroll
                    for (int ks = 0; ks < 3; ++ks) { const bf16x8 afw = *(const bf16x8*)(twa + l15 * 104 + 32 * ks + 8 * lq), afa = *(const bf16x8*)(twa + (16 + l15) * 104 + 32 * ks + 8 * lq);
#pragma unroll
                        for (int nt = 0; nt < 4; ++nt) { const bf16x8 bw = *(const bf16x8*)(W2t + (16 * nt + l15) * 104 + 32 * ks + 8 * lq), ba = *(const bf16x8*)(A2t + (16 * nt + l15) * 104 + 32 * ks + 8 * lq);
                            accW[nt] = MFMA16(afw, bw, accW[nt]); accA[nt] = MFMA16(afa, ba, accA[nt]); } }
                    float r_[4], kx0[4], v_[4], dec[4], a_[4], kkv[4]; float ss = 0.f;
#pragma unroll
                    for (int nt = 0; nt < 4; ++nt) { const int k = 16 * nt + l15;
                        const float wl = w0k[nt] + (w4 == 0 ? accW[nt][0] : w4 == 1 ? accW[nt][1] : w4 == 2 ? accW[nt][2] : accW[nt][3]);
                        const float al = a0k[nt] + (w4 == 0 ? accA[nt][0] : w4 == 1 ? accA[nt][1] : w4 == 2 ? accA[nt][2] : accA[nt][3]);
                        const float rr = bf2f(raw[(0 * 17 + tl + 1) * 64 + k]), rp_ = bf2f(raw[(0 * 17 + tl) * 64 + k]);
                        const float kr_ = bf2f(raw[(1 * 17 + tl + 1) * 64 + k]), kp = bf2f(raw[(1 * 17 + tl) * 64 + k]);
                        const float vr = bf2f(raw[(2 * 17 + tl + 1) * 64 + k]), vp = bf2f(raw[(2 * 17 + tl) * 64 + k]);
                        r_[nt] = rr + (rp_ - rr) * mu_r[nt]; kx0[nt] = kr_ + (kp - kr_) * mu_k[nt]; v_[nt] = vr + (vp - vr) * mu_v[nt];
                        dec[nt] = __expf(-0.60653066f * fsigmoid(wl)); a_[nt] = fsigmoid(al);
                        kkv[nt] = kx0[nt] * kkk[nt]; ss += kkv[nt] * kkv[nt]; }
                    const float rinv = rsqrtf(fmaxf(row16_sum(ss), 1e-24f));
                    float br = 0.f, krs = 0.f, bon = 0.f; float* vb = vnext + tl * 384;
#pragma unroll
                    for (int nt = 0; nt < 4; ++nt) { const int k = 16 * nt + l15;
                        const float kk = kkv[nt] * rinv, kmod = kx0[nt] * (1.0f + (a_[nt] - 1.0f) * kak[nt]), kb = kk * a_[nt];
                        br += kb * r_[nt]; krs += kmod * r_[nt]; bon += r_[nt] * kmod * rkk[nt];
                        vb[k] = dec[nt]; vb[64 + k] = -kk; vb[128 + k] = kb; vb[192 + k] = kmod; vb[256 + k] = dec[nt] * r_[nt]; vb[320 + k] = v_[nt]; }
                    br = row16_sum(br); krs = row16_sum(krs); bon = row16_sum(bon);
                    if (l15 == 0) { snext[tl * 4] = br; snext[tl * 4 + 1] = krs; snext[tl * 4 + 2] = bon; }
                }
                LBAR();
            }
#undef RW_PREFETCH
        }
        __syncthreads();
    }
}

#ifndef PROBE_ROLE
#define PROBE_ROLE -1
#endif
#define LBARW() do { if (PROBE_ROLE >= 0 && wave == PROBE_ROLE) { const unsigned long long tb_ = __builtin_amdgcn_s_memrealtime(); LBAR(); twait += __builtin_amdgcn_s_memrealtime() - tb_; } else { LBAR(); } } while (0)
__device__ void ptanh_phase(const Params& p) {
    u16* P = (u16*)(p.ws + OFF_P);
    const int gt = blockIdx.x * 512 + threadIdx.x, nth = gridDim.x * 512;
    for (int it = gt; it < NTOK * 24; it += nth) { const int row = it / 24, rem = it - row * 24, mt = rem / 12, g = rem - mt * 12;
        u16* cp = P + (size_t)row * 384 + mt * 192 + 8 * g;
        float c8[8], p8[8]; unpack8(*(const u32x4*)cp, c8);
        if ((row & (SEQL - 1)) != 0) unpack8(*(const u32x4*)(cp - 384 + 96), p8);
        else {
#pragma unroll
            for (int j = 0; j < 8; ++j) p8[j] = 0.f; }
#pragma unroll
        for (int j = 0; j < 8; ++j) { const float s = c8[j] + p8[j]; c8[j] = mt == 0 ? (1.0f - 2.0f * __builtin_amdgcn_rcpf(1.0f + __expf(2.0f * s))) : s; }
        *(u32x4*)cp = pack8(c8); }
}

__device__ unsigned long long rwkv2_phase(const Params& p, unsigned char* smem) {
    unsigned long long twait = 0;
    constexpr int TC = 16, NCH = SEQL / TC;
    u16* W2t = (u16*)smem;
    u16* A2t = W2t + 64 * 104;
    u16* raw = A2t + 64 * 104;
    u16* twa = raw + 3 * 17 * 64;
    u16* S1 = twa + 2 * 16 * 104;
    unsigned char* S1b = (unsigned char*)(S1 + 2 * 4 * 16 * 72);
    float* Mx = (float*)(S1b + 3 * 10560);
    u16* Mxb = (u16*)(Mx + 1024);
    u16* AhT = Mxb + 3 * 16 * 32;
    u16* VhT = AhT + 64 * 16;
    float* MVs = (float*)(VhT + 64 * 16);
    float* ssP = MVs + 16 * 64;
    float* bonP = ssP + 64;
    unsigned char* S2 = (unsigned char*)(bonP + 64);
    u16* Sb = (u16*)(S2 + 2 * 16896);
    const int tid = threadIdx.x, lane = tid & 63, wave = __builtin_amdgcn_readfirstlane(tid >> 6);
    const int l15 = lane & 15, lq = lane >> 4;
    u16* R = (u16*)(p.ws + OFF_R); const u16* Kb = (const u16*)(p.ws + OFF_KK); const u16* Vb = (const u16*)(p.ws + OFF_V); const u16* P = (const u16*)(p.ws + OFF_P);
    for (int unit = blockIdx.x; unit < 256; unit += gridDim.x) {
        const int b = unit >> 6, h = unit & 63, hc = 64 * h;
        for (int e = tid; e < 6144; e += 512) { const int j = e >> 6, k = e & 63; W2t[k * 104 + j] = f2bf(p.in[30][(size_t)j * 4096 + hc + k]); A2t[k * 104 + j] = f2bf(p.in[33][(size_t)j * 4096 + hc + k]); }
        for (int e = tid; e < 64 * 72; e += 512) Sb[e] = 0;
        for (int e = tid; e < 3 * 16 * 32; e += 512) Mxb[e] = 0;
        __syncthreads();
        if (wave < 4) {
            const int w4 = wave, ptid = tid, k = 16 * w4 + l15, kg = hc + k;
            const float mu_r = p.in[25][kg], mu_k = p.in[25][4096 + kg], mu_v = p.in[25][8192 + kg];
            const float w0k = p.in[28][kg], a0k = p.in[31][kg], kkk = p.in[34][kg], kak = p.in[35][kg], rkk = p.in[36][kg];
            u32x4 pfP[2]; u32x2 pfR[4];
#define RW_PREFETCH(c) do { const int row0_ = b * SEQL + (c) * TC; \
                _Pragma("unroll") for (int i = 0; i < 2; ++i) { const int it = ptid + 256 * i; const int mt = it / 192, rem = it - mt * 192, t_ = rem / 12, g_ = rem - t_ * 12; \
                    if (it < 384) pfP[i] = *(const u32x4*)(P + (size_t)(row0_ + t_) * 384 + mt * 192 + 8 * g_); } \
                _Pragma("unroll") for (int i = 0; i < 4; ++i) { const int it = ptid + 256 * i; const int ar = it / 272, rem = it - ar * 272, rr_ = rem >> 4, c4 = rem & 15; \
                    if (it < 816) { const u16* src_ = ar == 0 ? (const u16*)R : ar == 1 ? Kb : Vb; \
                        pfR[i] = ((c) == 0 && rr_ == 0) ? (u32x2){0u, 0u} : *(const u32x2*)(src_ + (size_t)(row0_ - 1 + rr_) * 4096 + hc + 4 * c4); } } } while (0)
            RW_PREFETCH(0);
            for (int pc = 0; pc <= NCH + 1; ++pc) {
                const bool prep = (pc < NCH);
                int ln_ = lane; asm volatile("" : "+v"(ln_)); const int l15 = ln_ & 15, lq = ln_ >> 4;
                u16* set1 = S1 + (pc & 1) * (4 * 16 * 72);
                u16* At = set1; u16* Rt = set1 + 16 * 72; u16* Bt = set1 + 2 * 16 * 72; u16* Kt = set1 + 3 * 16 * 72;
                unsigned char* set1b = S1b + (pc % 3) * 10560;
                float* Vf = (float*)set1b; u16* BKT = (u16*)(set1b + 4096); u16* VT = (u16*)(set1b + 8192); float* W15 = (float*)(set1b + 10240); float* bonus = (float*)(set1b + 10496);
                if (prep) {
#pragma unroll
                    for (int i = 0; i < 2; ++i) { const int it = ptid + 256 * i; const int mt = it / 192, rem = it - mt * 192, t_ = rem / 12, g_ = rem - t_ * 12;
                        if (it < 384) *(u32x4*)(twa + (mt * 16 + t_) * 104 + 8 * g_) = pfP[i]; }
#pragma unroll
                    for (int i = 0; i < 4; ++i) { const int it = ptid + 256 * i; const int ar = it / 272, rem = it - ar * 272, rr_ = rem >> 4, c4 = rem & 15;
                        if (it < 816) *(u32x2*)(raw + (ar * 17 + rr_) * 64 + 4 * c4) = pfR[i]; }
                }
                if (pc + 1 < NCH) RW_PREFETCH(pc + 1);
                LBARW();
                float au[4], bu[4];
                if (prep) {
                    float kkv[4], a_[4], eP[4], eTi[4];
                    f32x4 accW = {0.f, 0.f, 0.f, 0.f}, accA = {0.f, 0.f, 0.f, 0.f};
#pragma unroll
                    for (int ks = 0; ks < 3; ++ks) { const bf16x8 afw = *(const bf16x8*)(twa + l15 * 104 + 32 * ks + 8 * lq), afa = *(const bf16x8*)(twa + (16 + l15) * 104 + 32 * ks + 8 * lq);
                        const bf16x8 bwf = *(const bf16x8*)(W2t + k * 104 + 32 * ks + 8 * lq), baf = *(const bf16x8*)(A2t + k * 104 + 32 * ks + 8 * lq);
                        accW = MFMA16(afw, bwf, accW); accA = MFMA16(afa, baf, accA); }
                    float ld[4]; f32x4 cum = {0.f, 0.f, 0.f, 0.f};
#pragma unroll
                    for (int r = 0; r < 4; ++r) ld[r] = -0.60653066f * fsigmoid(w0k + accW[r]);
#pragma unroll
                    for (int r = 0; r < 4; ++r) cum = __builtin_amdgcn_mfma_f32_16x16x4f32((4 * lq + r <= l15) ? 1.0f : 0.0f, ld[r], cum, 0, 0, 0);
                    float kmq[4], vq[4];
#pragma unroll
                    for (int r = 0; r < 4; ++r) { const int t = 4 * lq + r;
                        const float rr = bf2f(raw[(0 * 17 + t + 1) * 64 + k]), rp_ = bf2f(raw[(0 * 17 + t) * 64 + k]);
                        const float kr_ = bf2f(raw[(1 * 17 + t + 1) * 64 + k]), kp = bf2f(raw[(1 * 17 + t) * 64 + k]);
                        const float vr = bf2f(raw[(2 * 17 + t + 1) * 64 + k]), vp = bf2f(raw[(2 * 17 + t) * 64 + k]);
                        const float r_ = rr + (rp_ - rr) * mu_r, kx0 = kr_ + (kp - kr_) * mu_k, v_ = vr + (vp - vr) * mu_v;
                        a_[r] = fsigmoid(a0k + accA[r]); kkv[r] = kx0 * kkk;
                        const float kmod = kx0 * (1.0f + (a_[r] - 1.0f) * kak);
                        const float eT = __expf(cum[r]); eTi[r] = __builtin_amdgcn_rcpf(eT); eP[r] = __expf(cum[r] - ld[r]);
                        const float ssp = row16_sum(kkv[r] * kkv[r]), bop = row16_sum(r_ * kmod * rkk);
                        if (l15 == 0) { ssP[t * 4 + w4] = ssp; bonP[t * 4 + w4] = bop; }
                        Rt[t * 72 + k] = f2bf(r_ * eT); kmq[r] = kmod * eTi[r]; Kt[t * 72 + k] = f2bf(kmq[r]);
                        Vf[t * 64 + k] = v_; vq[r] = v_;
                        au[r] = -kkv[r] * eP[r]; bu[r] = kkv[r] * a_[r] * eTi[r];
                        if (t == 15) W15[k] = eT; }
                    { u32x2 w_; w_.x = pk2(kmq[0], kmq[1]); w_.y = pk2(kmq[2], kmq[3]); *(u32x2*)(BKT + k * 32 + lq * 8 + 4) = w_; }
                    { u32x2 w_; w_.x = pk2(vq[0], vq[1]); w_.y = pk2(vq[2], vq[3]); *(u32x2*)(VT + k * 16 + 4 * lq) = w_; }
                }
                LBARW();
                if (prep) {
                    float bq[4];
#pragma unroll
                    for (int r = 0; r < 4; ++r) { const int t = 4 * lq + r; const f32x4 s4 = *(const f32x4*)(ssP + t * 4);
                        const float rinv = rsqrtf(fmaxf((s4[0] + s4[1]) + (s4[2] + s4[3]), 1e-24f));
                        At[t * 72 + k] = f2bf(au[r] * rinv); bq[r] = bu[r] * rinv; Bt[t * 72 + k] = f2bf(bq[r]);
                        if (w4 == 0 && l15 == 0) { const f32x4 b4 = *(const f32x4*)(bonP + t * 4); bonus[t] = (b4[0] + b4[1]) + (b4[2] + b4[3]); } }
                    { u32x2 w_; w_.x = pk2(bq[0], bq[1]); w_.y = pk2(bq[2], bq[3]); *(u32x2*)(BKT + k * 32 + lq * 8) = w_; }
                }
                LBARW();
            }
#undef RW_PREFETCH
        } else if (wave < 6) {
            for (int pc = 0; pc <= NCH + 1; ++pc) {
                const int cm = pc - 1; const bool act = (cm >= 0 && cm < NCH);
                int ln_ = lane; asm volatile("" : "+v"(ln_)); const int lane = ln_, l15 = ln_ & 15, lq = ln_ >> 4; (void)lane;
                const u16* set1 = S1 + (cm & 1) * (4 * 16 * 72);
                const u16* At = set1; const u16* Rt = set1 + 16 * 72; const u16* Bt = set1 + 2 * 16 * 72; const u16* Kt = set1 + 3 * 16 * 72;
                if (act) {
                    f32x4 m0 = {0.f, 0.f, 0.f, 0.f}, m1 = {0.f, 0.f, 0.f, 0.f};
                    const u16* Xt = (wave == 4) ? At : Rt;
#pragma unroll
                    for (int ks = 0; ks < 2; ++ks) { const int o = l15 * 72 + 32 * ks + 8 * lq;
                        const bf16x8 xf = *(const bf16x8*)(Xt + o), bf_ = *(const bf16x8*)(Bt + o), kf = *(const bf16x8*)(Kt + o);
                        m0 = MFMA16(xf, bf_, m0); m1 = MFMA16(xf, kf, m1); }
#pragma unroll
                    for (int r = 0; r < 4; ++r) { const int t = 4 * lq + r, s = l15;
                        if (wave == 4) { Mx[t * 16 + s] = (s < t) ? m0[r] : 0.f; Mxb[1024 + t * 32 + s] = f2bf((s < t) ? m1[r] : 0.f); }
                        else { Mxb[t * 32 + s] = f2bf((s <= t) ? m0[r] : 0.f); Mxb[512 + t * 32 + s] = f2bf((s <= t) ? m1[r] : 0.f); } }
                }
                LBARW();
                if (act) {
                    unsigned char* set2 = S2 + (cm & 1) * 16896;
                    const float* Vf = (const float*)(S1b + (cm % 3) * 10560);
#define TRI_ROW(dst, base, t) do { dst[0] = *(const f32x4*)(Mx + (base) + (t) * 16); dst[1] = *(const f32x4*)(Mx + (base) + (t) * 16 + 4); dst[2] = *(const f32x4*)(Mx + (base) + (t) * 16 + 8); dst[3] = *(const f32x4*)(Mx + (base) + (t) * 16 + 12); } while (0)
#define TRI_NEXT(rc, rn) do { _Pragma("unroll") for (int i_ = 0; i_ < 4; ++i_) rc[i_] = rn[i_]; asm volatile("" ::: "memory"); } while (0)
                    if (wave == 4) {
                        u16* Ah = (u16*)set2;
                        float ah[16], x0[16];
#pragma unroll
                        for (int t = 0; t < 16; ++t) x0[t] = bf2f(At[t * 72 + lane]);
                        f32x4 rc[4], rn[4];
                        TRI_ROW(rc, 0, 0);
#pragma unroll
                        for (int t = 0; t < 16; ++t) { if (t < 15) TRI_ROW(rn, 0, t + 1);
                            float pa[4] = {x0[t], 0.f, 0.f, 0.f};
#pragma unroll
                            for (int s = 0; s + 1 < t; ++s) pa[s & 3] += rc[s >> 2][s & 3] * ah[s];
                            float acc = (pa[0] + pa[1]) + (pa[2] + pa[3]);
                            if (t >= 1) acc += rc[(t - 1) >> 2][(t - 1) & 3] * ah[t - 1];
                            ah[t] = acc; Ah[t * 72 + lane] = f2bf(acc);
                            TRI_NEXT(rc, rn); }
                        { u32x4 q0, q1; q0.x = pk2(ah[0], ah[1]); q0.y = pk2(ah[2], ah[3]); q0.z = pk2(ah[4], ah[5]); q0.w = pk2(ah[6], ah[7]);
                          q1.x = pk2(ah[8], ah[9]); q1.y = pk2(ah[10], ah[11]); q1.z = pk2(ah[12], ah[13]); q1.w = pk2(ah[14], ah[15]);
                          *(u32x4*)(AhT + lane * 16) = q0; *(u32x4*)(AhT + lane * 16 + 8) = q1; }
                    } else {
                        float* Vh = (float*)(set2 + 4608);
                        { const u16* VT = (const u16*)(S1b + (cm % 3) * 10560 + 8192);
                          const bf16x8 makf = *(const bf16x8*)(Mxb + 1024 + l15 * 32 + 8 * lq);
#pragma unroll
                          for (int nt = 0; nt < 4; ++nt) { u32x4 vz = {0u, 0u, 0u, 0u}; if (lq < 2) vz = *(const u32x4*)(VT + (16 * nt + l15) * 16 + 8 * lq);
                              const f32x4 d = MFMA16(makf, as_frag(vz), ((f32x4){0.f, 0.f, 0.f, 0.f}));
#pragma unroll
                              for (int r = 0; r < 4; ++r) MVs[(4 * lq + r) * 64 + 16 * nt + l15] = d[r]; }
                          asm volatile("s_waitcnt lgkmcnt(0)" ::: "memory"); }
                        float vh[16], x0[16];
#pragma unroll
                        for (int t = 0; t < 16; ++t) x0[t] = MVs[t * 64 + lane];
                        f32x4 rc[4], rn[4];
                        TRI_ROW(rc, 0, 0);
#pragma unroll
                        for (int t = 0; t < 16; ++t) { if (t < 15) TRI_ROW(rn, 0, t + 1);
                            float pa[4] = {x0[t], 0.f, 0.f, 0.f};
#pragma unroll
                            for (int s = 0; s + 1 < t; ++s) pa[s & 3] += rc[s >> 2][s & 3] * vh[s];
                            float acc = (pa[0] + pa[1]) + (pa[2] + pa[3]);
                            if (t >= 1) acc += rc[(t - 1) >> 2][(t - 1) & 3] * vh[t - 1];
                            vh[t] = acc; Vh[t * 64 + lane] = acc;
                            TRI_NEXT(rc, rn); }
                        { u32x4 q0, q1; q0.x = pk2(vh[0], vh[1]); q0.y = pk2(vh[2], vh[3]); q0.z = pk2(vh[4], vh[5]); q0.w = pk2(vh[6], vh[7]);
                          q1.x = pk2(vh[8], vh[9]); q1.y = pk2(vh[10], vh[11]); q1.z = pk2(vh[12], vh[13]); q1.w = pk2(vh[14], vh[15]);
                          *(u32x4*)(VhT + lane * 16) = q0; *(u32x4*)(VhT + lane * 16 + 8) = q1; }
                    }
                }
#undef TRI_ROW
#undef TRI_NEXT
                LBARW();
                if (act) {
                    unsigned char* set2 = S2 + (cm & 1) * 16896;
                    const bf16x8 mrbf = *(const bf16x8*)(Mxb + l15 * 32 + 8 * lq);
                    if (wave == 4) {
                        u16* Rh = (u16*)(set2 + 2304); float* Yk = (float*)(set2 + 12800);
                        const u16* VT = (const u16*)(S1b + (cm % 3) * 10560 + 8192);
                        const bf16x8 mrkf = *(const bf16x8*)(Mxb + 512 + l15 * 32 + 8 * lq);
#pragma unroll
                        for (int nt = 0; nt < 4; ++nt) { u32x4 az = {0u, 0u, 0u, 0u}, vz = {0u, 0u, 0u, 0u};
                            if (lq < 2) { az = *(const u32x4*)(AhT + (16 * nt + l15) * 16 + 8 * lq); vz = *(const u32x4*)(VT + (16 * nt + l15) * 16 + 8 * lq); }
                            const f32x4 d = MFMA16(mrbf, as_frag(az), ((f32x4){0.f, 0.f, 0.f, 0.f})), e = MFMA16(mrkf, as_frag(vz), ((f32x4){0.f, 0.f, 0.f, 0.f}));
#pragma unroll
                            for (int r = 0; r < 4; ++r) { const int o = (4 * lq + r) * 72 + 16 * nt + l15; Rh[o] = f2bf(d[r] + bf2f(Rt[o])); Yk[(4 * lq + r) * 64 + 16 * nt + l15] = e[r]; } }
                    } else {
                        float* Yh = (float*)(set2 + 8704);
#pragma unroll
                        for (int nt = 0; nt < 4; ++nt) { u32x4 vz = {0u, 0u, 0u, 0u}; if (lq < 2) vz = *(const u32x4*)(VhT + (16 * nt + l15) * 16 + 8 * lq);
                            const f32x4 d = MFMA16(mrbf, as_frag(vz), ((f32x4){0.f, 0.f, 0.f, 0.f}));
#pragma unroll
                            for (int r = 0; r < 4; ++r) Yh[(4 * lq + r) * 64 + 16 * nt + l15] = d[r]; }
                    }
                }
                LBARW();
            }
        } else {
            const int ws = wave - 6;
            float gng[4], gnb[4];
#pragma unroll
            for (int nt = 0; nt < 4; ++nt) { gng[nt] = p.in[37][hc + 16 * nt + l15]; gnb[nt] = p.in[38][hc + 16 * nt + l15]; }
            f32x4 accS[2][4];
#pragma unroll
            for (int m = 0; m < 2; ++m)
#pragma unroll
                for (int n = 0; n < 4; ++n) accS[m][n] = (f32x4){0.f, 0.f, 0.f, 0.f};
            for (int pc = 0; pc <= NCH + 1; ++pc) {
                const int cs = pc - 2; const bool act = (cs >= 0 && cs < NCH); const bool doY = act && ((cs & 1) == ws);
                int ln_ = lane; asm volatile("" : "+v"(ln_)); const int lane = ln_, l15 = ln_ & 15, lq = ln_ >> 4; (void)lane;
                const unsigned char* set2 = S2 + (cs & 1) * 16896;
                const u16* Ah = (const u16*)set2; const u16* Rh = (const u16*)(set2 + 2304); const float* Vh = (const float*)(set2 + 4608); const float* Yh = (const float*)(set2 + 8704); const float* Yk = (const float*)(set2 + 12800);
                const unsigned char* set1b = S1b + (((cs % 3) + 3) % 3) * 10560;
                const float* Vf = (const float*)set1b; const u16* BKT = (const u16*)(set1b + 4096); const u16* VT = (const u16*)(set1b + 8192); const float* W15 = (const float*)(set1b + 10240); const float* bonus = (const float*)(set1b + 10496);
                f32x4 accY[4];
                if (act) {
                    bf16x8 ahf[2];
#pragma unroll
                    for (int ks = 0; ks < 2; ++ks) ahf[ks] = *(const bf16x8*)(Ah + l15 * 72 + 32 * ks + 8 * lq);
                    f32x4 accSA[2];
#pragma unroll
                    for (int m = 0; m < 2; ++m) { const int vb = 16 * (2 * ws + m);
#pragma unroll
                        for (int r = 0; r < 4; ++r) accSA[m][r] = Vh[(4 * lq + r) * 64 + vb + l15];
#pragma unroll
                        for (int ks = 0; ks < 2; ++ks) { const bf16x8 sbf = *(const bf16x8*)(Sb + (vb + l15) * 72 + 32 * ks + 8 * lq); accSA[m] = MFMA16(ahf[ks], sbf, accSA[m]); } }
                    if (doY) {
                        bf16x8 rhf[2];
#pragma unroll
                        for (int ks = 0; ks < 2; ++ks) rhf[ks] = *(const bf16x8*)(Rh + l15 * 72 + 32 * ks + 8 * lq);
#pragma unroll
                        for (int nt = 0; nt < 4; ++nt) {
#pragma unroll
                            for (int r = 0; r < 4; ++r) accY[nt][r] = Yh[(4 * lq + r) * 64 + 16 * nt + l15] + Yk[(4 * lq + r) * 64 + 16 * nt + l15];
#pragma unroll
                            for (int ks = 0; ks < 2; ++ks) { const bf16x8 sbf = *(const bf16x8*)(Sb + (16 * nt + l15) * 72 + 32 * ks + 8 * lq); accY[nt] = MFMA16(rhf[ks], sbf, accY[nt]); } }
                    }
#pragma unroll
                    for (int m = 0; m < 2; ++m) { const int vb = 16 * (2 * ws + m);
                        u32x4 af; af.x = pk2(accSA[m][0], accSA[m][1]); af.y = pk2(accSA[m][2], accSA[m][3]);
                        const u32x2 vt = *(const u32x2*)(VT + (vb + l15) * 16 + 4 * lq); af.z = vt.x; af.w = vt.y;
#pragma unroll
                        for (int n = 0; n < 4; ++n) { const bf16x8 bkf = *(const bf16x8*)(BKT + (16 * n + l15) * 32 + 8 * lq); accS[m][n] = MFMA16(as_frag(af), bkf, accS[m][n]); } }
#pragma unroll
                    for (int n = 0; n < 4; ++n) { const float w = W15[16 * n + l15];
#pragma unroll
                        for (int m = 0; m < 2; ++m) accS[m][n] = accS[m][n] * w; }
                }
                LBARW();
                if (act) {
#pragma unroll
                    for (int m = 0; m < 2; ++m)
#pragma unroll
                        for (int n = 0; n < 4; ++n)
#pragma unroll
                            for (int r = 0; r < 4; ++r) Sb[(16 * (2 * ws + m) + 4 * lq + r) * 72 + 16 * n + l15] = f2bf(accS[m][n][r]);
                }
                if (doY) {
#pragma unroll
                    for (int r = 0; r < 4; ++r) { const int t = 4 * lq + r; const size_t row = (size_t)(b * SEQL + cs * TC + t);
                        const float mu = row16_sum(accY[0][r] + accY[1][r] + accY[2][r] + accY[3][r]) * (1.0f / 64.0f);
                        float d[4], s2 = 0.f;
#pragma unroll
                        for (int nt = 0; nt < 4; ++nt) { d[nt] = accY[nt][r] - mu; s2 += d[nt] * d[nt]; }
                        const float rs = rsqrtf(row16_sum(s2) * (1.0f / 64.0f) + 64e-5f), bon = bonus[t];
#pragma unroll
                        for (int nt = 0; nt < 4; ++nt) R[row * 4096 + hc + 16 * nt + l15] = f2bf(d[nt] * rs * gng[nt] + gnb[nt] + bon * Vf[t * 64 + 16 * nt + l15]); }
                }
                LBARW();
                LBARW();
            }
        }
        __syncthreads();
    }
    return twait;
}

__global__ void __launch_bounds__(512, 2) mega(Params p) {
    extern __shared__ __attribute__((aligned(16))) unsigned char smem[];
    cg::grid_group grid = cg::this_grid();
    const int lo = p.ph_lo, hi = p.ph_hi;
#define IN(k) (lo <= (k) && (k) < hi)
#define SEAM(k) do { if (IN(k) && IN((k) + 1)) grid.sync(); if (PROBE_PH >= 0) { const unsigned long long tn_ = __builtin_amdgcn_s_memrealtime(); if ((PROBE_PH >> (k)) & 1) tp1 += tn_ - tp0; tp0 = tn_; } } while (0)
    unsigned long long tp0 = (PROBE_PH >= 0) ? __builtin_amdgcn_s_memrealtime() : 0ull, tp1 = 0;
    unsigned char* ws = p.ws;
    PG8_LAS unsigned char* glds = (PG8_LAS unsigned char*)smem;
    if (IN(0)) for (int rep_ = 0; rep_ < 1 + (REP_MASK & 1); ++rep_) {
        tconv(smem, p.in[2], 8192, 0, 8192, 2048, (u16*)(ws + OFF_W0IN), 2048);
        tconv(smem, p.in[21], 2048, 0, 2048, 4096, (u16*)(ws + OFF_W0OUT), 4096);
        prep_small(p);
        rows_phase<0>(p);
    }
    SEAM(0);
    if (IN(1)) {
        pg8::Gemm g{(const u16*)(ws + OFF_H), (const u16*)(ws + OFF_W0IN), NTOK, 8192, 2048}; pg8::StaticOrder S; S.init(NTOK, 8192, gridDim.x, blockIdx.x);
        pg8::EpiG<F1> E{F1{(u16*)(ws + OFF_XR), (u16*)(ws + OFF_XM), (u16*)(ws + OFF_Y0)}};
        pg8::gemm_phase(glds, g, S, E); if ((REP_MASK >> 1) & 1) pg8::gemm_phase(glds, g, S, E);
    }
    SEAM(1);
    if (IN(2)) {
        mqk_phase(p, smem); if ((REP_MASK >> 2) & 1) { mqk_phase(p, smem); }
        lru_phase<1>(p, smem); if ((REP_MASK >> 3) & 1) { lru_phase<1>(p, smem); }
        tconv(smem, p.in[24], 16384, 0, 8192, 2048, (u16*)(ws + OFF_W1), 2048); if ((REP_MASK >> 4) & 1) { tconv(smem, p.in[24], 16384, 0, 8192, 2048, (u16*)(ws + OFF_W1), 2048); }
    }
    SEAM(2);
    if (IN(3)) lru_carry(p); if ((REP_MASK >> 5) & 1) { lru_carry(p); }
    SEAM(3);
    if (IN(4)) {
#ifdef PROBE_SUB
        const unsigned long long ta_ = __builtin_amdgcn_s_memrealtime();
#endif
        mlstm_phase(p, smem);
#ifdef PROBE_SUB
        tp1 += __builtin_amdgcn_s_memrealtime() - ta_;
#endif
        lru_phase<2>(p, smem); }
    SEAM(4);
    if (IN(5)) mnorm_phase(p);
    SEAM(5);
    if (IN(6)) {
        pg8::Gemm g{(const u16*)(ws + OFF_Y0), (const u16*)(ws + OFF_W0OUT), NTOK, 2048, 4096}; pg8::StaticOrder S; S.init(NTOK, 2048, gridDim.x, blockIdx.x);
        pg8::EpiG<F2> E{F2{(u16*)(ws + OFF_M0)}};
        pg8::gemm_phase(glds, g, S, E); if ((REP_MASK >> 7) & 1) pg8::gemm_phase(glds, g, S, E);
    }
    SEAM(6);
    if (IN(7)) {
        rows_phase<1>(p); if ((REP_MASK >> 8) & 1) { rows_phase<1>(p); }
        tconv(smem, p.in[24], 16384, 8192, 4096, 2048, (u16*)(ws + OFF_W1) + (size_t)8192 * 2048, 2048); if ((REP_MASK >> 4) & 1) { tconv(smem, p.in[24], 16384, 8192, 4096, 2048, (u16*)(ws + OFF_W1) + (size_t)8192 * 2048, 2048); }
        prep_extras(p); if ((REP_MASK >> 4) & 1) { prep_extras(p); }
    }
    SEAM(7);
    if (IN(8)) {
        pg8::Gemm g{(const u16*)(ws + OFF_H), (const u16*)(ws + OFF_W1), NTOK, 12800, 2048}; pg8::StaticOrder S; S.init(NTOK, 12800, gridDim.x, blockIdx.x);
        pg8::EpiG<F3> E{F3{(u16*)(ws + OFF_R), (u16*)(ws + OFF_P)}};
        pg8::gemm_phase(glds, g, S, E); if ((REP_MASK >> 9) & 1) pg8::gemm_phase(glds, g, S, E);
    }
    SEAM(8);
    if (IN(9)) {
#if RWKV_CHUNKED
        ptanh_phase(p);
        grid.sync();
        { const unsigned long long tw_ = rwkv2_phase(p, smem); if (PROBE_ROLE >= 0) tp1 += tw_; }
#else
        rwkv_phase(p, smem);
#endif
        tconv(smem, p.in[24], 16384, 12288, 4096, 2048, (u16*)(ws + OFF_W1Z), 2048); if ((REP_MASK >> 4) & 1) { tconv(smem, p.in[24], 16384, 12288, 4096, 2048, (u16*)(ws + OFF_W1Z), 2048); }
        tconv(smem, p.in[39], 2048, 0, 2048, 4096, (u16*)(ws + OFF_W1OUT), 4096); if ((REP_MASK >> 4) & 1) { tconv(smem, p.in[39], 2048, 0, 2048, 4096, (u16*)(ws + OFF_W1OUT), 4096); }
    }
    SEAM(9);
    if (IN(10)) {
        pg8::Gemm g{(const u16*)(ws + OFF_H), (const u16*)(ws + OFF_W1Z), NTOK, 4096, 2048}; pg8::StaticOrder S; S.init(NTOK, 4096, gridDim.x, blockIdx.x);
        pg8::EpiG<F4> E{F4{(u16*)(ws + OFF_R)}};
        pg8::gemm_phase(glds, g, S, E);
    }
    SEAM(10);
    if (IN(11)) {
        pg8::Gemm g{(const u16*)(ws + OFF_R), (const u16*)(ws + OFF_W1OUT), NTOK, 2048, 4096}; pg8::StaticOrder S; S.init(NTOK, 2048, gridDim.x, blockIdx.x);
        pg8::EpiG<F2> E{F2{(u16*)(ws + OFF_M1)}};
        pg8::gemm_phase(glds, g, S, E); if ((REP_MASK >> 10) & 1) pg8::gemm_phase(glds, g, S, E);
    }
    SEAM(11);
    if (IN(12)) rows_phase<2>(p);
#ifdef PROBE_SUB
    { const unsigned long long te = __builtin_amdgcn_s_memrealtime(); while (__builtin_amdgcn_s_memrealtime() - te < tp1) __builtin_amdgcn_s_sleep(8); }
#endif
    if (PROBE_PH >= 0) { const unsigned long long te = __builtin_amdgcn_s_memrealtime(); while (__builtin_amdgcn_s_memrealtime() - te < tp1) __builtin_amdgcn_s_sleep(8); }
}

extern "C" void kernel_launch(void* const* d_in, const int* in_sizes, int n_in, void* d_out, int out_size, void* d_ws, size_t ws_size, hipStream_t stream) {
    static int grid_blocks = 0;
    if (!grid_blocks) {
        if (n_in != 41 || ws_size < WS_NEED) { fprintf(stderr, "kernel_launch: unexpected n_in %d / ws_size %zu (need %zu)\n", n_in, ws_size, (size_t)WS_NEED); grid_blocks = -1; }
        else {
            int dev = 0, cus = 0, per_cu = 0;
            hipGetDevice(&dev);
            hipDeviceGetAttribute(&cus, hipDeviceAttributeMultiprocessorCount, dev);
            if (hipFuncSetAttribute((const void*)mega, hipFuncAttributeMaxDynamicSharedMemorySize, LDS_BYTES) != hipSuccess) fprintf(stderr, "kernel_launch: hipFuncSetAttribute failed\n");
            hipOccupancyMaxActiveBlocksPerMultiprocessor(&per_cu, (const void*)mega, 512, LDS_BYTES);
            if (per_cu < 1) { fprintf(stderr, "kernel_launch: occupancy query says %d blocks/CU\n", per_cu); per_cu = 1; }
            grid_blocks = cus * 1;
            if (grid_blocks > cus * per_cu) grid_blocks = cus * per_cu;
        }
    }
    if (grid_blocks <= 0) return;
    Params p{};
    for (int i = 0; i < 41; ++i) p.in[i] = (const float*)d_in[i];
    p.out = (float*)d_out; p.ws = (unsigned char*)d_ws;
#if N_LAUNCH_MODE == 1
    p.ph_lo = 0; p.ph_hi = NPH;
    { void* args[] = {&p};
      hipError_t e = hipLaunchCooperativeKernel((const void*)mega, dim3(grid_blocks), dim3(512), args, LDS_BYTES, stream);
      if (e != hipSuccess) fprintf(stderr, "cooperative launch failed: %s (grid %d)\n", hipGetErrorString(e), grid_blocks); }
#else
    for (int ph = 0; ph < NPH; ++ph) { p.ph_lo = ph; p.ph_hi = ph + 1; void* args[] = {&p};
        hipError_t e = hipLaunchCooperativeKernel((const void*)mega, dim3(grid_blocks), dim3(512), args, LDS_BYTES, stream);
        if (e != hipSuccess) { fprintf(stderr, "launch %d failed: %s (grid %d)\n", ph, hipGetErrorString(e), grid_blocks); break; } }
#endif
}
```

```cpp
#include <hip/hip_runtime.h>
#include <hip/hip_cooperative_groups.h>
#include <cstdio>
namespace cg = cooperative_groups;

#ifndef REP_MASK
#define REP_MASK 0
#endif
#ifndef PROBE_PH
#define PROBE_PH -1
#endif
#define REPS(k) for (int rep_ = 0; rep_ < 1 + ((REP_MASK >> (k)) & 1); ++rep_)
#ifndef RWKV_CHUNKED
#define RWKV_CHUNKED 1
#endif
#ifndef N_LAUNCH_MODE
#define N_LAUNCH_MODE 1
#endif

typedef unsigned short u16;
typedef short bf16x8 __attribute__((ext_vector_type(8)));
typedef float f32x4 __attribute__((ext_vector_type(4)));
typedef float f32x2 __attribute__((ext_vector_type(2)));
typedef unsigned u32x4 __attribute__((ext_vector_type(4)));
typedef unsigned u32x2 __attribute__((ext_vector_type(2)));

constexpr int NTOK = 16384, DM = 2048, SEQL = 4096;
constexpr size_t MiB = (size_t)1 << 20;
constexpr size_t OFF_H = 0;
constexpr size_t OFF_XR = 64 * MiB;
constexpr size_t OFF_XM = 128 * MiB;
constexpr size_t OFF_Y0 = 192 * MiB;
constexpr size_t OFF_Q = 320 * MiB;
constexpr size_t OFF_KX = 384 * MiB;
constexpr size_t OFF_W0IN = 448 * MiB;
constexpr size_t OFF_W0OUT = 480 * MiB;
constexpr size_t OFF_SMALL = 496 * MiB;
constexpr size_t OFF_G = OFF_SMALL;
constexpr size_t OFF_LRUA = OFF_SMALL + 1 * MiB;
constexpr size_t OFF_LRUH = OFF_SMALL + 3 * MiB;
constexpr size_t OFF_LRUC = OFF_SMALL + 5 * MiB;
constexpr size_t OFF_LRUW = OFF_SMALL + 7 * MiB;
constexpr size_t OFF_WGT = OFF_SMALL + 8 * MiB;
constexpr size_t OFF_M0 = OFF_XR;
constexpr size_t OFF_R = 64 * MiB, OFF_KK = 192 * MiB, OFF_V = 320 * MiB;
constexpr size_t OFF_W1 = 448 * MiB;
constexpr size_t OFF_P = 498 * MiB;
constexpr size_t OFF_W1Z = 448 * MiB, OFF_W1OUT = 464 * MiB;
constexpr size_t OFF_M1 = OFF_V;
constexpr size_t WS_NEED = 510 * MiB;
constexpr int LDS_BYTES = 160 * 1024;
constexpr int NPH = 13;

struct Params { const float* in[41]; float* out; unsigned char* ws; int ph_lo, ph_hi; };

__device__ __forceinline__ unsigned pk2(float lo, float hi) { unsigned r; asm volatile("v_cvt_pk_bf16_f32 %0, %1, %2" : "=v"(r) : "v"(lo), "v"(hi)); return r; }
__device__ __forceinline__ u16 f2bf(float f) { return (u16)(pk2(f, 0.f) & 0xffffu); }
__device__ __forceinline__ float bf2f(u16 v) { return __uint_as_float(((unsigned)v) << 16); }
__device__ __forceinline__ float bflo(unsigned w) { return __uint_as_float(w << 16); }
__device__ __forceinline__ float bfhi(unsigned w) { return __uint_as_float(w & 0xffff0000u); }
__device__ __forceinline__ void unpack8(u32x4 w, float* f) { f[0] = bflo(w.x); f[1] = bfhi(w.x); f[2] = bflo(w.y); f[3] = bfhi(w.y); f[4] = bflo(w.z); f[5] = bfhi(w.z); f[6] = bflo(w.w); f[7] = bfhi(w.w); }
__device__ __forceinline__ u32x4 pack8(const float* f) { u32x4 w; w.x = pk2(f[0], f[1]); w.y = pk2(f[2], f[3]); w.z = pk2(f[4], f[5]); w.w = pk2(f[6], f[7]); return w; }
__device__ __forceinline__ bf16x8 as_frag(u32x4 w) { union { u32x4 u; bf16x8 b; } c; c.u = w; return c.b; }
__device__ __forceinline__ float sigmoidf_(float x) { return 1.0f / (1.0f + __expf(-x)); }
__device__ __forceinline__ float siluf_(float x) { return x / (1.0f + __expf(-x)); }
__device__ __forceinline__ float softplusf_(float x) { return fmaxf(x, 0.f) + log1pf(__expf(-fabsf(x))); }
__device__ __forceinline__ float wave_sum(float v) {
#pragma unroll
    for (int o = 32; o; o >>= 1) v += __shfl_xor(v, o);
    return v;
}
template <int CTRL> __device__ __forceinline__ float dppf(float v) { return __int_as_float(__builtin_amdgcn_update_dpp(0, __float_as_int(v), CTRL, 0xF, 0xF, false)); }
__device__ __forceinline__ float wave_sum_dpp(float v) {
    v += dppf<0xB1>(v); v += dppf<0x4E>(v); v += dppf<0x141>(v); v += dppf<0x140>(v);
    const int iv = __float_as_int(v);
    return __int_as_float(__builtin_amdgcn_readlane(iv, 0)) + __int_as_float(__builtin_amdgcn_readlane(iv, 16)) + __int_as_float(__builtin_amdgcn_readlane(iv, 32)) + __int_as_float(__builtin_amdgcn_readlane(iv, 48));
}
#define MFMA16(a, b, c) __builtin_amdgcn_mfma_f32_16x16x32_bf16((a), (b), (c), 0, 0, 0)

namespace pg8 {
#define PG8_LAS __attribute__((address_space(3)))
typedef unsigned short bf16_t;
constexpr int BM = 256, BK = 64, HALF = 128, HTB = HALF * BK * 2, STAGE_BYTES = 8 * HTB, NXCD = 8, WGM = 8;
__host__ __device__ __forceinline__ int lds_byte(int r, int c) { const int st = (r >> 4) * 2 + (c >> 5), rr = r & 15, cc = c & 31, ob = rr * 64 + cc * 2; return st * 1024 + (ob ^ (((ob >> 9) & 1) << 5)); }
__host__ __device__ __forceinline__ void stage_rc(int b, int& R, int& C) { const int st = b / 1024, sb = b % 1024, swz = sb ^ (((sb >> 9) & 1) << 5); R = (st >> 1) * 16 + swz / 64; C = (st & 1) * 32 + (swz % 64) / 2; }
__host__ __device__ __forceinline__ int perm32(int rho) { const int n = rho >> 4, i = rho & 15; return 8 * (i >> 2) + 4 * n + (i & 3); }
struct Unit { int pm, pn; };
struct Gemm { const bf16_t* A; const bf16_t* Bt; int M, N, K; };
struct StaticOrder {
    int nM, nN, nwg, G, c;
    __host__ __device__ void init(int M, int N, int G_, int c_) { nM = M / BM; nN = N / BM; nwg = nM * nN; G = G_; c = c_; }
    __host__ __device__ bool next(int i, Unit& u) const {
        const long L = (long)i * G + c; if (L >= nwg) return false;
        int wgid = (int)L; { const int q = nwg / NXCD, r = nwg % NXCD, xcd = wgid % NXCD, off = wgid / NXCD; wgid = (xcd < r ? xcd * (q + 1) : r * (q + 1) + (xcd - r) * q) + off; }
        const int nig = WGM * nN, gid = wgid / nig, fm = gid * WGM, gsz = (nM - fm) < WGM ? (nM - fm) : WGM;
        u.pm = fm + ((wgid % nig) % gsz); u.pn = (wgid % nig) / gsz; return true;
    }
};
template <class F> struct EpiG {
    static constexpr bool PERM = true;
    F f;
    __device__ __forceinline__ void operator()(const f32x4 (&acc)[2][2][4][2], const Unit& u, int wr, int wc, int fr, int fq) const {
        const int row0 = u.pm * BM + wr * 64 + fr, col0 = u.pn * BM + wc * 32 + 8 * fq;
#pragma unroll
        for (int ai = 0; ai < 2; ++ai)
#pragma unroll
            for (int m = 0; m < 4; ++m)
#pragma unroll
                for (int bj = 0; bj < 2; ++bj) f(row0 + ai * HALF + m * 16, col0 + bj * HALF, acc[ai][bj][m][0], acc[ai][bj][m][1]);
    }
};

template <class Epi>
__device__ __forceinline__ void gemm_phase(PG8_LAS unsigned char* lds, const Gemm g, const StaticOrder& S, const Epi& E) {
    const int tid = threadIdx.x, wid = __builtin_amdgcn_readfirstlane(tid >> 6), lane = tid & 63, wr = wid >> 2, wc = wid & 3, fr = lane & 15, fq = lane >> 4;
    const int K = g.K, nt = K / BK;
    unsigned voffA[2], voffB[2];
#pragma unroll
    for (int i = 0; i < 2; ++i) { int R, C; stage_rc(tid * 16 + i * 8192, R, C); const int Rb = Epi::PERM ? ((R & ~31) + perm32(R & 31)) : R;
        voffA[i] = (unsigned)(R * K + C) * 2u; voffB[i] = (unsigned)(Rb * K + C) * 2u; }
    const size_t kstep = (size_t)(BK * 2);
    const size_t hstep = (size_t)HALF * K * 2;
    const size_t tstep = 2 * hstep;
    const unsigned ldsw = (unsigned)wid * 1024u;
    const int aoff = lds_byte(wr * 64 + fr, fq * 8), boff = lds_byte(wc * 32 + fr, fq * 8);
#define PG8_SA(b, h) (((b) * 2 + (h)) * HTB)
#define PG8_SB(b, h) ((4 + (b) * 2 + (h)) * HTB)
#define PG8_STAGE(bufoff, gbase, voff) do { _Pragma("unroll") for (int _i = 0; _i < 2; ++_i) \
        __builtin_amdgcn_global_load_lds((const unsigned*)((const char*)(gbase) + (voff)[_i]), (PG8_LAS unsigned*)(lds + (bufoff) + ldsw + _i * 8192), 16, 0, 0); } while (0)
#define PG8_LDA(dst, b, h) do { _Pragma("unroll") for (int m = 0; m < 4; ++m) _Pragma("unroll") for (int k = 0; k < 2; ++k) dst[m][k] = *(const PG8_LAS bf16x8*)(lds + PG8_SA(b, h) + aoff + m * 2048 + k * 1024); } while (0)
#define PG8_LDB(dst, b, h) do { _Pragma("unroll") for (int n = 0; n < 2; ++n) _Pragma("unroll") for (int k = 0; k < 2; ++k) dst[n][k] = *(const PG8_LAS bf16x8*)(lds + PG8_SB(b, h) + boff + n * 2048 + k * 1024); } while (0)
#define PG8_MMA(ai, bj, At, Bt) do { __builtin_amdgcn_s_setprio(1); _Pragma("unroll") for (int m = 0; m < 4; ++m) _Pragma("unroll") for (int n = 0; n < 2; ++n) _Pragma("unroll") for (int k = 0; k < 2; ++k) \
        acc[ai][bj][m][n] = __builtin_amdgcn_mfma_f32_16x16x32_bf16(Bt[n][k], At[m][k], acc[ai][bj][m][n], 0, 0, 0); __builtin_amdgcn_s_setprio(0); } while (0)
#define PG8_WAIT_V(n) asm volatile("s_waitcnt vmcnt(" #n ")" ::: "memory")
#define PG8_WAIT_L(n) asm volatile("s_waitcnt lgkmcnt(" #n ")" ::: "memory")
#define PG8_BAR __builtin_amdgcn_s_barrier()
#define PG8_SCHED __builtin_amdgcn_sched_barrier(0)
    Unit cur, nxt; int ui = 0;
    if (!S.next(0, cur)) return;
    f32x4 acc[2][2][4][2];
#pragma unroll
    for (int a = 0; a < 2; ++a)
#pragma unroll
        for (int b = 0; b < 2; ++b)
#pragma unroll
            for (int m = 0; m < 4; ++m)
#pragma unroll
                for (int n = 0; n < 2; ++n) acc[a][b][m][n] = (f32x4){0.f, 0.f, 0.f, 0.f};
    bf16x8 At[4][2], B0[2][2], B1[2][2];
    const char* cA = (const char*)g.A + (size_t)cur.pm * tstep; const char* cB = (const char*)g.Bt + (size_t)cur.pn * tstep;
    PG8_STAGE(PG8_SB(0, 0), cB, voffB); PG8_STAGE(PG8_SA(0, 0), cA, voffA); PG8_STAGE(PG8_SB(0, 1), cB + hstep, voffB); PG8_STAGE(PG8_SA(0, 1), cA + hstep, voffA);
    if (wr == 1) PG8_BAR;
    PG8_WAIT_V(4); PG8_BAR;
    PG8_STAGE(PG8_SB(1, 0), cB + kstep, voffB); PG8_STAGE(PG8_SA(1, 0), cA + kstep, voffA); PG8_STAGE(PG8_SB(1, 1), cB + hstep + kstep, voffB);
    PG8_WAIT_V(6); PG8_BAR;
    for (;;) {
        const bool has_next = S.next(ui + 1, nxt);
        const char* nA = has_next ? (const char*)g.A + (size_t)nxt.pm * tstep : cA; const char* nB = has_next ? (const char*)g.Bt + (size_t)nxt.pn * tstep : cB;
        for (int t = 0; t < nt; t += 2) {
            const bool last = (t == nt - 2);
            const char* a1 = cA + (size_t)(t + 1) * kstep;
            const char* a2 = last ? nA : cA + (size_t)(t + 2) * kstep; const char* b2 = last ? nB : cB + (size_t)(t + 2) * kstep;
            const char* a3 = a2 + kstep; const char* b3 = b2 + kstep;
            PG8_LDB(B0, 0, 0); PG8_SCHED; PG8_LDA(At, 0, 0); PG8_STAGE(PG8_SA(1, 1), a1 + hstep, voffA);
            PG8_WAIT_L(8); PG8_BAR; PG8_WAIT_L(0); PG8_MMA(0, 0, At, B0); PG8_BAR; PG8_SCHED;
            PG8_LDB(B1, 0, 1); PG8_STAGE(PG8_SB(0, 0), b2, voffB);
            PG8_BAR; PG8_WAIT_L(0); PG8_MMA(0, 1, At, B1); PG8_BAR;
            PG8_LDA(At, 0, 1); PG8_STAGE(PG8_SA(0, 0), a2, voffA);
            PG8_BAR; PG8_WAIT_L(0); PG8_MMA(1, 0, At, B0); PG8_BAR; PG8_SCHED;
            PG8_STAGE(PG8_SB(0, 1), b2 + hstep, voffB);
            PG8_WAIT_V(6); PG8_BAR; PG8_MMA(1, 1, At, B1); PG8_BAR;
            PG8_LDB(B0, 1, 0); PG8_SCHED; PG8_LDA(At, 1, 0); PG8_STAGE(PG8_SA(0, 1), a2 + hstep, voffA);
            PG8_WAIT_L(8); PG8_BAR; PG8_WAIT_L(0); PG8_MMA(0, 0, At, B0); PG8_BAR; PG8_SCHED;
            PG8_LDB(B1, 1, 1); PG8_STAGE(PG8_SB(1, 0), b3, voffB);
            PG8_BAR; PG8_WAIT_L(0); PG8_MMA(0, 1, At, B1); PG8_BAR;
            PG8_LDA(At, 1, 1); PG8_STAGE(PG8_SA(1, 0), a3, voffA);
            PG8_BAR; PG8_WAIT_L(0); PG8_MMA(1, 0, At, B0); PG8_BAR; PG8_SCHED;
            PG8_STAGE(PG8_SB(1, 1), b3 + hstep, voffB);
            PG8_WAIT_V(6); PG8_BAR; PG8_MMA(1, 1, At, B1); PG8_BAR;
        }
        E(acc, cur, wr, wc, fr, fq);
        if (!has_next) break;
#pragma unroll
        for (int a = 0; a < 2; ++a)
#pragma unroll
            for (int b = 0; b < 2; ++b)
#pragma unroll
                for (int m = 0; m < 4; ++m)
#pragma unroll
                    for (int n = 0; n < 2; ++n) acc[a][b][m][n] = (f32x4){0.f, 0.f, 0.f, 0.f};
        cur = nxt; cA = nA; cB = nB; ++ui;
    }
    PG8_WAIT_V(0);
    if (wr == 0) PG8_BAR;
    PG8_BAR;
#undef PG8_SA
#undef PG8_SB
#undef PG8_STAGE
#undef PG8_LDA
#undef PG8_LDB
#undef PG8_MMA
#undef PG8_WAIT_V
#undef PG8_WAIT_L
#undef PG8_BAR
#undef PG8_SCHED
}
}

__device__ __forceinline__ void store8bf(u16* dst, f32x4 v0, f32x4 v1) { u32x4 w; w.x = pk2(v0[0], v0[1]); w.y = pk2(v0[2], v0[3]); w.z = pk2(v1[0], v1[1]); w.w = pk2(v1[2], v1[3]); *(u32x4*)dst = w; }
struct F1 { u16 *XR, *XM, *Y0;
    __device__ __forceinline__ void operator()(int row, int col, f32x4 v0, f32x4 v1) const {
        const int reg = col >> 11, cc = col & 2047;
        u16* dst = reg == 0 ? XR + (size_t)row * 2048 + cc : reg == 1 ? Y0 + (size_t)row * 4096 + cc : reg == 2 ? XM + (size_t)row * 2048 + cc : Y0 + (size_t)row * 4096 + 2048 + cc;
        store8bf(dst, v0, v1); } };
struct F2 { u16* C;
    __device__ __forceinline__ void operator()(int row, int col, f32x4 v0, f32x4 v1) const { store8bf(C + (size_t)row * 2048 + col, v0, v1); } };
struct F3 { u16 *RKV, *P;
    __device__ __forceinline__ void operator()(int row, int col, f32x4 v0, f32x4 v1) const {
        if (col < 12288) { const int reg = col >> 12, cc = col & 4095; store8bf(RKV + (size_t)reg * ((size_t)NTOK * 4096) + (size_t)row * 4096 + cc, v0, v1); }
        else { const int cc = col - 12288; if (cc < 384) store8bf(P + (size_t)row * 384 + cc, v0, v1); } } };
struct F4 { u16* R;
    __device__ __forceinline__ void operator()(int row, int col, f32x4 v0, f32x4 v1) const {
        u16* d = R + (size_t)row * 4096 + col; const u32x4 w = *(const u32x4*)d; float y[8]; unpack8(w, y);
        f32x4 o0, o1;
#pragma unroll
        for (int j = 0; j < 4; ++j) { o0[j] = y[j] * siluf_(v0[j]); o1[j] = y[4 + j] * siluf_(v1[j]); }
        store8bf(d, o0, o1); } };

__device__ void tconv(unsigned char* smem, const float* src, int ldsrc, int col0, int N, int K, u16* dst, int ldd) {
    float* T = (float*)smem;
    const int tid = threadIdx.x, tilesN = N >> 6, ntile = tilesN * (K >> 6);
    const int lr = tid >> 4, lc = (tid & 15) * 4;
    const int sn = tid >> 3, sk = (tid & 7) * 8;
    int tile = blockIdx.x;
    f32x4 v0 = {0.f, 0.f, 0.f, 0.f}, v1 = {0.f, 0.f, 0.f, 0.f};
    if (tile < ntile) { const int tn = tile % tilesN, tk = tile / tilesN; const float* s = src + (size_t)(tk * 64 + lr) * ldsrc + col0 + tn * 64 + lc;
        v0 = __builtin_nontemporal_load((const f32x4*)s); v1 = __builtin_nontemporal_load((const f32x4*)(s + (size_t)32 * ldsrc)); }
    for (; tile < ntile; tile += gridDim.x) {
        const int tn = tile % tilesN, tk = tile / tilesN;
#pragma unroll
        for (int j = 0; j < 4; ++j) { T[lr * 65 + lc + j] = v0[j]; T[(lr + 32) * 65 + lc + j] = v1[j]; }
        asm volatile("s_waitcnt lgkmcnt(0)" ::: "memory"); __builtin_amdgcn_s_barrier(); asm volatile("" ::: "memory");
        const int nx = tile + gridDim.x;
        if (nx < ntile) { const int tn2 = nx % tilesN, tk2 = nx / tilesN; const float* s = src + (size_t)(tk2 * 64 + lr) * ldsrc + col0 + tn2 * 64 + lc;
            v0 = __builtin_nontemporal_load((const f32x4*)s); v1 = __builtin_nontemporal_load((const f32x4*)(s + (size_t)32 * ldsrc)); }
        float f[8];
#pragma unroll
        for (int j = 0; j < 8; ++j) f[j] = T[(sk + j) * 65 + sn];
        *(u32x4*)(dst + (size_t)(tn * 64 + sn) * ldd + tk * 64 + sk) = pack8(f);
        asm volatile("s_waitcnt lgkmcnt(0)" ::: "memory"); __builtin_amdgcn_s_barrier(); asm volatile("" ::: "memory");
    }
    __syncthreads();
}

template <int MODE> __device__ void rows_phase(const Params& p) {
    const int lane = threadIdx.x & 63, gw = blockIdx.x * 8 + (threadIdx.x >> 6), nw = gridDim.x * 8;
    const float* x = p.in[0];
    for (int row = gw; row < NTOK; row += nw) {
        if (MODE == 0) {
            f32x4 v[8]; float ss = 0.f;
#pragma unroll
            for (int i = 0; i < 8; ++i) { v[i] = __builtin_nontemporal_load((const f32x4*)(x + (size_t)row * DM + i * 256 + lane * 4)); ss += v[i][0] * v[i][0] + v[i][1] * v[i][1] + v[i][2] * v[i][2] + v[i][3] * v[i][3]; }
            ss = wave_sum(ss); const float r = rsqrtf(ss * (1.0f / DM) + 1e-6f);
            u16* H = (u16*)(p.ws + OFF_H);
#pragma unroll
            for (int i = 0; i < 8; ++i) { const int c = i * 256 + lane * 4; const f32x4 g = *(const f32x4*)(p.in[1] + c);
                u32x2 w; w.x = pk2(v[i][0] * r * g[0], v[i][1] * r * g[1]); w.y = pk2(v[i][2] * r * g[2], v[i][3] * r * g[3]); *(u32x2*)(H + (size_t)row * DM + c) = w; }
        } else {
            const u16* Mx = (const u16*)(p.ws + (MODE == 1 ? OFF_M0 : OFF_M1));
            const float* base = MODE == 1 ? x : p.out;
            const float* gpost = p.in[MODE == 1 ? 22 : 40];
            f32x4 m[8]; float ss = 0.f;
#pragma unroll
            for (int i = 0; i < 8; ++i) { const u32x2 w_ = __builtin_nontemporal_load((const u32x2*)(Mx + (size_t)row * DM + i * 256 + lane * 4)); m[i] = (f32x4){bflo(w_.x), bfhi(w_.x), bflo(w_.y), bfhi(w_.y)};
                ss += m[i][0] * m[i][0] + m[i][1] * m[i][1] + m[i][2] * m[i][2] + m[i][3] * m[i][3]; }
            ss = wave_sum(ss); const float r = rsqrtf(ss * (1.0f / DM) + 1e-6f);
            float ss1 = 0.f;
#pragma unroll
            for (int i = 0; i < 8; ++i) { const int c = i * 256 + lane * 4; const f32x4 g = *(const f32x4*)(gpost + c); const f32x4 b = __builtin_nontemporal_load((const f32x4*)(base + (size_t)row * DM + c));
                m[i] = b + m[i] * r * g; ss1 += m[i][0] * m[i][0] + m[i][1] * m[i][1] + m[i][2] * m[i][2] + m[i][3] * m[i][3];
                __builtin_nontemporal_store(m[i], (f32x4*)(p.out + (size_t)row * DM + c)); }
            if (MODE == 1) {
                ss1 = wave_sum(ss1); const float r1 = rsqrtf(ss1 * (1.0f / DM) + 1e-6f);
                u16* H = (u16*)(p.ws + OFF_H);
#pragma unroll
                for (int i = 0; i < 8; ++i) { const int c = i * 256 + lane * 4; const f32x4 g = *(const f32x4*)(p.in[23] + c);
                    u32x2 w; w.x = pk2(m[i][0] * r1 * g[0], m[i][1] * r1 * g[1]); w.y = pk2(m[i][2] * r1 * g[2], m[i][3] * r1 * g[3]); *(u32x2*)(H + (size_t)row * DM + c) = w; }
            }
        }
    }
}

__device__ void prep_small(const Params& p) {
    const int gt = blockIdx.x * 512 + threadIdx.x, nt = gridDim.x * 512;
    u16* LW = (u16*)(p.ws + OFF_LRUW);
    for (int e = gt; e < 2 * 16 * 128 * 128; e += nt) { const int i = e & 127, j = (e >> 7) & 127, blk = (e >> 14) & 15, g = e >> 18;
        LW[e] = f2bf(p.in[g ? 7 : 5][(size_t)(blk * 128 + i) * 128 + j]); }
    u16* WG = (u16*)(p.ws + OFF_WGT);
    for (int e = gt; e < 16 * 6144; e += nt) { const int c = e % 6144, n = e / 6144; WG[e] = f2bf(n < 8 ? p.in[15][c * 8 + n] : p.in[17][c * 8 + n - 8]); }
}
__device__ void prep_extras(const Params& p) {
    const int gt = blockIdx.x * 512 + threadIdx.x, nt = gridDim.x * 512;
    u16* W = (u16*)(p.ws + OFF_W1) + (size_t)12288 * 2048;
    for (int e = gt; e < 512 * 2048; e += nt) { const int k = e & 2047, n = e >> 11; float v = 0.f;
        if (n < 96) v = (1.f - p.in[26][k]) * p.in[29][k * 96 + n];
        else if (n < 192) v = p.in[26][k] * p.in[29][k * 96 + n - 96];
        else if (n < 288) v = (1.f - p.in[27][k]) * p.in[32][k * 96 + n - 192];
        else if (n < 384) v = p.in[27][k] * p.in[32][k * 96 + n - 288];
        W[e] = f2bf(v); }
}

#define LBAR0() do { asm volatile("s_waitcnt lgkmcnt(0)" ::: "memory"); __builtin_amdgcn_s_barrier(); asm volatile("" ::: "memory"); } while (0)
__device__ __forceinline__ float fsig0(float x) { return __builtin_amdgcn_rcpf(1.0f + __expf(-x)); }
template <int PASS> __device__ void lru_phase(const Params& p, unsigned char* smem) {
    float* xcf = (float*)smem;
    float* As = xcf + 64 * 132;
    float* Us = As + 64 * 132;
    float* qA = Us + 64 * 132;
    float* qH = qA + 512;
    const int tid = threadIdx.x, lane = tid & 63, wave = __builtin_amdgcn_readfirstlane(tid >> 6);
    const u16* XR = (const u16*)(p.ws + OFF_XR);
    u16* Y0 = (u16*)(p.ws + OFF_Y0);
    const u16* LW = (const u16*)(p.ws + OFF_LRUW);
    float* LA = (float*)(p.ws + OFF_LRUA); float* LH = (float*)(p.ws + OFF_LRUH); const float* LC = (const float*)(p.ws + OFF_LRUC);
    const float* cw = p.in[3]; const float* cb = p.in[4];
    u32x4 craw[2][4];
#define LRU_CLOAD(tl_) do { const int jb_ = (tl_) & 15, c_ = ((tl_) >> 4) & 63, b_ = (tl_) >> 10; \
        _Pragma("unroll") for (int it = 0; it < 2; ++it) { const int t_ = (tid >> 4) + 32 * it, ch_ = jb_ * 128 + (tid & 15) * 8; \
            _Pragma("unroll") for (int j = 0; j < 4; ++j) { const int s_ = c_ * 64 + t_ - 3 + j; \
                craw[it][j] = (s_ >= 0) ? *(const u32x4*)(XR + (size_t)(b_ * SEQL + s_) * 2048 + ch_) : (u32x4){0u, 0u, 0u, 0u}; } } } while (0)
    if ((int)blockIdx.x < 4096) LRU_CLOAD((int)blockIdx.x);
    const bool jb_fixed = (gridDim.x & 15) == 0;
    bf16x8 hba[4], hbx[4]; float hb_a = 0.f, hb_x = 0.f, hsp = 0.f;
    if (jb_fixed) { const int jb0 = blockIdx.x & 15, cg0 = jb0 * 128 + 16 * wave + (lane & 15);
#pragma unroll
        for (int ks = 0; ks < 4; ++ks) { const size_t wo = (size_t)((jb0 * 128 + 16 * wave + (lane & 15)) * 128 + ks * 32 + 8 * (lane >> 4));
            hba[ks] = *(const bf16x8*)(LW + wo); hbx[ks] = *(const bf16x8*)(LW + (size_t)16 * 128 * 128 + wo); }
        hb_a = p.in[6][cg0]; hb_x = p.in[8][cg0]; hsp = softplusf_(-p.in[9][cg0]); }
    for (int tile = blockIdx.x; tile < 4096; tile += gridDim.x) {
        const int jb = tile & 15, c = (tile >> 4) & 63, b = tile >> 10;
        const int row0 = b * SEQL + c * 64;
        u16 zpre[16];
        if (PASS == 2) {
#pragma unroll
            for (int tt = 0; tt < 16; ++tt) zpre[tt] = Y0[(size_t)(row0 + (tid >> 7) * 16 + tt) * 4096 + jb * 128 + (tid & 127)];
        }
#pragma unroll
        for (int it = 0; it < 2; ++it) {
            const int t = (tid >> 4) + 32 * it, c8 = (tid & 15) * 8, ch = jb * 128 + c8;
            float acc[8];
            { const f32x4 b0 = *(const f32x4*)(cb + ch), b1 = *(const f32x4*)(cb + ch + 4);
#pragma unroll
              for (int i = 0; i < 4; ++i) { acc[i] = b0[i]; acc[4 + i] = b1[i]; } }
#pragma unroll
            for (int j = 0; j < 4; ++j) { float xv[8]; unpack8(craw[it][j], xv);
                const f32x4 w0 = *(const f32x4*)(cw + j * 2048 + ch), w1 = *(const f32x4*)(cw + j * 2048 + ch + 4);
#pragma unroll
                for (int i = 0; i < 4; ++i) { acc[i] += w0[i] * xv[i]; acc[4 + i] += w1[i] * xv[4 + i]; } }
            *(f32x4*)(xcf + t * 132 + c8) = (f32x4){acc[0], acc[1], acc[2], acc[3]}; *(f32x4*)(xcf + t * 132 + c8 + 4) = (f32x4){acc[4], acc[5], acc[6], acc[7]};
        }
        if (tile + (int)gridDim.x < 4096) LRU_CLOAD(tile + (int)gridDim.x);
        LBAR0();
        f32x4 accA[4], accX[4];
#pragma unroll
        for (int m = 0; m < 4; ++m) { accA[m] = (f32x4){0.f, 0.f, 0.f, 0.f}; accX[m] = (f32x4){0.f, 0.f, 0.f, 0.f}; }
#pragma unroll
        for (int ks = 0; ks < 4; ++ks) {
            const size_t wo = (size_t)((jb * 128 + 16 * wave + (lane & 15)) * 128 + ks * 32 + 8 * (lane >> 4));
            const bf16x8 ba = jb_fixed ? hba[ks] : *(const bf16x8*)(LW + wo), bx = jb_fixed ? hbx[ks] : *(const bf16x8*)(LW + (size_t)16 * 128 * 128 + wo);
#pragma unroll
            for (int m = 0; m < 4; ++m) { const float* s = xcf + (16 * m + (lane & 15)) * 132 + ks * 32 + 8 * (lane >> 4);
                const f32x4 lo = *(const f32x4*)s, hi = *(const f32x4*)(s + 4); float f[8] = {lo[0], lo[1], lo[2], lo[3], hi[0], hi[1], hi[2], hi[3]};
                const bf16x8 af = as_frag(pack8(f));
                accA[m] = MFMA16(af, ba, accA[m]); accX[m] = MFMA16(af, bx, accX[m]); }
        }
        {
            const int ch = 16 * wave + (lane & 15), cgl = jb * 128 + ch;
            const float ba_ = jb_fixed ? hb_a : p.in[6][cgl], bx_ = jb_fixed ? hb_x : p.in[8][cgl], sp = jb_fixed ? hsp : softplusf_(-p.in[9][cgl]);
#pragma unroll
            for (int m = 0; m < 4; ++m)
#pragma unroll
                for (int r = 0; r < 4; ++r) { const int t = 16 * m + 4 * (lane >> 4) + r;
                    const float rg = fsig0(accA[m][r] + ba_), ig = fsig0(accX[m][r] + bx_);
                    const float la = -8.0f * rg * sp, a = __expf(la), u = __builtin_amdgcn_sqrtf(fmaxf(1.0f - a * a, 0.f)) * (ig * xcf[t * 132 + ch]);
                    As[t * 132 + ch] = a; Us[t * 132 + ch] = u; }
        }
        LBAR0();
        const int ch = tid & 127, q = tid >> 7, cgl = jb * 128 + ch;
        { float h = 0.f, A = 1.f;
#pragma unroll
          for (int tt = 0; tt < 16; ++tt) { const int t = q * 16 + tt; const float a = As[t * 132 + ch], u = Us[t * 132 + ch]; h = a * h + u; A *= a;
              if (PASS == 2) { Us[t * 132 + ch] = h; As[t * 132 + ch] = A; } }
          qA[q * 128 + ch] = A; qH[q * 128 + ch] = h; }
        LBAR0();
        if (PASS == 1) {
            if (q == 0) { float h = 0.f, A = 1.f;
#pragma unroll
                for (int qq = 0; qq < 4; ++qq) { h = qA[qq * 128 + ch] * h + qH[qq * 128 + ch]; A *= qA[qq * 128 + ch]; }
                LA[(size_t)(b * 64 + c) * 2048 + cgl] = A; LH[(size_t)(b * 64 + c) * 2048 + cgl] = h; }
        } else {
            float carry = LC[(size_t)(b * 64 + c) * 2048 + cgl];
            for (int qq = 0; qq < q; ++qq) carry = qA[qq * 128 + ch] * carry + qH[qq * 128 + ch];
#pragma unroll
            for (int tt = 0; tt < 16; ++tt) { const int t = q * 16 + tt; const float hh = Us[t * 132 + ch] + As[t * 132 + ch] * carry; const float z = bf2f(zpre[tt]);
                Y0[(size_t)(row0 + t) * 4096 + cgl] = f2bf(hh * z * fsig0(z)); }
        }
        LBAR0();
    }
}
__device__ void lru_carry(const Params& p) {
    const float* LA = (const float*)(p.ws + OFF_LRUA); const float* LH = (const float*)(p.ws + OFF_LRUH); float* LC = (float*)(p.ws + OFF_LRUC);
    for (int idx = blockIdx.x * 512 + threadIdx.x; idx < 4 * 2048; idx += gridDim.x * 512) { const int b = idx >> 11, cg_ = idx & 2047; float c = 0.f;
#pragma unroll 8
        for (int k = 0; k < 64; ++k) { const size_t o = (size_t)(b * 64 + k) * 2048 + cg_; LC[o] = c; c = LA[o] * c + LH[o]; } }
}

__device__ void mqk_phase(const Params& p, unsigned char* smem) {
    float* red = (float*)smem;
    const int tid = threadIdx.x, lane = tid & 63, wave = __builtin_amdgcn_readfirstlane(tid >> 6);
    const u16* XM = (const u16*)(p.ws + OFF_XM); u16* Q = (u16*)(p.ws + OFF_Q); u16* KX = (u16*)(p.ws + OFF_KX);
    const u16* WG = (const u16*)(p.ws + OFF_WGT); float* G = (float*)(p.ws + OFF_G);
    for (int tile = blockIdx.x; tile < 256; tile += gridDim.x) {
        const int row0 = tile * 64;
        f32x4 acc[4];
#pragma unroll
        for (int m = 0; m < 4; ++m) acc[m] = (f32x4){0.f, 0.f, 0.f, 0.f};
        for (int ks = 0; ks < 8; ++ks) {
            const int c0 = 256 * wave + 32 * ks + 8 * (lane >> 4);
            float cw[4][8], cbv[8];
#pragma unroll
            for (int j = 0; j < 4; ++j) { const f32x4 a = *(const f32x4*)(p.in[10] + j * 2048 + c0), b = *(const f32x4*)(p.in[10] + j * 2048 + c0 + 4);
#pragma unroll
                for (int i = 0; i < 4; ++i) { cw[j][i] = a[i]; cw[j][4 + i] = b[i]; } }
            { const f32x4 a = *(const f32x4*)(p.in[11] + c0), b = *(const f32x4*)(p.in[11] + c0 + 4);
#pragma unroll
              for (int i = 0; i < 4; ++i) { cbv[i] = a[i]; cbv[4 + i] = b[i]; } }
            const bf16x8 bq = *(const bf16x8*)(WG + (size_t)(lane & 15) * 6144 + c0), bk = *(const bf16x8*)(WG + (size_t)(lane & 15) * 6144 + 2048 + c0), bv = *(const bf16x8*)(WG + (size_t)(lane & 15) * 6144 + 4096 + c0);
            const float* wqp = p.in[12] + (size_t)(c0 >> 2) * 16; const float* wkp = p.in[13] + (size_t)(c0 >> 2) * 16; const float* wvp = p.in[14] + (size_t)(c0 >> 2) * 16;
            u32x4 xraw[4];
#define MQ_LOAD(dst, mm) do { const int tk_ = row0 + 16 * (mm) + (lane & 15), s_ = tk_ & (SEQL - 1); \
                _Pragma("unroll") for (int j = 0; j < 4; ++j) dst[j] = (s_ - 3 + j >= 0) ? *(const u32x4*)(XM + (size_t)(tk_ - 3 + j) * 2048 + c0) : (u32x4){0u, 0u, 0u, 0u}; } while (0)
            MQ_LOAD(xraw, 0);
#pragma unroll
            for (int m = 0; m < 4; ++m) {
                const int tk = row0 + 16 * m + (lane & 15);
                u32x4 xnx[4];
                if (m < 3) MQ_LOAD(xnx, m + 1);
                float xmc[8], xcur[8];
#pragma unroll
                for (int i = 0; i < 8; ++i) xmc[i] = cbv[i];
#pragma unroll
                for (int j = 0; j < 4; ++j) { float xv[8]; unpack8(xraw[j], xv);
#pragma unroll
                    for (int i = 0; i < 8; ++i) { xmc[i] += cw[j][i] * xv[i]; if (j == 3) xcur[i] = xv[i]; } }
                if (m < 3) {
#pragma unroll
                    for (int j = 0; j < 4; ++j) xraw[j] = xnx[j]; }
#pragma unroll
                for (int i = 0; i < 8; ++i) xmc[i] = xmc[i] * fsig0(xmc[i]);
                float qv[8], kv[8], vv[8];
#pragma unroll
                for (int bb = 0; bb < 2; ++bb)
#pragma unroll
                    for (int jj = 0; jj < 4; ++jj) { float aq = 0.f, ak = 0.f, av = 0.f;
#pragma unroll
                        for (int ii = 0; ii < 4; ++ii) { aq += xmc[4 * bb + ii] * wqp[bb * 16 + ii * 4 + jj]; ak += xmc[4 * bb + ii] * wkp[bb * 16 + ii * 4 + jj]; av += xcur[4 * bb + ii] * wvp[bb * 16 + ii * 4 + jj]; }
                        qv[4 * bb + jj] = aq; kv[4 * bb + jj] = ak; vv[4 * bb + jj] = av; }
                const u32x4 qw = pack8(qv), kw = pack8(kv), vw = pack8(vv);
                acc[m] = MFMA16(as_frag(qw), bq, acc[m]); acc[m] = MFMA16(as_frag(kw), bk, acc[m]); acc[m] = MFMA16(as_frag(vw), bv, acc[m]);
#pragma unroll
                for (int i = 0; i < 8; ++i) kv[i] *= 0.0625f;
                *(u32x4*)(Q + (size_t)tk * 2048 + c0) = qw; *(u32x4*)(KX + (size_t)tk * 2048 + c0) = pack8(kv);
            }
        }
#pragma unroll
        for (int m = 0; m < 4; ++m)
#pragma unroll
            for (int r = 0; r < 4; ++r) red[(wave * 64 + 16 * m + 4 * (lane >> 4) + r) * 16 + (lane & 15)] = acc[m][r];
        __syncthreads();
        for (int e = tid; e < 1024; e += 512) { const int tok = e >> 4, n = e & 15; float s = (n < 8) ? p.in[16][n] : p.in[18][n - 8];
#pragma unroll
            for (int w = 0; w < 8; ++w) s += red[(w * 64 + tok) * 16 + n];
            G[(size_t)(row0 + tok) * 16 + n] = s; }
        __syncthreads();
    }
}

__device__ void mlstm_phase(const Params& p, unsigned char* smem) {
    u16* Ks = (u16*)smem;
    u16* Vt = Ks + 128 * 264;
    u16* Vwt = Vt + 48 * 136;
    u16* Ps = Vwt + 48 * 136;
    u16* Ct = Ps + 128 * 136;
    float* gc = (float*)(Ct + 48 * 264);
    float* gM = gc + 128; float* gE = gM + 128; float* gF = gE + 128; float* gW = gF + 128; float* gS = gW + 128;
    const int tid = threadIdx.x, lane = tid & 63, wave = __builtin_amdgcn_readfirstlane(tid >> 6);
    const int l15 = lane & 15, lq = lane >> 4;
    const u16* XM = (const u16*)(p.ws + OFF_XM); const u16* Q = (const u16*)(p.ws + OFF_Q); const u16* KX = (const u16*)(p.ws + OFF_KX);
    const float* G = (const float*)(p.ws + OFF_G); u16* Hm = (u16*)(p.ws + OFF_H);
    for (int unit = blockIdx.x; unit < 256; unit += gridDim.x) {
        int sl = unit & 7, bh_ = unit >> 3;
        if (gridDim.x == 256) { const int xcd_ = unit & 7, j_ = unit >> 3; bh_ = xcd_ * 4 + (j_ >> 3); sl = j_ & 7; }
        const int h = bh_ & 7, b = bh_ >> 3;
        f32x4 accC[3][2];
#pragma unroll
        for (int a = 0; a < 3; ++a)
#pragma unroll
            for (int c = 0; c < 2; ++c) accC[a][c] = (f32x4){0.f, 0.f, 0.f, 0.f};
        float m_prev = 0.f;
        for (int e = tid; e < 16 * 136; e += 512) { const int r = e / 136; Vt[32 * 136 + e] = (r == 0) ? (u16)0x3F80 : (u16)0; Vwt[32 * 136 + e] = 0; }
        for (int e = tid; e < 48 * 264; e += 512) Ct[e] = 0;
        const int vc = 256 * h + 32 * sl + 4 * (tid & 7);
        const float* wvp = p.in[14] + (size_t)(vc >> 2) * 16;
        __syncthreads();
        for (int chunk = 0; chunk < 32; ++chunk) {
            const int row0 = b * SEQL + chunk * 128;
#pragma unroll
            for (int i = 0; i < 8; ++i) { const int idx = tid + 512 * i, r = idx >> 5, cc = (idx & 31) * 8;
                *(u32x4*)(Ks + r * 264 + cc) = *(const u32x4*)(KX + (size_t)(row0 + r) * 2048 + 256 * h + cc); }
            bf16x8 qf[8];
#pragma unroll
            for (int ks = 0; ks < 8; ++ks) qf[ks] = *(const bf16x8*)(Q + (size_t)(row0 + 16 * wave + l15) * 2048 + 256 * h + 32 * ks + 8 * lq);
            float vv[2][4];
#pragma unroll
            for (int i = 0; i < 2; ++i) { const int t = (tid + 512 * i) >> 3; const u32x2 raw = *(const u32x2*)(XM + (size_t)(row0 + t) * 2048 + vc);
                const float x0 = bflo(raw.x), x1 = bfhi(raw.x), x2 = bflo(raw.y), x3 = bfhi(raw.y);
#pragma unroll
                for (int jj = 0; jj < 4; ++jj) vv[i][jj] = x0 * wvp[jj] + x1 * wvp[4 + jj] + x2 * wvp[8 + jj] + x3 * wvp[12 + jj]; }
#pragma unroll
            for (int i = 0; i < 2; ++i) { const int t = (tid + 512 * i) >> 3;
#pragma unroll
                for (int jj = 0; jj < 4; ++jj) Vt[(4 * (tid & 7) + jj) * 136 + t] = f2bf(vv[i][jj]); }
            LBAR0();
            if (wave == 0) {
                const int t0 = 2 * lane;
                const float ig0 = G[(size_t)(row0 + t0) * 16 + h], fg0 = G[(size_t)(row0 + t0) * 16 + 8 + h];
                const float ig1 = G[(size_t)(row0 + t0 + 1) * 16 + h], fg1 = G[(size_t)(row0 + t0 + 1) * 16 + 8 + h];
                const float lf0 = -softplusf_(-fg0), lf1 = -softplusf_(-fg1);
                float s = lf0 + lf1;
#pragma unroll
                for (int d = 1; d < 64; d <<= 1) { const float o = __shfl_up(s, d); if (lane >= d) s += o; }
                const float b1 = s, b0 = s - lf1;
                const float c0 = ig0 - b0, c1 = ig1 - b1;
                float mx = fmaxf(c0, c1);
#pragma unroll
                for (int d = 1; d < 64; d <<= 1) { const float o = __shfl_up(mx, d); if (lane >= d) mx = fmaxf(mx, o); }
                float pm = __shfl_up(mx, 1); if (lane == 0) pm = -3.0e38f;
                const float M0 = fmaxf(fmaxf(pm, c0), m_prev), M1 = fmaxf(mx, m_prev);
                const float Ml = __shfl(M1, 63), bL = __shfl(b1, 63);
                gc[t0] = c0; gc[t0 + 1] = c1; gM[t0] = M0; gM[t0 + 1] = M1;
                gE[t0] = __expf(m_prev - M0); gE[t0 + 1] = __expf(m_prev - M1);
                gF[t0] = __expf(-(b0 + M0)); gF[t0 + 1] = __expf(-(b1 + M1));
                gW[t0] = __expf(c0 - Ml); gW[t0 + 1] = __expf(c1 - Ml);
                if (lane == 0) gS[0] = __expf(m_prev - Ml);
                m_prev = bL + Ml;
            }
            f32x4 accS[8];
#pragma unroll
            for (int n = 0; n < 8; ++n) { accS[n] = (f32x4){0.f, 0.f, 0.f, 0.f};
                if (n <= wave) {
#pragma unroll
                    for (int ks = 0; ks < 8; ++ks) { const bf16x8 kf = *(const bf16x8*)(Ks + (16 * n + l15) * 264 + 32 * ks + 8 * lq); accS[n] = MFMA16(qf[ks], kf, accS[n]); } } }
            LBAR0();
#pragma unroll
            for (int i = 0; i < 2; ++i) { const int t = (tid + 512 * i) >> 3; const float w = gW[t];
#pragma unroll
                for (int jj = 0; jj < 4; ++jj) { const int dv = 4 * (tid & 7) + jj; Vwt[dv * 136 + t] = f2bf(bf2f(Vt[dv * 136 + t]) * w); } }
            if (tid < 128) Vwt[32 * 136 + tid] = f2bf(gW[tid]);
#pragma unroll
            for (int n = 0; n < 8; ++n) if (n <= (wave | 1)) { const int s = 16 * n + l15; const float cs = gc[s];
#pragma unroll
                for (int r = 0; r < 4; ++r) { const int t = 16 * wave + 4 * lq + r; const float val = (n <= wave && s <= t) ? accS[n][r] * __expf(cs - gM[t]) : 0.f; Ps[t * 136 + s] = f2bf(val); } }
            LBAR0();
            f32x4 oi[3], oc[3];
#pragma unroll
            for (int nt = 0; nt < 3; ++nt) { oi[nt] = (f32x4){0.f, 0.f, 0.f, 0.f}; oc[nt] = (f32x4){0.f, 0.f, 0.f, 0.f}; }
#pragma unroll
            for (int kk = 0; kk < 4; ++kk) if (kk <= (wave >> 1)) { const bf16x8 pf = *(const bf16x8*)(Ps + (16 * wave + l15) * 136 + 32 * kk + 8 * lq);
#pragma unroll
                for (int nt = 0; nt < 3; ++nt) { const bf16x8 vf = *(const bf16x8*)(Vt + (16 * nt + l15) * 136 + 32 * kk + 8 * lq); oi[nt] = MFMA16(pf, vf, oi[nt]); } }
#pragma unroll
            for (int ks = 0; ks < 8; ++ks)
#pragma unroll
                for (int nt = 0; nt < 3; ++nt) { const bf16x8 cf = *(const bf16x8*)(Ct + (16 * nt + l15) * 264 + 32 * ks + 8 * lq); oc[nt] = MFMA16(qf[ks], cf, oc[nt]); }
#pragma unroll
            for (int r = 0; r < 4; ++r) { const int t = 16 * wave + 4 * lq + r; const float E = gE[t], F = gF[t];
                float den = oi[2][r] + E * oc[2][r]; den = __shfl(den, lane & 48);
                const float inv = 1.0f / fmaxf(fabsf(den), F);
#pragma unroll
                for (int nt = 0; nt < 2; ++nt) Hm[(size_t)(row0 + t) * 2048 + 256 * h + 32 * sl + 16 * nt + l15] = f2bf((oi[nt][r] + E * oc[nt][r]) * inv); }
            { const float decay = gS[0];
#pragma unroll
              for (int a = 0; a < 3; ++a)
#pragma unroll
                for (int c = 0; c < 2; ++c) accC[a][c] = accC[a][c] * decay; }
#pragma unroll
            for (int kk = 0; kk < 4; ++kk) {
                bf16x8 ktf[2];
#pragma unroll
                for (int ntk = 0; ntk < 2; ++ntk) { const int dk = 32 * wave + 16 * ntk + l15;
#pragma unroll
                    for (int j = 0; j < 8; ++j) ktf[ntk][j] = (short)Ks[(32 * kk + 8 * lq + j) * 264 + dk]; }
#pragma unroll
                for (int mt = 0; mt < 3; ++mt) { const bf16x8 vwf = *(const bf16x8*)(Vwt + (16 * mt + l15) * 136 + 32 * kk + 8 * lq);
#pragma unroll
                    for (int ntk = 0; ntk < 2; ++ntk) accC[mt][ntk] = MFMA16(vwf, ktf[ntk], accC[mt][ntk]); }
            }
            LBAR0();
#pragma unroll
            for (int mt = 0; mt < 3; ++mt)
#pragma unroll
                for (int ntk = 0; ntk < 2; ++ntk)
#pragma unroll
                    for (int r = 0; r < 4; ++r) Ct[(16 * mt + 4 * lq + r) * 264 + 32 * wave + 16 * ntk + l15] = f2bf(accC[mt][ntk][r]);
        }
        __syncthreads();
    }
}

__device__ void mnorm_phase(const Params& p) {
    const int lane = threadIdx.x & 63, wave = threadIdx.x >> 6;
    const u16* XM = (const u16*)(p.ws + OFF_XM); const u16* Hm = (const u16*)(p.ws + OFF_H); u16* Y0 = (u16*)(p.ws + OFF_Y0);
    const int c = 256 * wave + 4 * lane;
    float cw[4][4];
#pragma unroll
    for (int j = 0; j < 4; ++j) { const f32x4 a = *(const f32x4*)(p.in[10] + j * 2048 + c);
#pragma unroll
        for (int i = 0; i < 4; ++i) cw[j][i] = a[i]; }
    const f32x4 cbv = *(const f32x4*)(p.in[11] + c), skip = *(const f32x4*)(p.in[19] + c), gn = *(const f32x4*)(p.in[20] + c);
    for (int blk = blockIdx.x; blk < 256; blk += gridDim.x) {
        u32x2 hr, xr[4], zr;
#define MN_LOAD(tk_) do { const int s_ = (tk_) & (SEQL - 1); hr = *(const u32x2*)(Hm + (size_t)(tk_) * 2048 + c); zr = *(const u32x2*)(Y0 + (size_t)(tk_) * 4096 + 2048 + c); \
            _Pragma("unroll") for (int j = 0; j < 4; ++j) xr[j] = (s_ - 3 + j >= 0) ? *(const u32x2*)(XM + (size_t)((tk_) - 3 + j) * 2048 + c) : (u32x2){0u, 0u}; } while (0)
        MN_LOAD(blk * 64);
#pragma unroll 2
        for (int tt = 0; tt < 64; ++tt) {
            const int tk = blk * 64 + tt;
            const u32x2 hc_ = hr, zc_ = zr; const u32x2 xc0 = xr[0], xc1 = xr[1], xc2 = xr[2], xc3 = xr[3];
            if (tt < 63) MN_LOAD(tk + 1);
            float hv[4] = {bflo(hc_.x), bfhi(hc_.x), bflo(hc_.y), bfhi(hc_.y)};
            const float mu = wave_sum_dpp(hv[0] + hv[1] + hv[2] + hv[3]) * (1.0f / 256.0f);
            float d[4], sq = 0.f;
#pragma unroll
            for (int i = 0; i < 4; ++i) { d[i] = hv[i] - mu; sq += d[i] * d[i]; }
            const float rs = rsqrtf(wave_sum_dpp(sq) * (1.0f / 256.0f) + 1e-6f);
            float xmc[4] = {cbv[0], cbv[1], cbv[2], cbv[3]};
            const u32x2 xs[4] = {xc0, xc1, xc2, xc3};
#pragma unroll
            for (int j = 0; j < 4; ++j) { xmc[0] += cw[j][0] * bflo(xs[j].x); xmc[1] += cw[j][1] * bfhi(xs[j].x); xmc[2] += cw[j][2] * bflo(xs[j].y); xmc[3] += cw[j][3] * bfhi(xs[j].y); }
            const float z[4] = {bflo(zc_.x), bfhi(zc_.x), bflo(zc_.y), bfhi(zc_.y)};
            float o[4];
#pragma unroll
            for (int i = 0; i < 4; ++i) o[i] = (d[i] * rs * gn[i] + skip[i] * xmc[i] * fsig0(xmc[i])) * z[i] * fsig0(z[i]);
            u32x2 w; w.x = pk2(o[0], o[1]); w.y = pk2(o[2], o[3]); *(u32x2*)(Y0 + (size_t)tk * 4096 + 2048 + c) = w;
        }
#undef MN_LOAD
    }
}

__device__ __forceinline__ float fsigmoid(float x) { return __builtin_amdgcn_rcpf(1.0f + __expf(-x)); }
__device__ __forceinline__ float ftanh(float x) { return 1.0f - 2.0f * __builtin_amdgcn_rcpf(1.0f + __expf(2.0f * x)); }
__device__ __forceinline__ float row16_sum(float v) { v += dppf<0xB1>(v); v += dppf<0x4E>(v); v += dppf<0x141>(v); v += dppf<0x140>(v); return v; }
#define LBAR() do { asm volatile("s_waitcnt lgkmcnt(0)" ::: "memory"); __builtin_amdgcn_s_barrier(); asm volatile("" ::: "memory"); } while (0)
struct RwStep { f32x4 d0, d1, a0, a1, b0, b1, k0, k1, w0, w1; float v0, v1; f32x2 sc; };
__device__ __forceinline__ RwStep rw_load(const float* vb, const float* vrow, const float* sb) {
    RwStep s;
    s.d0 = *(const f32x4*)vb; s.d1 = *(const f32x4*)(vb + 4); s.a0 = *(const f32x4*)(vb + 64); s.a1 = *(const f32x4*)(vb + 68);
    s.b0 = *(const f32x4*)(vb + 128); s.b1 = *(const f32x4*)(vb + 132); s.k0 = *(const f32x4*)(vb + 192); s.k1 = *(const f32x4*)(vb + 196);
    s.w0 = *(const f32x4*)(vb + 256); s.w1 = *(const f32x4*)(vb + 260);
    s.v0 = vrow[320]; s.v1 = vrow[352]; s.sc = *(const f32x2*)sb;
    return s;
}
__device__ void rwkv_phase(const Params& p, unsigned char* smem) {
    constexpr int TC = 16, NCH = SEQL / TC;
    u16* W2t = (u16*)smem;
    u16* A2t = W2t + 64 * 104;
    float* vec = (float*)(A2t + 64 * 104);
    float* scal = vec + 2 * TC * 384;
    float* Yraw = scal + 2 * TC * 4;
    u16* raw = (u16*)(Yraw + 2 * TC * 64);
    u16* twa = raw + 3 * 17 * 64;
    const int tid = threadIdx.x, lane = tid & 63, wave = __builtin_amdgcn_readfirstlane(tid >> 6);
    const int l15 = lane & 15, lq = lane >> 4;
    u16* R = (u16*)(p.ws + OFF_R); const u16* Kb = (const u16*)(p.ws + OFF_KK); const u16* Vb = (const u16*)(p.ws + OFF_V); const u16* P = (const u16*)(p.ws + OFF_P);
    for (int unit = blockIdx.x; unit < 256; unit += gridDim.x) {
        const int b = unit >> 6, h = unit & 63, hc = 64 * h;
        for (int e = tid; e < 6144; e += 512) { const int j = e >> 6, k = e & 63; W2t[k * 104 + j] = f2bf(p.in[30][(size_t)j * 4096 + hc + k]); A2t[k * 104 + j] = f2bf(p.in[33][(size_t)j * 4096 + hc + k]); }
        __syncthreads();
        if (wave < 4) {
            const int rp = tid >> 3, j8 = tid & 7;
            f32x2 S0[4], S1[4];
#pragma unroll
            for (int i = 0; i < 4; ++i) { S0[i] = (f32x2){0.f, 0.f}; S1[i] = (f32x2){0.f, 0.f}; }
            for (int pc = -1; pc <= NCH; ++pc) {
                const bool act = (pc >= 0 && pc < NCH);
                const float* vbase = vec + (pc & 1) * TC * 384;
                const float* sbase = scal + (pc & 1) * TC * 4;
                float* ybase = Yraw + (pc & 1) * TC * 64;
#pragma unroll 1
                for (int q = 0; q < 2; ++q) {
                    if (act) {
                        RwStep cur = rw_load(vbase + (8 * q) * 384 + 8 * j8, vbase + (8 * q) * 384 + rp, sbase + (8 * q) * 4);
#pragma unroll
                        for (int tt = 0; tt < 8; ++tt) {
                            const int t = 8 * q + tt;
                            RwStep nxt = cur;
                            if (tt < 7) nxt = rw_load(vbase + (t + 1) * 384 + 8 * j8, vbase + (t + 1) * 384 + rp, sbase + (t + 1) * 4);
                            __builtin_amdgcn_sched_barrier(0);
                            const f32x2 av[4] = {{cur.a0[0], cur.a0[1]}, {cur.a0[2], cur.a0[3]}, {cur.a1[0], cur.a1[1]}, {cur.a1[2], cur.a1[3]}};
                            const f32x2 wv[4] = {{cur.w0[0], cur.w0[1]}, {cur.w0[2], cur.w0[3]}, {cur.w1[0], cur.w1[1]}, {cur.w1[2], cur.w1[3]}};
                            const f32x2 dv[4] = {{cur.d0[0], cur.d0[1]}, {cur.d0[2], cur.d0[3]}, {cur.d1[0], cur.d1[1]}, {cur.d1[2], cur.d1[3]}};
                            const f32x2 bv[4] = {{cur.b0[0], cur.b0[1]}, {cur.b0[2], cur.b0[3]}, {cur.b1[0], cur.b1[1]}, {cur.b1[2], cur.b1[3]}};
                            const f32x2 kv[4] = {{cur.k0[0], cur.k0[1]}, {cur.k0[2], cur.k0[3]}, {cur.k1[0], cur.k1[1]}, {cur.k1[2], cur.k1[3]}};
                            f32x2 q1 = S0[0] * av[0], q2 = S0[0] * wv[0], q3 = S1[0] * av[0], q4 = S1[0] * wv[0];
#pragma unroll
                            for (int i = 1; i < 4; ++i) { q1 += S0[i] * av[i]; q2 += S0[i] * wv[i]; q3 += S1[i] * av[i]; q4 += S1[i] * wv[i]; }
                            float p1 = q1.x + q1.y, p2 = q2.x + q2.y, p3 = q3.x + q3.y, p4 = q4.x + q4.y;
                            p1 += dppf<0xB1>(p1); p2 += dppf<0xB1>(p2); p3 += dppf<0xB1>(p3); p4 += dppf<0xB1>(p4);
                            p1 += dppf<0x4E>(p1); p2 += dppf<0x4E>(p2); p3 += dppf<0x4E>(p3); p4 += dppf<0x4E>(p4);
                            p1 += dppf<0x141>(p1); p2 += dppf<0x141>(p2); p3 += dppf<0x141>(p3); p4 += dppf<0x141>(p4);
                            { const float y0 = p2 + p1 * cur.sc.x + cur.v0 * cur.sc.y, y1 = p4 + p3 * cur.sc.x + cur.v1 * cur.sc.y;
                              if (j8 == 0) { ybase[t * 64 + rp] = y0; ybase[t * 64 + 32 + rp] = y1; } }
                            const f32x2 sa0 = {p1, p1}, sa1 = {p3, p3}, vv0 = {cur.v0, cur.v0}, vv1 = {cur.v1, cur.v1};
#pragma unroll
                            for (int i = 0; i < 4; ++i) { S0[i] = (S0[i] * dv[i] + vv0 * kv[i]) + sa0 * bv[i]; S1[i] = (S1[i] * dv[i] + vv1 * kv[i]) + sa1 * bv[i]; }
                            cur = nxt;
                        }
                    }
                    LBAR();
                }
            }
        } else {
            const int w4 = wave - 4, ptid = tid - 256, tl = 4 * lq + w4;
            float mu_r[4], mu_k[4], mu_v[4], w0k[4], a0k[4], kkk[4], kak[4], rkk[4], gng[4], gnb[4];
#pragma unroll
            for (int nt = 0; nt < 4; ++nt) { const int k = hc + 16 * nt + l15;
                mu_r[nt] = p.in[25][k]; mu_k[nt] = p.in[25][4096 + k]; mu_v[nt] = p.in[25][8192 + k];
                w0k[nt] = p.in[28][k]; a0k[nt] = p.in[31][k]; kkk[nt] = p.in[34][k]; kak[nt] = p.in[35][k]; rkk[nt] = p.in[36][k]; gng[nt] = p.in[37][k]; gnb[nt] = p.in[38][k]; }
            u32x4 pfP[4]; u32x2 pfR[4];
#define RW_PREFETCH(c) do { const int row0_ = b * SEQL + (c) * TC; \
                _Pragma("unroll") for (int i = 0; i < 2; ++i) { const int it = ptid + 256 * i; const int mt = it / 192, rem = it - mt * 192, t_ = rem / 12, g_ = rem - t_ * 12; \
                    if (it < 384) { const size_t row_ = (size_t)(row0_ + t_); pfP[2 * i] = *(const u32x4*)(P + row_ * 384 + mt * 192 + 8 * g_); \
                        pfP[2 * i + 1] = ((c) == 0 && t_ == 0) ? (u32x4){0u, 0u, 0u, 0u} : *(const u32x4*)(P + (row_ - 1) * 384 + mt * 192 + 96 + 8 * g_); } } \
                _Pragma("unroll") for (int i = 0; i < 4; ++i) { const int it = ptid + 256 * i; const int ar = it / 272, rem = it - ar * 272, rr_ = rem >> 4, c4 = rem & 15; \
                    if (it < 816) { const u16* src_ = ar == 0 ? (const u16*)R : ar == 1 ? Kb : Vb; \
                        pfR[i] = ((c) == 0 && rr_ == 0) ? (u32x2){0u, 0u} : *(const u32x2*)(src_ + (size_t)(row0_ - 1 + rr_) * 4096 + hc + 4 * c4); } } } while (0)
            RW_PREFETCH(0);
            for (int pc = -1; pc <= NCH; ++pc) {
                const int cn = pc + 1;
                const bool prep = (cn < NCH);
                float* vnext = vec + (cn & 1) * TC * 384;
                float* snext = scal + (cn & 1) * TC * 4;
                if (prep) {
#pragma unroll
                    for (int i = 0; i < 2; ++i) { const int it = ptid + 256 * i; const int mt = it / 192, rem = it - mt * 192, t_ = rem / 12, g_ = rem - t_ * 12;
                        if (it < 384) { float c8[8], p8[8]; unpack8(pfP[2 * i], c8); unpack8(pfP[2 * i + 1], p8);
#pragma unroll
                            for (int j = 0; j < 8; ++j) { const float s = c8[j] + p8[j]; c8[j] = mt == 0 ? ftanh(s) : s; }
                            *(u32x4*)(twa + (mt * 16 + t_) * 104 + 8 * g_) = pack8(c8); } }
#pragma unroll
                    for (int i = 0; i < 4; ++i) { const int it = ptid + 256 * i; const int ar = it / 272, rem = it - ar * 272, rr_ = rem >> 4, c4 = rem & 15;
                        if (it < 816) *(u32x2*)(raw + (ar * 17 + rr_) * 64 + 4 * c4) = pfR[i]; }
                }
                if (cn + 1 < NCH) RW_PREFETCH(cn + 1);
                if (pc >= 1) {
                    const int cp = pc - 1; const float* vprev = vec + (cp & 1) * TC * 384; const float* sprev = scal + (cp & 1) * TC * 4; const float* yprev = Yraw + (cp & 1) * TC * 64;
                    const size_t row = (size_t)(b * SEQL + cp * TC + tl);
                    float y[4], s1 = 0.f;
#pragma unroll
                    for (int nt = 0; nt < 4; ++nt) { y[nt] = yprev[tl * 64 + 16 * nt + l15]; s1 += y[nt]; }
                    const float mu = row16_sum(s1) * (1.0f / 64.0f); float s2 = 0.f;
#pragma unroll
                    for (int nt = 0; nt < 4; ++nt) { y[nt] -= mu; s2 += y[nt] * y[nt]; }
                    const float rs = rsqrtf(row16_sum(s2) * (1.0f / 64.0f) + 64e-5f), bon = sprev[tl * 4 + 2];
#pragma unroll
                    for (int nt = 0; nt < 4; ++nt) R[row * 4096 + hc + 16 * nt + l15] = f2bf(y[nt] * rs * gng[nt] + gnb[nt] + bon * vprev[tl * 384 + 320 + 16 * nt + l15]);
                }
                LBAR();
                if (prep) {
                    f32x4 accW[4], accA[4];
#pragma unroll
                    for (int nt = 0; nt < 4; ++nt) { accW[nt] = (f32x4){0.f, 0.f, 0.f, 0.f}; accA[nt] = (f32x4){0.f, 0.f, 0.f, 0.f}; }
#pragma unroll
                    for (int ks = 0; ks < 3; ++ks) { const bf16x8 afw = *(const bf16x8*)(twa + l15 * 104 + 32 * ks + 8 * lq), afa = *(const bf16x8*)(twa + (16 + l15) * 104 + 32 * ks + 8 * lq);
#pragma unroll
                        for (int nt = 0; nt < 4; ++nt) { const bf16x8 bw = *(const bf16x8*)(W2t + (16 * nt + l15) * 104 + 32 * ks + 8 * lq), ba = *(const bf16x8*)(A2t + (16 * nt + l15) * 104 + 32 * ks + 8 * lq);
                            accW[nt] = MFMA16(afw, bw, accW[nt]); accA[nt] = MFMA16(afa, ba, accA[nt]); } }
                    float r_[4], kx0[4], v_[4], dec[4], a_[4], kkv[4]; float ss = 0.f;
#pragma unroll
                    for (int nt = 0; nt < 4; ++nt) { const int k = 16 * nt + l15;
                        const float wl = w0k[nt] + (w4 == 0 ? accW[nt][0] : w4 == 1 ? accW[nt][1] : w4 == 2 ? accW[nt][2] : accW[nt][3]);
                        const float al = a0k[nt] + (w4 == 0 ? accA[nt][0] : w4 == 1 ? accA[nt][1] : w4 == 2 ? accA[nt][2] : accA[nt][3]);
                        const float rr = bf2f(raw[(0 * 17 + tl + 1) * 64 + k]), rp_ = bf2f(raw[(0 * 17 + tl) * 64 + k]);
                        const float kr_ = bf2f(raw[(1 * 17 + tl + 1) * 64 + k]), kp = bf2f(raw[(1 * 17 + tl) * 64 + k]);
                        const float vr = bf2f(raw[(2 * 17 + tl + 1) * 64 + k]), vp = bf2f(raw[(2 * 17 + tl) * 64 + k]);
                        r_[nt] = rr + (rp_ - rr) * mu_r[nt]; kx0[nt] = kr_ + (kp - kr_) * mu_k[nt]; v_[nt] = vr + (vp - vr) * mu_v[nt];
                        dec[nt] = __expf(-0.60653066f * fsigmoid(wl)); a_[nt] = fsigmoid(al);
                        kkv[nt] = kx0[nt] * kkk[nt]; ss += kkv[nt] * kkv[nt]; }
                    const float rinv = rsqrtf(fmaxf(row16_sum(ss), 1e-24f));
                    float br = 0.f, krs = 0.f, bon = 0.f; float* vb = vnext + tl * 384;
#pragma unroll
                    for (int nt = 0; nt < 4; ++nt) { const int k = 16 * nt + l15;
                        const float kk = kkv[nt] * rinv, kmod = kx0[nt] * (1.0f + (a_[nt] - 1.0f) * kak[nt]), kb = kk * a_[nt];
                        br += kb * r_[nt]; krs += kmod * r_[nt]; bon += r_[nt] * kmod * rkk[nt];
                        vb[k] = dec[nt]; vb[64 + k] = -kk; vb[128 + k] = kb; vb[192 + k] = kmod; vb[256 + k] = dec[nt] * r_[nt]; vb[320 + k] = v_[nt]; }
                    br = row16_sum(br); krs = row16_sum(krs); bon = row16_sum(bon);
                    if (l15 == 0) { snext[tl * 4] = br; snext[tl * 4 + 1] = krs; snext[tl * 4 + 2] = bon; }
                }
                LBAR();
            }
#undef RW_PREFETCH
        }
        __syncthreads();
    }
}

#ifndef PROBE_ROLE
#define PROBE_ROLE -1
#endif
#define LBARW() do { if (PROBE_ROLE >= 0 && wave == PROBE_ROLE) { const unsigned long long tb_ = __builtin_amdgcn_s_memrealtime(); LBAR(); twait += __builtin_amdgcn_s_memrealtime() - tb_; } else { LBAR(); } } while (0)
__device__ void ptanh_phase(const Params& p) {
    u16* P = (u16*)(p.ws + OFF_P);
    const int gt = blockIdx.x * 512 + threadIdx.x, nth = gridDim.x * 512;
    for (int it = gt; it < NTOK * 24; it += nth) { const int row = it / 24, rem = it - row * 24, mt = rem / 12, g = rem - mt * 12;
        u16* cp = P + (size_t)row * 384 + mt * 192 + 8 * g;
        float c8[8], p8[8]; unpack8(*(const u32x4*)cp, c8);
        if ((row & (SEQL - 1)) != 0) unpack8(*(const u32x4*)(cp - 384 + 96), p8);
        else {
#pragma unroll
            for (int j = 0; j < 8; ++j) p8[j] = 0.f; }
#pragma unroll
        for (int j = 0; j < 8; ++j) { const float s = c8[j] + p8[j]; c8[j] = mt == 0 ? (1.0f - 2.0f * __builtin_amdgcn_rcpf(1.0f + __expf(2.0f * s))) : s; }
        *(u32x4*)cp = pack8(c8); }
}

__device__ unsigned long long rwkv2_phase(const Params& p, unsigned char* smem) {
    unsigned long long twait = 0;
    constexpr int TC = 16, NCH = SEQL / TC;
    u16* W2t = (u16*)smem;
    u16* A2t = W2t + 64 * 104;
    u16* raw = A2t + 64 * 104;
    u16* twa = raw + 3 * 17 * 64;
    u16* S1 = twa + 2 * 16 * 104;
    unsigned char* S1b = (unsigned char*)(S1 + 2 * 4 * 16 * 72);
    float* Mx = (float*)(S1b + 3 * 10560);
    u16* Mxb = (u16*)(Mx + 1024);
    u16* AhT = Mxb + 3 * 16 * 32;
    u16* VhT = AhT + 64 * 16;
    float* MVs = (float*)(VhT + 64 * 16);
    float* ssP = MVs + 16 * 64;
    float* bonP = ssP + 64;
    unsigned char* S2 = (unsigned char*)(bonP + 64);
    u16* Sb = (u16*)(S2 + 2 * 16896);
    const int tid = threadIdx.x, lane = tid & 63, wave = __builtin_amdgcn_readfirstlane(tid >> 6);
    const int l15 = lane & 15, lq = lane >> 4;
    u16* R = (u16*)(p.ws + OFF_R); const u16* Kb = (const u16*)(p.ws + OFF_KK); const u16* Vb = (const u16*)(p.ws + OFF_V); const u16* P = (const u16*)(p.ws + OFF_P);
    for (int unit = blockIdx.x; unit < 256; unit += gridDim.x) {
        const int b = unit >> 6, h = unit & 63, hc = 64 * h;
        for (int e = tid; e < 6144; e += 512) { const int j = e >> 6, k = e & 63; W2t[k * 104 + j] = f2bf(p.in[30][(size_t)j * 4096 + hc + k]); A2t[k * 104 + j] = f2bf(p.in[33][(size_t)j * 4096 + hc + k]); }
        for (int e = tid; e < 64 * 72; e += 512) Sb[e] = 0;
        for (int e = tid; e < 3 * 16 * 32; e += 512) Mxb[e] = 0;
        __syncthreads();
        if (wave < 4) {
            const int w4 = wave, ptid = tid, k = 16 * w4 + l15, kg = hc + k;
            const float mu_r = p.in[25][kg], mu_k = p.in[25][4096 + kg], mu_v = p.in[25][8192 + kg];
            const float w0k = p.in[28][kg], a0k = p.in[31][kg], kkk = p.in[34][kg], kak = p.in[35][kg], rkk = p.in[36][kg];
            u32x4 pfP[2]; u32x2 pfR[4];
#define RW_PREFETCH(c) do { const int row0_ = b * SEQL + (c) * TC; \
                _Pragma("unroll") for (int i = 0; i < 2; ++i) { const int it = ptid + 256 * i; const int mt = it / 192, rem = it - mt * 192, t_ = rem / 12, g_ = rem - t_ * 12; \
                    if (it < 384) pfP[i] = *(const u32x4*)(P + (size_t)(row0_ + t_) * 384 + mt * 192 + 8 * g_); } \
                _Pragma("unroll") for (int i = 0; i < 4; ++i) { const int it = ptid + 256 * i; const int ar = it / 272, rem = it - ar * 272, rr_ = rem >> 4, c4 = rem & 15; \
                    if (it < 816) { const u16* src_ = ar == 0 ? (const u16*)R : ar == 1 ? Kb : Vb; \
                        pfR[i] = ((c) == 0 && rr_ == 0) ? (u32x2){0u, 0u} : *(const u32x2*)(src_ + (size_t)(row0_ - 1 + rr_) * 4096 + hc + 4 * c4); } } } while (0)
            RW_PREFETCH(0);
            for (int pc = 0; pc <= NCH + 1; ++pc) {
                const bool prep = (pc < NCH);
                int ln_ = lane; asm volatile("" : "+v"(ln_)); const int l15 = ln_ & 15, lq = ln_ >> 4;
                u16* set1 = S1 + (pc & 1) * (4 * 16 * 72);
                u16* At = set1; u16* Rt = set1 + 16 * 72; u16* Bt = set1 + 2 * 16 * 72; u16* Kt = set1 + 3 * 16 * 72;
                unsigned char* set1b = S1b + (pc % 3) * 10560;
                float* Vf = (float*)set1b; u16* BKT = (u16*)(set1b + 4096); u16* VT = (u16*)(set1b + 8192); float* W15 = (float*)(set1b + 10240); float* bonus = (float*)(set1b + 10496);
                if (prep) {
#pragma unroll
                    for (int i = 0; i < 2; ++i) { const int it = ptid + 256 * i; const int mt = it / 192, rem = it - mt * 192, t_ = rem / 12, g_ = rem - t_ * 12;
                        if (it < 384) *(u32x4*)(twa + (mt * 16 + t_) * 104 + 8 * g_) = pfP[i]; }
#pragma unroll
                    for (int i = 0; i < 4; ++i) { const int it = ptid + 256 * i; const int ar = it / 272, rem = it - ar * 272, rr_ = rem >> 4, c4 = rem & 15;
                        if (it < 816) *(u32x2*)(raw + (ar * 17 + rr_) * 64 + 4 * c4) = pfR[i]; }
                }
                if (pc + 1 < NCH) RW_PREFETCH(pc + 1);
                LBARW();
                float au[4], bu[4];
                if (prep) {
                    float kkv[4], a_[4], eP[4], eTi[4];
                    f32x4 accW = {0.f, 0.f, 0.f, 0.f}, accA = {0.f, 0.f, 0.f, 0.f};
#pragma unroll
                    for (int ks = 0; ks < 3; ++ks) { const bf16x8 afw = *(const bf16x8*)(twa + l15 * 104 + 32 * ks + 8 * lq), afa = *(const bf16x8*)(twa + (16 + l15) * 104 + 32 * ks + 8 * lq);
                        const bf16x8 bwf = *(const bf16x8*)(W2t + k * 104 + 32 * ks + 8 * lq), baf = *(const bf16x8*)(A2t + k * 104 + 32 * ks + 8 * lq);
                        accW = MFMA16(afw, bwf, accW); accA = MFMA16(afa, baf, accA); }
                    float ld[4]; f32x4 cum = {0.f, 0.f, 0.f, 0.f};
#pragma unroll
                    for (int r = 0; r < 4; ++r) ld[r] = -0.60653066f * fsigmoid(w0k + accW[r]);
#pragma unroll
                    for (int r = 0; r < 4; ++r) cum = __builtin_amdgcn_mfma_f32_16x16x4f32((4 * lq + r <= l15) ? 1.0f : 0.0f, ld[r], cum, 0, 0, 0);
                    float kmq[4], vq[4];
#pragma unroll
                    for (int r = 0; r < 4; ++r) { const int t = 4 * lq + r;
                        const float rr = bf2f(raw[(0 * 17 + t + 1) * 64 + k]), rp_ = bf2f(raw[(0 * 17 + t) * 64 + k]);
                        const float kr_ = bf2f(raw[(1 * 17 + t + 1) * 64 + k]), kp = bf2f(raw[(1 * 17 + t) * 64 + k]);
                        const float vr = bf2f(raw[(2 * 17 + t + 1) * 64 + k]), vp = bf2f(raw[(2 * 17 + t) * 64 + k]);
                        const float r_ = rr + (rp_ - rr) * mu_r, kx0 = kr_ + (kp - kr_) * mu_k, v_ = vr + (vp - vr) * mu_v;
                        a_[r] = fsigmoid(a0k + accA[r]); kkv[r] = kx0 * kkk;
                        const float kmod = kx0 * (1.0f + (a_[r] - 1.0f) * kak);
                        const float eT = __expf(cum[r]); eTi[r] = __builtin_amdgcn_rcpf(eT); eP[r] = __expf(cum[r] - ld[r]);
                        const float ssp = row16_sum(kkv[r] * kkv[r]), bop = row16_sum(r_ * kmod * rkk);
                        if (l15 == 0) { ssP[t * 4 + w4] = ssp; bonP[t * 4 + w4] = bop; }
                        Rt[t * 72 + k] = f2bf(r_ * eT); kmq[r] = kmod * eTi[r]; Kt[t * 72 + k] = f2bf(kmq[r]);
                        Vf[t * 64 + k] = v_; vq[r] = v_;
                        au[r] = -kkv[r] * eP[r]; bu[r] = kkv[r] * a_[r] * eTi[r];
                        if (t == 15) W15[k] = eT; }
                    { u32x2 w_; w_.x = pk2(kmq[0], kmq[1]); w_.y = pk2(kmq[2], kmq[3]); *(u32x2*)(BKT + k * 32 + lq * 8 + 4) = w_; }
                    { u32x2 w_; w_.x = pk2(vq[0], vq[1]); w_.y = pk2(vq[2], vq[3]); *(u32x2*)(VT + k * 16 + 4 * lq) = w_; }
                }
                LBARW();
                if (prep) {
                    float bq[4];
#pragma unroll
                    for (int r = 0; r < 4; ++r) { const int t = 4 * lq + r; const f32x4 s4 = *(const f32x4*)(ssP + t * 4);
                        const float rinv = rsqrtf(fmaxf((s4[0] + s4[1]) + (s4[2] + s4[3]), 1e-24f));
                        At[t * 72 + k] = f2bf(au[r] * rinv); bq[r] = bu[r] * rinv; Bt[t * 72 + k] = f2bf(bq[r]);
                        if (w4 == 0 && l15 == 0) { const f32x4 b4 = *(const f32x4*)(bonP + t * 4); bonus[t] = (b4[0] + b4[1]) + (b4[2] + b4[3]); } }
                    { u32x2 w_; w_.x = pk2(bq[0], bq[1]); w_.y = pk2(bq[2], bq[3]); *(u32x2*)(BKT + k * 32 + lq * 8) = w_; }
                }
                LBARW();
            }
#undef RW_PREFETCH
        } else if (wave < 6) {
            for (int pc = 0; pc <= NCH + 1; ++pc) {
                const int cm = pc - 1; const bool act = (cm >= 0 && cm < NCH);
                int ln_ = lane; asm volatile("" : "+v"(ln_)); const int lane = ln_, l15 = ln_ & 15, lq = ln_ >> 4; (void)lane;
                const u16* set1 = S1 + (cm & 1) * (4 * 16 * 72);
                const u16* At = set1; const u16* Rt = set1 + 16 * 72; const u16* Bt = set1 + 2 * 16 * 72; const u16* Kt = set1 + 3 * 16 * 72;
                if (act) {
                    f32x4 m0 = {0.f, 0.f, 0.f, 0.f}, m1 = {0.f, 0.f, 0.f, 0.f};
                    const u16* Xt = (wave == 4) ? At : Rt;
#pragma unroll
                    for (int ks = 0; ks < 2; ++ks) { const int o = l15 * 72 + 32 * ks + 8 * lq;
                        const bf16x8 xf = *(const bf16x8*)(Xt + o), bf_ = *(const bf16x8*)(Bt + o), kf = *(const bf16x8*)(Kt + o);
                        m0 = MFMA16(xf, bf_, m0); m1 = MFMA16(xf, kf, m1); }
#pragma unroll
                    for (int r = 0; r < 4; ++r) { const int t = 4 * lq + r, s = l15;
                        if (wave == 4) { Mx[t * 16 + s] = (s < t) ? m0[r] : 0.f; Mxb[1024 + t * 32 + s] = f2bf((s < t) ? m1[r] : 0.f); }
                        else { Mxb[t * 32 + s] = f2bf((s <= t) ? m0[r] : 0.f); Mxb[512 + t * 32 + s] = f2bf((s <= t) ? m1[r] : 0.f); } }
                }
                LBARW();
                if (act) {
                    unsigned char* set2 = S2 + (cm & 1) * 16896;
                    const float* Vf = (const float*)(S1b + (cm % 3) * 10560);
#define TRI_ROW(dst, base, t) do { dst[0] = *(const f32x4*)(Mx + (base) + (t) * 16); dst[1] = *(const f32x4*)(Mx + (base) + (t) * 16 + 4); dst[2] = *(const f32x4*)(Mx + (base) + (t) * 16 + 8); dst[3] = *(const f32x4*)(Mx + (base) + (t) * 16 + 12); } while (0)
#define TRI_NEXT(rc, rn) do { _Pragma("unroll") for (int i_ = 0; i_ < 4; ++i_) rc[i_] = rn[i_]; asm volatile("" ::: "memory"); } while (0)
                    if (wave == 4) {
                        u16* Ah = (u16*)set2;
                        float ah[16], x0[16];
#pragma unroll
                        for (int t = 0; t < 16; ++t) x0[t] = bf2f(At[t * 72 + lane]);
                        f32x4 rc[4], rn[4];
                        TRI_ROW(rc, 0, 0);
#pragma unroll
                        for (int t = 0; t < 16; ++t) { if (t < 15) TRI_ROW(rn, 0, t + 1);
                            float pa[4] = {x0[t], 0.f, 0.f, 0.f};
#pragma unroll
                            for (int s = 0; s + 1 < t; ++s) pa[s & 3] += rc[s >> 2][s & 3] * ah[s];
                            float acc = (pa[0] + pa[1]) + (pa[2] + pa[3]);
                            if (t >= 1) acc += rc[(t - 1) >> 2][(t - 1) & 3] * ah[t - 1];
                            ah[t] = acc; Ah[t * 72 + lane] = f2bf(acc);
                            TRI_NEXT(rc, rn); }
                        { u32x4 q0, q1; q0.x = pk2(ah[0], ah[1]); q0.y = pk2(ah[2], ah[3]); q0.z = pk2(ah[4], ah[5]); q0.w = pk2(ah[6], ah[7]);
                          q1.x = pk2(ah[8], ah[9]); q1.y = pk2(ah[10], ah[11]); q1.z = pk2(ah[12], ah[13]); q1.w = pk2(ah[14], ah[15]);
                          *(u32x4*)(AhT + lane * 16) = q0; *(u32x4*)(AhT + lane * 16 + 8) = q1; }
                    } else {
                        float* Vh = (float*)(set2 + 4608);
                        { const u16* VT = (const u16*)(S1b + (cm % 3) * 10560 + 8192);
                          const bf16x8 makf = *(const bf16x8*)(Mxb + 1024 + l15 * 32 + 8 * lq);
#pragma unroll
                          for (int nt = 0; nt < 4; ++nt) { u32x4 vz = {0u, 0u, 0u, 0u}; if (lq < 2) vz = *(const u32x4*)(VT + (16 * nt + l15) * 16 + 8 * lq);
                              const f32x4 d = MFMA16(makf, as_frag(vz), ((f32x4){0.f, 0.f, 0.f, 0.f}));
#pragma unroll
                              for (int r = 0; r < 4; ++r) MVs[(4 * lq + r) * 64 + 16 * nt + l15] = d[r]; }
                          asm volatile("s_waitcnt lgkmcnt(0)" ::: "memory"); }
                        float vh[16], x0[16];
#pragma unroll
                        for (int t = 0; t < 16; ++t) x0[t] = MVs[t * 64 + lane];
                        f32x4 rc[4], rn[4];
                        TRI_ROW(rc, 0, 0);
#pragma unroll
                        for (int t = 0; t < 16; ++t) { if (t < 15) TRI_ROW(rn, 0, t + 1);
                            float pa[4] = {x0[t], 0.f, 0.f, 0.f};
#pragma unroll
                            for (int s = 0; s + 1 < t; ++s) pa[s & 3] += rc[s >> 2][s & 3] * vh[s];
                            float acc = (pa[0] + pa[1]) + (pa[2] + pa[3]);
                            if (t >= 1) acc += rc[(t - 1) >> 2][(t - 1) & 3] * vh[t - 1];
                            vh[t] = acc; Vh[t * 64 + lane] = acc;
                            TRI_NEXT(rc, rn); }
                        { u32x4 q0, q1; q0.x = pk2(vh[0], vh[1]); q0.y = pk2(vh[2], vh[3]); q0.z = pk2(vh[4], vh[5]); q0.w = pk2(vh[6], vh[7]);
                          q1.x = pk2(vh[8], vh[9]); q1.y = pk2(vh[10], vh[11]); q1.z = pk2(vh[12], vh[13]); q1.w = pk2(vh[14], vh[15]);
                          *(u32x4*)(VhT + lane * 16) = q0; *(u32x4*)(VhT + lane * 16 + 8) = q1; }
                    }
                }
#undef TRI_ROW
#undef TRI_NEXT
                LBARW();
                if (act) {
                    unsigned char* set2 = S2 + (cm & 1) * 16896;
                    const bf16x8 mrbf = *(const bf16x8*)(Mxb + l15 * 32 + 8 * lq);
                    if (wave == 4) {
                        u16* Rh = (u16*)(set2 + 2304); float* Yk = (float*)(set2 + 12800);
                        const u16* VT = (const u16*)(S1b + (cm % 3) * 10560 + 8192);
                        const bf16x8 mrkf = *(const bf16x8*)(Mxb + 512 + l15 * 32 + 8 * lq);
#pragma unroll
                        for (int nt = 0; nt < 4; ++nt) { u32x4 az = {0u, 0u, 0u, 0u}, vz = {0u, 0u, 0u, 0u};
                            if (lq < 2) { az = *(const u32x4*)(AhT + (16 * nt + l15) * 16 + 8 * lq); vz = *(const u32x4*)(VT + (16 * nt + l15) * 16 + 8 * lq); }
                            const f32x4 d = MFMA16(mrbf, as_frag(az), ((f32x4){0.f, 0.f, 0.f, 0.f})), e = MFMA16(mrkf, as_frag(vz), ((f32x4){0.f, 0.f, 0.f, 0.f}));
#pragma unroll
                            for (int r = 0; r < 4; ++r) { const int o = (4 * lq + r) * 72 + 16 * nt + l15; Rh[o] = f2bf(d[r] + bf2f(Rt[o])); Yk[(4 * lq + r) * 64 + 16 * nt + l15] = e[r]; } }
                    } else {
                        float* Yh = (float*)(set2 + 8704);
#pragma unroll
                        for (int nt = 0; nt < 4; ++nt) { u32x4 vz = {0u, 0u, 0u, 0u}; if (lq < 2) vz = *(const u32x4*)(VhT + (16 * nt + l15) * 16 + 8 * lq);
                            const f32x4 d = MFMA16(mrbf, as_frag(vz), ((f32x4){0.f, 0.f, 0.f, 0.f}));
#pragma unroll
                            for (int r = 0; r < 4; ++r) Yh[(4 * lq + r) * 64 + 16 * nt + l15] = d[r]; }
                    }
                }
                LBARW();
            }
        } else {
            const int ws = wave - 6;
            float gng[4], gnb[4];
#pragma unroll
            for (int nt = 0; nt < 4; ++nt) { gng[nt] = p.in[37][hc + 16 * nt + l15]; gnb[nt] = p.in[38][hc + 16 * nt + l15]; }
            f32x4 accS[2][4];
#pragma unroll
            for (int m = 0; m < 2; ++m)
#pragma unroll
                for (int n = 0; n < 4; ++n) accS[m][n] = (f32x4){0.f, 0.f, 0.f, 0.f};
            for (int pc = 0; pc <= NCH + 1; ++pc) {
                const int cs = pc - 2; const bool act = (cs >= 0 && cs < NCH); const bool doY = act && ((cs & 1) == ws);
                int ln_ = lane; asm volatile("" : "+v"(ln_)); const int lane = ln_, l15 = ln_ & 15, lq = ln_ >> 4; (void)lane;
                const unsigned char* set2 = S2 + (cs & 1) * 16896;
                const u16* Ah = (const u16*)set2; const u16* Rh = (const u16*)(set2 + 2304); const float* Vh = (const float*)(set2 + 4608); const float* Yh = (const float*)(set2 + 8704); const float* Yk = (const float*)(set2 + 12800);
                const unsigned char* set1b = S1b + (((cs % 3) + 3) % 3) * 10560;
                const float* Vf = (const float*)set1b; const u16* BKT = (const u16*)(set1b + 4096); const u16* VT = (const u16*)(set1b + 8192); const float* W15 = (const float*)(set1b + 10240); const float* bonus = (const float*)(set1b + 10496);
                f32x4 accY[4], accSA[2];
                if (act) {
                    bf16x8 ahf[2];
#pragma unroll
                    for (int ks = 0; ks < 2; ++ks) ahf[ks] = *(const bf16x8*)(Ah + l15 * 72 + 32 * ks + 8 * lq);
#pragma unroll
                    for (int m = 0; m < 2; ++m) { const int vb = 16 * (2 * ws + m);
#pragma unroll
                        for (int r = 0; r < 4; ++r) accSA[m][r] = Vh[(4 * lq + r) * 64 + vb + l15];
#pragma unroll
                        for (int ks = 0; ks < 2; ++ks) { const bf16x8 sbf = *(const bf16x8*)(Sb + (vb + l15) * 72 + 32 * ks + 8 * lq); accSA[m] = MFMA16(ahf[ks], sbf, accSA[m]); } }
                    if (doY) {
                        bf16x8 rhf[2];
#pragma unroll
                        for (int ks = 0; ks < 2; ++ks) rhf[ks] = *(const bf16x8*)(Rh + l15 * 72 + 32 * ks + 8 * lq);
#pragma unroll
                        for (int nt = 0; nt < 4; ++nt) {
#pragma unroll
                            for (int r = 0; r < 4; ++r) accY[nt][r] = Yh[(4 * lq + r) * 64 + 16 * nt + l15] + Yk[(4 * lq + r) * 64 + 16 * nt + l15];
#pragma unroll
                            for (int ks = 0; ks < 2; ++ks) { const bf16x8 sbf = *(const bf16x8*)(Sb + (16 * nt + l15) * 72 + 32 * ks + 8 * lq); accY[nt] = MFMA16(rhf[ks], sbf, accY[nt]); } }
                    }
                }
                LBARW();
                if (act) {
#pragma unroll
                    for (int m = 0; m < 2; ++m) { const int vb = 16 * (2 * ws + m);
                        u32x4 af; af.x = pk2(accSA[m][0], accSA[m][1]); af.y = pk2(accSA[m][2], accSA[m][3]);
                        const u32x2 vt = *(const u32x2*)(VT + (vb + l15) * 16 + 4 * lq); af.z = vt.x; af.w = vt.y;
#pragma unroll
                        for (int n = 0; n < 4; ++n) { const bf16x8 bkf = *(const bf16x8*)(BKT + (16 * n + l15) * 32 + 8 * lq); accS[m][n] = MFMA16(as_frag(af), bkf, accS[m][n]); } }
#pragma unroll
                    for (int n = 0; n < 4; ++n) { const float w = W15[16 * n + l15];
#pragma unroll
                        for (int m = 0; m < 2; ++m) accS[m][n] = accS[m][n] * w; }
#pragma unroll
                    for (int m = 0; m < 2; ++m)
#pragma unroll
                        for (int n = 0; n < 4; ++n)
#pragma unroll
                            for (int r = 0; r < 4; ++r) Sb[(16 * (2 * ws + m) + 4 * lq + r) * 72 + 16 * n + l15] = f2bf(accS[m][n][r]);
                }
                LBARW();
                if (doY) {
#pragma unroll
                    for (int r = 0; r < 4; ++r) { const int t = 4 * lq + r; const size_t row = (size_t)(b * SEQL + cs * TC + t);
                        const float mu = row16_sum(accY[0][r] + accY[1][r] + accY[2][r] + accY[3][r]) * (1.0f / 64.0f);
                        float d[4], s2 = 0.f;
#pragma unroll
                        for (int nt = 0; nt < 4; ++nt) { d[nt] = accY[nt][r] - mu; s2 += d[nt] * d[nt]; }
                        const float rs = rsqrtf(row16_sum(s2) * (1.0f / 64.0f) + 64e-5f), bon = bonus[t];
#pragma unroll
                        for (int nt = 0; nt < 4; ++nt) R[row * 4096 + hc + 16 * nt + l15] = f2bf(d[nt] * rs * gng[nt] + gnb[nt] + bon * Vf[t * 64 + 16 * nt + l15]); }
                }
                LBARW();
            }
        }
        __syncthreads();
    }
    return twait;
}

__global__ void __launch_bounds__(512, 2) mega(Params p) {
    extern __shared__ __attribute__((aligned(16))) unsigned char smem[];
    cg::grid_group grid = cg::this_grid();
    const int lo = p.ph_lo, hi = p.ph_hi;
#define IN(k) (lo <= (k) && (k) < hi)
#define SEAM(k) do { if (IN(k) && IN((k) + 1)) grid.sync(); if (PROBE_PH >= 0) { const unsigned long long tn_ = __builtin_amdgcn_s_memrealtime(); if ((PROBE_PH >> (k)) & 1) tp1 += tn_ - tp0; tp0 = tn_; } } while (0)
    unsigned long long tp0 = (PROBE_PH >= 0) ? __builtin_amdgcn_s_memrealtime() : 0ull, tp1 = 0;
    unsigned char* ws = p.ws;
    PG8_LAS unsigned char* glds = (PG8_LAS unsigned char*)smem;
    if (IN(0)) for (int rep_ = 0; rep_ < 1 + (REP_MASK & 1); ++rep_) {
        tconv(smem, p.in[2], 8192, 0, 8192, 2048, (u16*)(ws + OFF_W0IN), 2048);
        tconv(smem, p.in[21], 2048, 0, 2048, 4096, (u16*)(ws + OFF_W0OUT), 4096);
        prep_small(p);
        rows_phase<0>(p);
    }
    SEAM(0);
    if (IN(1)) {
        pg8::Gemm g{(const u16*)(ws + OFF_H), (const u16*)(ws + OFF_W0IN), NTOK, 8192, 2048}; pg8::StaticOrder S; S.init(NTOK, 8192, gridDim.x, blockIdx.x);
        pg8::EpiG<F1> E{F1{(u16*)(ws + OFF_XR), (u16*)(ws + OFF_XM), (u16*)(ws + OFF_Y0)}};
        pg8::gemm_phase(glds, g, S, E); if ((REP_MASK >> 1) & 1) pg8::gemm_phase(glds, g, S, E);
    }
    SEAM(1);
    if (IN(2)) {
        mqk_phase(p, smem); if ((REP_MASK >> 2) & 1) { mqk_phase(p, smem); }
        lru_phase<1>(p, smem); if ((REP_MASK >> 3) & 1) { lru_phase<1>(p, smem); }
        tconv(smem, p.in[24], 16384, 0, 8192, 2048, (u16*)(ws + OFF_W1), 2048); if ((REP_MASK >> 4) & 1) { tconv(smem, p.in[24], 16384, 0, 8192, 2048, (u16*)(ws + OFF_W1), 2048); }
    }
    SEAM(2);
    if (IN(3)) lru_carry(p); if ((REP_MASK >> 5) & 1) { lru_carry(p); }
    SEAM(3);
    if (IN(4)) {
#ifdef PROBE_SUB
        const unsigned long long ta_ = __builtin_amdgcn_s_memrealtime();
#endif
        mlstm_phase(p, smem);
#ifdef PROBE_SUB
        tp1 += __builtin_amdgcn_s_memrealtime() - ta_;
#endif
        lru_phase<2>(p, smem); }
    SEAM(4);
    if (IN(5)) mnorm_phase(p);
    SEAM(5);
    if (IN(6)) {
        pg8::Gemm g{(const u16*)(ws + OFF_Y0), (const u16*)(ws + OFF_W0OUT), NTOK, 2048, 4096}; pg8::StaticOrder S; S.init(NTOK, 2048, gridDim.x, blockIdx.x);
        pg8::EpiG<F2> E{F2{(u16*)(ws + OFF_M0)}};
        pg8::gemm_phase(glds, g, S, E); if ((REP_MASK >> 7) & 1) pg8::gemm_phase(glds, g, S, E);
    }
    SEAM(6);
    if (IN(7)) {
        rows_phase<1>(p); if ((REP_MASK >> 8) & 1) { rows_phase<1>(p); }
        tconv(smem, p.in[24], 16384, 8192, 4096, 2048, (u16*)(ws + OFF_W1) + (size_t)8192 * 2048, 2048); if ((REP_MASK >> 4) & 1) { tconv(smem, p.in[24], 16384, 8192, 4096, 2048, (u16*)(ws + OFF_W1) + (size_t)8192 * 2048, 2048); }
        prep_extras(p); if ((REP_MASK >> 4) & 1) { prep_extras(p); }
    }
    SEAM(7);
    if (IN(8)) {
        pg8::Gemm g{(const u16*)(ws + OFF_H), (const u16*)(ws + OFF_W1), NTOK, 12800, 2048}; pg8::StaticOrder S; S.init(NTOK, 12800, gridDim.x, blockIdx.x);
        pg8::EpiG<F3> E{F3{(u16*)(ws + OFF_R), (u16*)(ws + OFF_P)}};
        pg8::gemm_phase(glds, g, S, E); if ((REP_MASK >> 9) & 1) pg8::gemm_phase(glds, g, S, E);
    }
    SEAM(8);
    if (IN(9)) {
#if RWKV_CHUNKED
        ptanh_phase(p);
        grid.sync();
        { const unsigned long long tw_ = rwkv2_phase(p, smem); if (PROBE_ROLE >= 0) tp1 += tw_; }
#else
        rwkv_phase(p, smem);
#endif
        tconv(smem, p.in[24], 16384, 12288, 4096, 2048, (u16*)(ws + OFF_W1Z), 2048); if ((REP_MASK >> 4) & 1) { tconv(smem, p.in[24], 16384, 12288, 4096, 2048, (u16*)(ws + OFF_W1Z), 2048); }
        tconv(smem, p.in[39], 2048, 0, 2048, 4096, (u16*)(ws + OFF_W1OUT), 4096); if ((REP_MASK >> 4) & 1) { tconv(smem, p.in[39], 2048, 0, 2048, 4096, (u16*)(ws + OFF_W1OUT), 4096); }
    }
    SEAM(9);
    if (IN(10)) {
        pg8::Gemm g{(const u16*)(ws + OFF_H), (const u16*)(ws + OFF_W1Z), NTOK, 4096, 2048}; pg8::StaticOrder S; S.init(NTOK, 4096, gridDim.x, blockIdx.x);
        pg8::EpiG<F4> E{F4{(u16*)(ws + OFF_R)}};
        pg8::gemm_phase(glds, g, S, E);
    }
    SEAM(10);
    if (IN(11)) {
        pg8::Gemm g{(const u16*)(ws + OFF_R), (const u16*)(ws + OFF_W1OUT), NTOK, 2048, 4096}; pg8::StaticOrder S; S.init(NTOK, 2048, gridDim.x, blockIdx.x);
        pg8::EpiG<F2> E{F2{(u16*)(ws + OFF_M1)}};
        pg8::gemm_phase(glds, g, S, E); if ((REP_MASK >> 10) & 1) pg8::gemm_phase(glds, g, S, E);
    }
    SEAM(11);
    if (IN(12)) rows_phase<2>(p);
#ifdef PROBE_SUB
    { const unsigned long long te = __builtin_amdgcn_s_memrealtime(); while (__builtin_amdgcn_s_memrealtime() - te < tp1) __builtin_amdgcn_s_sleep(8); }
#endif
    if (PROBE_PH >= 0) { const unsigned long long te = __builtin_amdgcn_s_memrealtime(); while (__builtin_amdgcn_s_memrealtime() - te < tp1) __builtin_amdgcn_s_sleep(8); }
}

extern "C" void kernel_launch(void* const* d_in, const int* in_sizes, int n_in, void* d_out, int out_size, void* d_ws, size_t ws_size, hipStream_t stream) {
    static int grid_blocks = 0;
    if (!grid_blocks) {
        if (n_in != 41 || ws_size < WS_NEED) { fprintf(stderr, "kernel_launch: unexpected n_in %d / ws_size %zu (need %zu)\n", n_in, ws_size, (size_t)WS_NEED); grid_blocks = -1; }
        else {
            int dev = 0, cus = 0, per_cu = 0;
            hipGetDevice(&dev);
            hipDeviceGetAttribute(&cus, hipDeviceAttributeMultiprocessorCount, dev);
            if (hipFuncSetAttribute((const void*)mega, hipFuncAttributeMaxDynamicSharedMemorySize, LDS_BYTES) != hipSuccess) fprintf(stderr, "kernel_launch: hipFuncSetAttribute failed\n");
            hipOccupancyMaxActiveBlocksPerMultiprocessor(&per_cu, (const void*)mega, 512, LDS_BYTES);
            if (per_cu < 1) { fprintf(stderr, "kernel_launch: occupancy query says %d blocks/CU\n", per_cu); per_cu = 1; }
            grid_blocks = cus * 1;
            if (grid_blocks > cus * per_cu) grid_blocks = cus * per_cu;
        }
    }
    if (grid_blocks <= 0) return;
    Params p{};
    for (int i = 0; i < 41; ++i) p.in[i] = (const float*)d_in[i];
    p.out = (float*)d_out; p.ws = (unsigned char*)d_ws;
#if N_LAUNCH_MODE == 1
    p.ph_lo = 0; p.ph_hi = NPH;
    { void* args[] = {&p};
      hipError_t e = hipLaunchCooperativeKernel((const void*)mega, dim3(grid_blocks), dim3(512), args, LDS_BYTES, stream);
      if (e != hipSuccess) fprintf(stderr, "cooperative launch failed: %s (grid %d)\n", hipGetErrorString(e), grid_blocks); }
#else
    for (int ph = 0; ph < NPH; ++ph) { p.ph_lo = ph; p.ph_hi = ph + 1; void* args[] = {&p};
        hipError_t e = hipLaunchCooperativeKernel((const void*)mega, dim3(grid_blocks), dim3(512), args, LDS_BYTES, stream);
        if (e != hipSuccess) { fprintf(stderr, "launch %d failed: %s (grid %d)\n", ph, hipGetErrorString(e), grid_blocks); break; } }
#endif
}
```
